# Optimizing an MI355X kernel written in HIP

```python
import jax, jax.numpy as jnp
from jax import lax
import numpy as np

D_MODEL = 1024
BATCH = 1
SEQ = 16384
DEPTH = 1

RET_HEADS = 8
RET_DK = 64
RET_DV = 128
RET_CHUNK = 128
ROPE_BASE = 10000.0
SB_HEADS = 8
SB_DH = 64
SB_BLOCK = 128
PEER_HEADS = 8
N_KEYS = 128
N_EXPERTS = N_KEYS * N_KEYS
PEER_TOPK = 16
PEER_DKEY = 256
PEER_CHUNK = 128
EPS = 1e-6

RET_QK = RET_HEADS * RET_DK
RET_V = RET_HEADS * RET_DV
SB_W = SB_HEADS * SB_DH
IN_SIZES = (RET_QK, RET_QK, RET_V, RET_V, SB_W, SB_W, SB_W, D_MODEL, D_MODEL)
IN_WIDTH = sum(IN_SIZES)

kernel_name = 'hybrid_retention_stickbreak_peer'


def rmsnorm(x, g):
    xf = x.astype(jnp.float32)
    y = xf * lax.rsqrt(jnp.mean(xf * xf, axis=-1, keepdims=True) + EPS)
    return (y * g.astype(jnp.float32)).astype(x.dtype)


def group_norm(y, g):
    yf = y.astype(jnp.float32)
    mu = jnp.mean(yf, axis=-1, keepdims=True)
    var = jnp.mean(jnp.square(yf - mu), axis=-1, keepdims=True)
    return (yf - mu) * lax.rsqrt(var + EPS) * g.astype(jnp.float32)


def rope(x, pos):
    half = x.shape[-1] // 2
    freqs = ROPE_BASE ** (-jnp.arange(half, dtype=jnp.float32) / half)
    ang = pos[:, None] * freqs[None, :]
    cos = jnp.cos(ang)[:, None, :]
    sin = jnp.sin(ang)[:, None, :]
    xf = x.astype(jnp.float32)
    x1, x2 = xf[..., :half], xf[..., half:]
    return jnp.concatenate([x1 * cos - x2 * sin, x1 * sin + x2 * cos], axis=-1)


def retention(q, k, v):
    B, S, H, dk = q.shape
    dv = v.shape[-1]
    C = RET_CHUNK
    n = S // C
    log_g = jnp.log1p(-jnp.exp2(-5.0 - jnp.arange(H, dtype=jnp.float32)))
    i = jnp.arange(C, dtype=jnp.float32)
    diff = i[:, None] - i[None, :]
    dmask = jnp.where(diff >= 0, jnp.exp(log_g[:, None, None] * jnp.maximum(diff, 0.0)), 0.0)
    q_dec = jnp.exp(log_g[:, None] * (i + 1.0)).T[None, :, :, None]
    k_dec = jnp.exp(log_g[:, None] * (C - 1.0 - i)).T[None, :, :, None]
    c_dec = jnp.exp(log_g * C)[None, :, None, None]

    def chunks(t):
        return jnp.moveaxis(t.reshape(B, n, C, H, t.shape[-1]), 1, 0)

    def step(state, xs):
        qc, kc, vc = xs
        scores = jnp.einsum('bihd,bjhd->bhij', qc, kc) * dmask[None]
        y = jnp.einsum('bhij,bjhe->bihe', scores, vc)
        y = y + jnp.einsum('bihd,bhde->bihe', qc, state) * q_dec
        state = state * c_dec + jnp.einsum('bjhd,bjhe->bhde', kc * k_dec, vc)
        return state, y

    state0 = jnp.zeros((B, H, dk, dv), jnp.float32)
    _, ys = lax.scan(step, state0, (chunks(q), chunks(k), chunks(v)))
    return jnp.moveaxis(ys, 0, 1).reshape(B, S, H, dv)


def stick_breaking(q, k, v):
    B, S, H, d = q.shape
    n = S // SB_BLOCK
    scale = SB_DH ** -0.5
    qh = jnp.transpose(q, (0, 2, 1, 3))
    kh = jnp.transpose(k, (0, 2, 1, 3))
    vh = jnp.transpose(v, (0, 2, 1, 3))
    qb = jnp.moveaxis(qh.reshape(B, H, n, SB_BLOCK, d), 2, 0)
    kpos = jnp.arange(S)

    def block(args):
        qi, bi = args
        z = jnp.einsum('bhtd,bhsd->bhts', qi, kh).astype(jnp.float32) * scale
        tpos = bi * SB_BLOCK + jnp.arange(SB_BLOCK)
        mask = kpos[None, :] < tpos[:, None]
        log_stay = jnp.where(mask, jax.nn.log_sigmoid(-z), 0.0)
        later = lax.cumsum(log_stay, axis=3, reverse=True) - log_stay
        w = jnp.where(mask, jnp.exp(jax.nn.log_sigmoid(z) + later), 0.0)
        return jnp.einsum('bhts,bhsd->bhtd', w.astype(vh.dtype), vh)

    out = lax.map(block, (qb, jnp.arange(n)))
    out = jnp.moveaxis(out, 0, 2).reshape(B, H, S, d)
    return jnp.transpose(out, (0, 2, 1, 3)).reshape(B, S, H * d)


def peer(x, w_q, sub_keys_1, sub_keys_2, u_tab, v_tab):
    B, S, D = x.shape
    T = PEER_CHUNK
    n = S // T
    xc = jnp.moveaxis(x.reshape(B, n, T, D), 1, 0)
    k1 = sub_keys_1.astype(jnp.float32)
    k2 = sub_keys_2.astype(jnp.float32)

    def block(xb):
        q = (xb @ w_q).reshape(B, T, PEER_HEADS, 2, PEER_DKEY // 2).astype(jnp.float32)
        s1 = jnp.einsum('bthd,nd->bthn', q[..., 0, :], k1)
        s2 = jnp.einsum('bthd,nd->bthn', q[..., 1, :], k2)
        v1, i1 = lax.top_k(s1, PEER_TOPK)
        v2, i2 = lax.top_k(s2, PEER_TOPK)
        cand_s = (v1[..., :, None] + v2[..., None, :]).reshape(B, T, PEER_HEADS, PEER_TOPK * PEER_TOPK)
        cand_i = (i1[..., :, None] * N_KEYS + i2[..., None, :]).reshape(B, T, PEER_HEADS, PEER_TOPK * PEER_TOPK)
        top_s, pos = lax.top_k(cand_s, PEER_TOPK)
        idx = jnp.take_along_axis(cand_i, pos, axis=-1)
        g = jax.nn.softmax(top_s, axis=-1)
        u_sel = jnp.take(u_tab, idx, axis=0)
        h = jnp.einsum('bthkd,btd->bthk', u_sel, xb)
        a = (jax.nn.gelu(h.astype(jnp.float32)) * g).astype(xb.dtype)
        return jnp.einsum('bthk,bthkd->btd', a, jnp.take(v_tab, idx, axis=0))

    y = lax.map(block, xc)
    return jnp.moveaxis(y, 0, 1).reshape(B, S, D)


def setup_inputs(seed: int = 0) -> dict:
    key = jax.random.key(seed)
    ks = jax.random.split(key, 17)
    f = jnp.float32
    nrm = lambda k, shape, s: jax.random.normal(k, shape, f) * s
    gain = lambda k, shape: 1.0 + 0.02 * jax.random.normal(k, shape, f)
    return {
        'x': jax.random.normal(ks[0], (BATCH, SEQ, D_MODEL), f),
        'norm_attn': gain(ks[1], (DEPTH, D_MODEL)),
        'w_in': nrm(ks[2], (DEPTH, D_MODEL, IN_WIDTH), D_MODEL ** -0.5),
        'ret_q_norm': gain(ks[3], (DEPTH, RET_DK)),
        'ret_k_norm': gain(ks[4], (DEPTH, RET_DK)),
        'ret_group_norm': gain(ks[5], (DEPTH, RET_V)),
        'sb_q_norm': gain(ks[6], (DEPTH, SB_DH)),
        'sb_k_norm': gain(ks[7], (DEPTH, SB_DH)),
        'w_branch_ret': nrm(ks[8], (DEPTH, RET_V, D_MODEL), RET_V ** -0.5),
        'w_branch_sb': nrm(ks[9], (DEPTH, SB_W, D_MODEL), SB_W ** -0.5),
        'w_out': nrm(ks[10], (DEPTH, D_MODEL, D_MODEL), D_MODEL ** -0.5),
        'norm_ffn': gain(ks[11], (DEPTH, D_MODEL)),
        'peer_w_q': nrm(ks[12], (DEPTH, D_MODEL, PEER_HEADS * PEER_DKEY), D_MODEL ** -0.5),
        'peer_sub_keys_1': nrm(ks[13], (DEPTH, N_KEYS, PEER_DKEY // 2), (PEER_DKEY // 2) ** -0.5),
        'peer_sub_keys_2': nrm(ks[14], (DEPTH, N_KEYS, PEER_DKEY // 2), (PEER_DKEY // 2) ** -0.5),
        'peer_u': nrm(ks[15], (DEPTH, N_EXPERTS, D_MODEL), D_MODEL ** -0.5),
        'peer_v': nrm(ks[16], (DEPTH, N_EXPERTS, D_MODEL), PEER_HEADS ** -0.5),
    }


def reference(x, norm_attn, w_in, ret_q_norm, ret_k_norm, ret_group_norm, sb_q_norm, sb_k_norm,
              w_branch_ret, w_branch_sb, w_out, norm_ffn, peer_w_q, peer_sub_keys_1,
              peer_sub_keys_2, peer_u, peer_v):
    B, S, D = x.shape
    pos = jnp.arange(S, dtype=jnp.float32)
    split_points = np.cumsum(IN_SIZES)[:-1].tolist()
    for l in range(DEPTH):
        xn = rmsnorm(x, norm_attn[l])
        proj = xn @ w_in[l]
        rq, rk, rv, rg, sq, sk, sv, ga, gb = jnp.split(proj, split_points, axis=-1)

        rq = rope(rmsnorm(rq.reshape(B, S, RET_HEADS, RET_DK), ret_q_norm[l]), pos)
        rk = rope(rmsnorm(rk.reshape(B, S, RET_HEADS, RET_DK), ret_k_norm[l]), pos) * (RET_DK ** -0.5)
        ret = retention(rq, rk, rv.reshape(B, S, RET_HEADS, RET_DV).astype(jnp.float32))
        ret = group_norm(ret, ret_group_norm[l].reshape(RET_HEADS, RET_DV)).reshape(B, S, RET_V)
        ret = ret.astype(x.dtype) * jax.nn.silu(rg)
        y_a = ret @ w_branch_ret[l]

        sq = rmsnorm(sq.reshape(B, S, SB_HEADS, SB_DH), sb_q_norm[l])
        sk = rmsnorm(sk.reshape(B, S, SB_HEADS, SB_DH), sb_k_norm[l])
        sb = stick_breaking(sq, sk, sv.reshape(B, S, SB_HEADS, SB_DH))
        y_b = sb @ w_branch_sb[l]

        mixed = jax.nn.sigmoid(ga) * y_a + jax.nn.sigmoid(gb) * y_b
        x = x + mixed @ w_out[l]

        hn = rmsnorm(x, norm_ffn[l])
        x = x + peer(hn, peer_w_q[l], peer_sub_keys_1[l], peer_sub_keys_2[l], peer_u[l], peer_v[l])
    return x
```

```cpp
#include <hip/hip_runtime.h>
#include <stdint.h>

typedef unsigned short u16;
#define S_ 16384
#define D_ 1024
#define MB_ ((size_t)1 << 20)

#define WS_WOUTT (1 * MB_)
#define WS_WQT (3 * MB_)
#define WS_K1 (7 * MB_)
#define WS_K2 (7 * MB_ + 65536)
#define WS_ROPE_C (8 * MB_)
#define WS_ROPE_S (10 * MB_)
#define WS_SSQ (12 * MB_)
#define WS_RQ (16 * MB_)
#define WS_RK (32 * MB_)
#define WS_RV (48 * MB_)
#define WS_SQ (80 * MB_)
#define WS_SK (96 * MB_)
#define WS_SV (112 * MB_)
#define WS_RG (128 * MB_)
#define WS_GA (160 * MB_)
#define WS_GB (192 * MB_)
#define WS_IDX (224 * MB_)
#define WS_G (232 * MB_)
#define WS_NEED (248 * MB_)
#define WS_U16 WS_RQ
#define WS_V16 WS_RV
#define WS_MIXED WS_SQ
#define WS_X1H WS_RG
#define WS_Q WS_GA
#define DO_XN (0 * MB_)
#define DO_WINT (32 * MB_)
#define DO_SB (32 * MB_)
#define DO_WBRAT (60 * MB_)
#define DO_WBRBT (62 * MB_)

__device__ __forceinline__ u16 f2bf(float f) { unsigned u = __float_as_uint(f); u += 0x7FFFu + ((u >> 16) & 1u); return (u16)(u >> 16); }
__device__ __forceinline__ float bf2f(u16 b) { return __uint_as_float(((unsigned)b) << 16); }
__device__ __forceinline__ u16 f2h(float f) { _Float16 h = (_Float16)f; return *(u16*)&h; }
__device__ __forceinline__ float h2f(u16 b) { _Float16 h = *(_Float16*)&b; return (float)h; }
template <bool F16> __device__ __forceinline__ float ld16(const u16* p) { return F16 ? h2f(*p) : bf2f(*p); }
__device__ __forceinline__ float sigmoidf_(float x) { return 1.0f / (1.0f + __expf(-x)); }

__global__ void k_rms_x(const float* __restrict__ x, const float* __restrict__ g, u16* __restrict__ xn) {
  __shared__ float red[4];
  const int t = blockIdx.x, tid = threadIdx.x;
  const float4 v = ((const float4*)(x + (size_t)t * D_))[tid];
  float s = v.x * v.x + v.y * v.y + v.z * v.z + v.w * v.w;
  for (int o = 32; o > 0; o >>= 1) s += __shfl_xor(s, o);
  if ((tid & 63) == 0) red[tid >> 6] = s;
  __syncthreads();
  s = red[0] + red[1] + red[2] + red[3];
  const float r = rsqrtf(s * (1.0f / D_) + 1e-6f);
  const float4 gg = ((const float4*)g)[tid];
  u16* o = xn + (size_t)t * D_ + tid * 4;
  o[0] = f2bf(v.x * r * gg.x); o[1] = f2bf(v.y * r * gg.y); o[2] = f2bf(v.z * r * gg.z); o[3] = f2bf(v.w * r * gg.w);
}

template <bool F16> __global__ void k_transpose(const float* __restrict__ W, u16* __restrict__ Wt, int K, int N, const float* __restrict__ scale) {
  __shared__ float tile[32][33];
  const int k0 = blockIdx.y * 32, n0 = blockIdx.x * 32, tx = threadIdx.x & 31, ty = threadIdx.x >> 5;
  for (int i = ty; i < 32; i += 8) { const int k = k0 + i; tile[i][tx] = W[(size_t)k * N + n0 + tx] * (scale ? scale[k] : 1.0f); }
  __syncthreads();
  for (int i = ty; i < 32; i += 8) { const float v = tile[tx][i]; Wt[(size_t)(n0 + i) * K + k0 + tx] = F16 ? f2h(v) : f2bf(v); }
}
__global__ void k_conv_bf16(const float* __restrict__ a, u16* __restrict__ o, int n) { const int i = blockIdx.x * blockDim.x + threadIdx.x; if (i < n) o[i] = f2bf(a[i]); }
__global__ void k_conv_table(const float* __restrict__ a, u16* __restrict__ o, const float* __restrict__ colscale) {
  const size_t i = ((size_t)blockIdx.x * blockDim.x + threadIdx.x) * 4;
  const float4 v = *(const float4*)(a + i);
  float4 s = make_float4(1.f, 1.f, 1.f, 1.f);
  if (colscale) s = *(const float4*)(colscale + (i & (D_ - 1)));
  o[i] = f2h(v.x * s.x); o[i + 1] = f2h(v.y * s.y); o[i + 2] = f2h(v.z * s.z); o[i + 3] = f2h(v.w * s.w);
}
__global__ void k_rope_table(float* __restrict__ c, float* __restrict__ s) {
  const int i = blockIdx.x * blockDim.x + threadIdx.x;
  const int t = i >> 5, f = i & 31;
  const float freq = powf(10000.0f, -(float)f / 32.0f);
  const float ang = (float)t * freq;
  float sn, cs; sincosf(ang, &sn, &cs);
  c[i] = cs; s[i] = sn;
}

template <bool F16, class Epi> __global__ void __launch_bounds__(256) k_gemm_naive(const u16* __restrict__ A, const u16* __restrict__ Bt, int M, int N, int K, Epi E) {
  __shared__ float As[64][33], Bs[64][33];
  const int tid = threadIdx.x, tx = tid & 15, ty = tid >> 4, m0 = blockIdx.y * 64, n0 = blockIdx.x * 64;
  float acc[4][4];
#pragma unroll
  for (int i = 0; i < 4; ++i)
#pragma unroll
    for (int j = 0; j < 4; ++j) acc[i][j] = 0.f;
  const int lr = tid >> 2, lc = (tid & 3) * 8;
  for (int k0 = 0; k0 < K; k0 += 32) {
    const u16* ap = A + (size_t)(m0 + lr) * K + k0 + lc; const u16* bp = Bt + (size_t)(n0 + lr) * K + k0 + lc;
#pragma unroll
    for (int j = 0; j < 8; ++j) { As[lr][lc + j] = ld16<F16>(ap + j); Bs[lr][lc + j] = ld16<F16>(bp + j); }
    __syncthreads();
#pragma unroll 8
    for (int k = 0; k < 32; ++k) {
      float a[4], b[4];
#pragma unroll
      for (int i = 0; i < 4; ++i) { a[i] = As[ty * 4 + i][k]; b[i] = Bs[tx * 4 + i][k]; }
#pragma unroll
      for (int i = 0; i < 4; ++i)
#pragma unroll
        for (int j = 0; j < 4; ++j) acc[i][j] += a[i] * b[j];
    }
    __syncthreads();
  }
#pragma unroll
  for (int i = 0; i < 4; ++i)
#pragma unroll
    for (int j = 0; j < 4; ++j) E(m0 + ty * 4 + i, n0 + tx * 4 + j, acc[i][j]);
}
struct EpiInProj {
  u16 *rq, *rk, *rv, *rg, *sq, *sk, *sv, *ga, *gb;
  __device__ void operator()(int r, int c, float v) const {
    u16* b; int ld, c0;
    if (c < 512) { b = rq; ld = 512; c0 = 0; } else if (c < 1024) { b = rk; ld = 512; c0 = 512; } else if (c < 2048) { b = rv; ld = 1024; c0 = 1024; }
    else if (c < 3072) { b = rg; ld = 1024; c0 = 2048; } else if (c < 3584) { b = sq; ld = 512; c0 = 3072; } else if (c < 4096) { b = sk; ld = 512; c0 = 3584; }
    else if (c < 4608) { b = sv; ld = 512; c0 = 4096; } else if (c < 5632) { b = ga; ld = 1024; c0 = 4608; } else { b = gb; ld = 1024; c0 = 5632; }
    b[(size_t)r * ld + (c - c0)] = f2bf(v);
  }
};
struct EpiMixB { u16* mixed; const u16* gb; __device__ void operator()(int r, int c, float v) const { const size_t i = (size_t)r * D_ + c; mixed[i] = f2bf(sigmoidf_(bf2f(gb[i])) * v); } };
struct EpiMixA { u16* mixed; const u16* ga; __device__ void operator()(int r, int c, float v) const { const size_t i = (size_t)r * D_ + c; mixed[i] = f2bf(bf2f(mixed[i]) + sigmoidf_(bf2f(ga[i])) * v); } };
struct EpiOut { const float* x; float* x1; u16* x1h; __device__ void operator()(int r, int c, float v) const { const size_t i = (size_t)r * D_ + c; const float o = x[i] + v; x1[i] = o; x1h[i] = f2h(o); } };
struct EpiQ { const float* ssq; u16* q; __device__ void operator()(int r, int c, float v) const { const float rstd = rsqrtf(ssq[r] * (1.0f / D_) + 1e-6f); q[(size_t)r * 2048 + c] = f2bf(v * rstd); } };

__global__ void k_rowssq(const float* __restrict__ x1, float* __restrict__ ssq) {
  __shared__ float red[4];
  const int t = blockIdx.x, tid = threadIdx.x;
  const float4 v = ((const float4*)(x1 + (size_t)t * D_))[tid];
  float s = v.x * v.x + v.y * v.y + v.z * v.z + v.w * v.w;
  for (int o = 32; o > 0; o >>= 1) s += __shfl_xor(s, o);
  if ((tid & 63) == 0) red[tid >> 6] = s;
  __syncthreads();
  if (tid == 0) ssq[t] = red[0] + red[1] + red[2] + red[3];
}

__global__ void k_qknorm(u16* __restrict__ buf, const float* __restrict__ gain, const float* __restrict__ rc, const float* __restrict__ rs, int which) {
  const int i = blockIdx.x * blockDim.x + threadIdx.x;
  const int t = i >> 3, h = i & 7;
  u16* p = buf + (size_t)t * 512 + h * 64;
  float v[64]; float ss = 0.f;
#pragma unroll
  for (int d = 0; d < 64; ++d) { v[d] = bf2f(p[d]); ss += v[d] * v[d]; }
  const float r = rsqrtf(ss * (1.0f / 64.0f) + 1e-6f);
#pragma unroll
  for (int d = 0; d < 64; ++d) v[d] = v[d] * r * gain[d];
  if (which < 2) {
    const float sc = which == 1 ? 0.125f : 1.0f;
#pragma unroll
    for (int d = 0; d < 32; ++d) {
      const float c = rc[t * 32 + d], s = rs[t * 32 + d];
      const float a = v[d], b = v[d + 32];
      v[d] = (a * c - b * s) * sc; v[d + 32] = (a * s + b * c) * sc;
    }
  }
#pragma unroll
  for (int d = 0; d < 64; ++d) p[d] = f2bf(v[d]);
}

struct RetConst { float l2g[8]; };
__global__ void __launch_bounds__(256) k_ret_naive(const u16* __restrict__ rq, const u16* __restrict__ rk, const u16* __restrict__ rv, u16* __restrict__ rg,
                                                   const float* __restrict__ gn, RetConst rc) {
  __shared__ float red[64][4][2];
  const int h = blockIdx.y, t0 = blockIdx.x * 64, tid = threadIdx.x, tl = tid & 63, eq = tid >> 6, t = t0 + tl;
  float q[64], acc[32];
#pragma unroll
  for (int d = 0; d < 64; ++d) q[d] = bf2f(rq[(size_t)t * 512 + h * 64 + d]);
#pragma unroll
  for (int e = 0; e < 32; ++e) acc[e] = 0.f;
  const float l2g = rc.l2g[h];
  for (int s = 0; s <= t0 + 63; ++s) {
    const u16* kp = rk + (size_t)s * 512 + h * 64;
    float sc = 0.f;
#pragma unroll
    for (int d = 0; d < 64; ++d) sc += q[d] * bf2f(kp[d]);
    const float w = (s <= t) ? sc * exp2f((float)(t - s) * l2g) : 0.f;
    const u16* vp = rv + (size_t)s * 1024 + h * 128 + eq * 32;
#pragma unroll
    for (int e = 0; e < 32; ++e) acc[e] += w * bf2f(vp[e]);
  }
  float s1 = 0.f;
#pragma unroll
  for (int e = 0; e < 32; ++e) s1 += acc[e];
  red[tl][eq][0] = s1;
  __syncthreads();
  const float mu = (red[tl][0][0] + red[tl][1][0] + red[tl][2][0] + red[tl][3][0]) * (1.0f / 128.0f);
  float s2 = 0.f;
#pragma unroll
  for (int e = 0; e < 32; ++e) { const float d = acc[e] - mu; s2 += d * d; }
  red[tl][eq][1] = s2;
  __syncthreads();
  const float var = (red[tl][0][1] + red[tl][1][1] + red[tl][2][1] + red[tl][3][1]) * (1.0f / 128.0f);
  const float rstd = rsqrtf(var + 1e-6f);
  u16* gp = rg + (size_t)t * 1024 + h * 128 + eq * 32;
#pragma unroll
  for (int e = 0; e < 32; ++e) {
    const float g = bf2f(gp[e]);
    const float y = (acc[e] - mu) * rstd * gn[h * 128 + eq * 32 + e];
    gp[e] = f2bf(y * g * sigmoidf_(g));
  }
}

__global__ void __launch_bounds__(256) k_sb_naive(const u16* __restrict__ sq, const u16* __restrict__ sk, const u16* __restrict__ sv, u16* __restrict__ sb) {
  const int h = blockIdx.y, t0 = blockIdx.x * 64, tid = threadIdx.x, tl = tid & 63, eq = tid >> 6, t = t0 + tl;
  float q[64], acc[16];
#pragma unroll
  for (int d = 0; d < 64; ++d) q[d] = bf2f(sq[(size_t)t * 512 + h * 64 + d]);
#pragma unroll
  for (int e = 0; e < 16; ++e) acc[e] = 0.f;
  float later = 0.f;
  for (int s = t0 + 62; s >= 0; --s) {
    if (s < t0 && __all(later < -104.0f)) break;
    const u16* kp = sk + (size_t)s * 512 + h * 64;
    float z = 0.f;
#pragma unroll
    for (int d = 0; d < 64; ++d) z += q[d] * bf2f(kp[d]);
    z *= 0.125f;
    if (s < t) {
      const float sp = fmaxf(z, 0.f) + log1pf(__expf(-fabsf(z)));
      const float w = __expf((z - sp) + later);
      const u16* vp = sv + (size_t)s * 512 + h * 64 + eq * 16;
#pragma unroll
      for (int e = 0; e < 16; ++e) acc[e] += w * bf2f(vp[e]);
      later -= sp;
    }
  }
  u16* op = sb + (size_t)t * 512 + h * 64 + eq * 16;
#pragma unroll
  for (int e = 0; e < 16; ++e) op[e] = f2bf(acc[e]);
}

#define INS16(V, I, x, id) do { float _x = (x); int _i = (id); \
  _Pragma("unroll") for (int _j = 15; _j >= 1; --_j) { const bool _a = _x > V[_j - 1], _b = _x > V[_j]; \
    const float nv = _a ? V[_j - 1] : (_b ? _x : V[_j]); const int ni = _a ? I[_j - 1] : (_b ? _i : I[_j]); V[_j] = nv; I[_j] = ni; } \
  if (_x > V[0]) { V[0] = _x; I[0] = _i; } } while (0)
__global__ void __launch_bounds__(64) k_select_naive(const u16* __restrict__ q, const u16* __restrict__ k1, const u16* __restrict__ k2, u16* __restrict__ idx, float* __restrict__ gw) {
  __shared__ u16 ks[2][128 * 128];
  for (int i = threadIdx.x; i < 128 * 128; i += 64) { ks[0][i] = k1[i]; ks[1][i] = k2[i]; }
  __syncthreads();
  const int i = blockIdx.x * 64 + threadIdx.x, t = i >> 3, h = i & 7;
  float v1[16], v2[16]; int i1[16], i2[16];
#pragma unroll
  for (int j = 0; j < 16; ++j) { v1[j] = -3.0e38f; v2[j] = -3.0e38f; i1[j] = 0; i2[j] = 0; }
  const u16* qp = q + (size_t)t * 2048 + h * 256;
  for (int n = 0; n < 128; ++n) {
    float s = 0.f;
    for (int d = 0; d < 128; ++d) s += bf2f(qp[d]) * bf2f(ks[0][n * 128 + d]);
    INS16(v1, i1, s, n);
  }
  for (int n = 0; n < 128; ++n) {
    float s = 0.f;
    for (int d = 0; d < 128; ++d) s += bf2f(qp[128 + d]) * bf2f(ks[1][n * 128 + d]);
    INS16(v2, i2, s, n);
  }
  float tv[16]; int ti[16];
#pragma unroll
  for (int j = 0; j < 16; ++j) { tv[j] = -3.0e38f; ti[j] = 0; }
#pragma unroll
  for (int a = 0; a < 16; ++a)
#pragma unroll
    for (int b = 0; b < 16; ++b)
      if ((a + 1) * (b + 1) <= 16) INS16(tv, ti, v1[a] + v2[b], i1[a] * 128 + i2[b]);
  float sum = 0.f, e[16];
#pragma unroll
  for (int j = 0; j < 16; ++j) { e[j] = __expf(tv[j] - tv[0]); sum += e[j]; }
  const float inv = 1.0f / sum;
#pragma unroll
  for (int j = 0; j < 16; ++j) { idx[(size_t)t * 128 + h * 16 + j] = (u16)ti[j]; gw[(size_t)t * 128 + h * 16 + j] = e[j] * inv; }
}

__device__ __forceinline__ float gelu_tanh(float x) { const float u = 0.7978845608028654f * (x + 0.044715f * x * x * x); return 0.5f * x * (1.0f + tanhf(u)); }
__global__ void __launch_bounds__(256) k_gather_naive(const u16* __restrict__ x1h, const float* __restrict__ ssq, const u16* __restrict__ idx, const float* __restrict__ gw,
                                                      const u16* __restrict__ u16t, const u16* __restrict__ v16t, float* __restrict__ out) {
  __shared__ float a_s[128]; __shared__ int e_s[128];
  const int t = blockIdx.x, tid = threadIdx.x, lane = tid & 63, w = tid >> 6;
  if (tid < 128) e_s[tid] = idx[(size_t)t * 128 + tid];
  __syncthreads();
  float xr[16];
#pragma unroll
  for (int j = 0; j < 16; ++j) xr[j] = h2f(x1h[(size_t)t * D_ + lane * 16 + j]);
  const float rstd = rsqrtf(ssq[t] * (1.0f / D_) + 1e-6f);
  for (int p = w; p < 128; p += 4) {
    const u16* up = u16t + (size_t)e_s[p] * D_ + lane * 16;
    float s = 0.f;
#pragma unroll
    for (int j = 0; j < 16; ++j) s += xr[j] * h2f(up[j]);
    for (int o = 32; o > 0; o >>= 1) s += __shfl_xor(s, o);
    if (lane == 0) a_s[p] = gelu_tanh(s * rstd) * gw[(size_t)t * 128 + p];
  }
  __syncthreads();
  float acc[4] = {0.f, 0.f, 0.f, 0.f};
  for (int p = 0; p < 128; ++p) {
    const u16* vp = v16t + (size_t)e_s[p] * D_ + tid * 4;
    const float a = a_s[p];
#pragma unroll
    for (int j = 0; j < 4; ++j) acc[j] += a * h2f(vp[j]);
  }
  float* op = out + (size_t)t * D_ + tid * 4;
#pragma unroll
  for (int j = 0; j < 4; ++j) op[j] += acc[j];
}

extern "C" void kernel_launch(void* const* d_in, const int* in_sizes, int n_in, void* d_out, int out_size, void* d_ws, size_t ws_size, hipStream_t stream) {
  if (ws_size < WS_NEED) return;
  const float* x = (const float*)d_in[0]; const float* norm_attn = (const float*)d_in[1]; const float* w_in = (const float*)d_in[2];
  const float* ret_q_norm = (const float*)d_in[3]; const float* ret_k_norm = (const float*)d_in[4]; const float* ret_gn = (const float*)d_in[5];
  const float* sb_q_norm = (const float*)d_in[6]; const float* sb_k_norm = (const float*)d_in[7]; const float* w_bra = (const float*)d_in[8];
  const float* w_brb = (const float*)d_in[9]; const float* w_out = (const float*)d_in[10]; const float* norm_ffn = (const float*)d_in[11];
  const float* w_q = (const float*)d_in[12]; const float* sk1 = (const float*)d_in[13]; const float* sk2 = (const float*)d_in[14];
  const float* peer_u = (const float*)d_in[15]; const float* peer_v = (const float*)d_in[16];
  char* ws = (char*)d_ws; char* dob = (char*)d_out; float* out = (float*)d_out;
  u16* XN = (u16*)(dob + DO_XN); u16* WINT = (u16*)(dob + DO_WINT); u16* SB = (u16*)(dob + DO_SB); u16* WBRAT = (u16*)(dob + DO_WBRAT); u16* WBRBT = (u16*)(dob + DO_WBRBT);
  u16* WOUTT = (u16*)(ws + WS_WOUTT); u16* WQT = (u16*)(ws + WS_WQT); u16* K1 = (u16*)(ws + WS_K1); u16* K2 = (u16*)(ws + WS_K2);
  float* RC = (float*)(ws + WS_ROPE_C); float* RS = (float*)(ws + WS_ROPE_S); float* SSQ = (float*)(ws + WS_SSQ);
  u16* RQ = (u16*)(ws + WS_RQ); u16* RK = (u16*)(ws + WS_RK); u16* RV = (u16*)(ws + WS_RV); u16* SQ = (u16*)(ws + WS_SQ); u16* SK = (u16*)(ws + WS_SK);
  u16* SV = (u16*)(ws + WS_SV); u16* RG = (u16*)(ws + WS_RG); u16* GA = (u16*)(ws + WS_GA); u16* GB = (u16*)(ws + WS_GB);
  u16* IDX = (u16*)(ws + WS_IDX); float* GW = (float*)(ws + WS_G);
  u16* U16 = (u16*)(ws + WS_U16); u16* V16 = (u16*)(ws + WS_V16); u16* MIXED = (u16*)(ws + WS_MIXED); u16* X1H = (u16*)(ws + WS_X1H); u16* Q = (u16*)(ws + WS_Q);

  k_rms_x<<<S_, 256, 0, stream>>>(x, norm_attn, XN);
  k_transpose<false><<<dim3(6656 / 32, 1024 / 32), 256, 0, stream>>>(w_in, WINT, 1024, 6656, nullptr);
  k_transpose<false><<<dim3(1024 / 32, 1024 / 32), 256, 0, stream>>>(w_bra, WBRAT, 1024, 1024, nullptr);
  k_transpose<false><<<dim3(1024 / 32, 512 / 32), 256, 0, stream>>>(w_brb, WBRBT, 512, 1024, nullptr);
  k_transpose<false><<<dim3(1024 / 32, 1024 / 32), 256, 0, stream>>>(w_out, WOUTT, 1024, 1024, nullptr);
  k_transpose<true><<<dim3(2048 / 32, 1024 / 32), 256, 0, stream>>>(w_q, WQT, 1024, 2048, norm_ffn);
  k_conv_bf16<<<64, 256, 0, stream>>>(sk1, K1, 16384);
  k_conv_bf16<<<64, 256, 0, stream>>>(sk2, K2, 16384);
  k_rope_table<<<S_ * 32 / 256, 256, 0, stream>>>(RC, RS);
  { EpiInProj e{RQ, RK, RV, RG, SQ, SK, SV, GA, GB};
    k_gemm_naive<false, EpiInProj><<<dim3(6656 / 64, S_ / 64), 256, 0, stream>>>(XN, WINT, S_, 6656, 1024, e); }
  k_qknorm<<<S_ * 8 / 256, 256, 0, stream>>>(RQ, ret_q_norm, RC, RS, 0);
  k_qknorm<<<S_ * 8 / 256, 256, 0, stream>>>(RK, ret_k_norm, RC, RS, 1);
  k_qknorm<<<S_ * 8 / 256, 256, 0, stream>>>(SQ, sb_q_norm, RC, RS, 2);
  k_qknorm<<<S_ * 8 / 256, 256, 0, stream>>>(SK, sb_k_norm, RC, RS, 3);
  { RetConst rc; for (int h = 0; h < 8; ++h) rc.l2g[h] = (float)log2(1.0 - exp2(-5.0 - (double)h));
    k_ret_naive<<<dim3(S_ / 64, 8), 256, 0, stream>>>(RQ, RK, RV, RG, ret_gn, rc); }
  k_sb_naive<<<dim3(S_ / 64, 8), 256, 0, stream>>>(SQ, SK, SV, SB);
  k_conv_table<<<S_ * D_ / 4 / 256, 256, 0, stream>>>(peer_u, U16, norm_ffn);
  k_conv_table<<<S_ * D_ / 4 / 256, 256, 0, stream>>>(peer_v, V16, nullptr);
  { EpiMixB e{MIXED, GB}; k_gemm_naive<false, EpiMixB><<<dim3(1024 / 64, S_ / 64), 256, 0, stream>>>(SB, WBRBT, S_, 1024, 512, e); }
  { EpiMixA e{MIXED, GA}; k_gemm_naive<false, EpiMixA><<<dim3(1024 / 64, S_ / 64), 256, 0, stream>>>(RG, WBRAT, S_, 1024, 1024, e); }
  { EpiOut e{x, out, X1H}; k_gemm_naive<false, EpiOut><<<dim3(1024 / 64, S_ / 64), 256, 0, stream>>>(MIXED, WOUTT, S_, 1024, 1024, e); }
  k_rowssq<<<S_, 256, 0, stream>>>(out, SSQ);
  { EpiQ e{SSQ, Q}; k_gemm_naive<true, EpiQ><<<dim3(2048 / 64, S_ / 64), 256, 0, stream>>>(X1H, WQT, S_, 2048, 1024, e); }
  k_select_naive<<<S_ * 8 / 64, 64, 0, stream>>>(Q, K1, K2, IDX, GW);
  k_gather_naive<<<S_, 256, 0, stream>>>(X1H, SSQ, IDX, GW, U16, V16, out);
}
```

```cpp
#include <hip/hip_runtime.h>
#include <stdint.h>

typedef unsigned short u16;
#define S_ 16384
#define D_ 1024
#define MB_ ((size_t)1 << 20)

#define WS_WOUTT (1 * MB_)
#define WS_WQT (3 * MB_)
#define WS_K1 (7 * MB_)
#define WS_K2 (7 * MB_ + 65536)
#define WS_ROPE_C (8 * MB_)
#define WS_ROPE_S (10 * MB_)
#define WS_SSQ (12 * MB_)
#define WS_RQ (16 * MB_)
#define WS_RK (32 * MB_)
#define WS_RV (48 * MB_)
#define WS_SQ (80 * MB_)
#define WS_SK (96 * MB_)
#define WS_SV (112 * MB_)
#define WS_RG (128 * MB_)
#define WS_GA (160 * MB_)
#define WS_GB (192 * MB_)
#define WS_IDX (224 * MB_)
#define WS_G (232 * MB_)
#define WS_NEED (248 * MB_)
#define WS_U16 WS_RQ
#define WS_V16 WS_RV
#define WS_MIXED WS_SQ
#define WS_X1H WS_RG
#define WS_Q WS_GA
#define DO_XN (0 * MB_)
#define DO_WINT (32 * MB_)
#define DO_SB (32 * MB_)
#define DO_WBRAT (60 * MB_)
#define DO_WBRBT (62 * MB_)

__device__ __forceinline__ u16 f2bf(float f) { unsigned u = __float_as_uint(f); u += 0x7FFFu + ((u >> 16) & 1u); return (u16)(u >> 16); }
__device__ __forceinline__ float bf2f(u16 b) { return __uint_as_float(((unsigned)b) << 16); }
__device__ __forceinline__ u16 f2h(float f) { _Float16 h = (_Float16)f; return *(u16*)&h; }
__device__ __forceinline__ float h2f(u16 b) { _Float16 h = *(_Float16*)&b; return (float)h; }
template <bool F16> __device__ __forceinline__ float ld16(const u16* p) { return F16 ? h2f(*p) : bf2f(*p); }
__device__ __forceinline__ float sigmoidf_(float x) { return 1.0f / (1.0f + __expf(-x)); }

__global__ void k_rms_x(const float* __restrict__ x, const float* __restrict__ g, u16* __restrict__ xn) {
  __shared__ float red[4];
  const int t = blockIdx.x, tid = threadIdx.x;
  const float4 v = ((const float4*)(x + (size_t)t * D_))[tid];
  float s = v.x * v.x + v.y * v.y + v.z * v.z + v.w * v.w;
  for (int o = 32; o > 0; o >>= 1) s += __shfl_xor(s, o);
  if ((tid & 63) == 0) red[tid >> 6] = s;
  __syncthreads();
  s = red[0] + red[1] + red[2] + red[3];
  const float r = rsqrtf(s * (1.0f / D_) + 1e-6f);
  const float4 gg = ((const float4*)g)[tid];
  u16* o = xn + (size_t)t * D_ + tid * 4;
  o[0] = f2bf(v.x * r * gg.x); o[1] = f2bf(v.y * r * gg.y); o[2] = f2bf(v.z * r * gg.z); o[3] = f2bf(v.w * r * gg.w);
}

template <bool F16> __global__ void k_transpose(const float* __restrict__ W, u16* __restrict__ Wt, int K, int N, const float* __restrict__ scale) {
  __shared__ float tile[32][33];
  const int k0 = blockIdx.y * 32, n0 = blockIdx.x * 32, tx = threadIdx.x & 31, ty = threadIdx.x >> 5;
  for (int i = ty; i < 32; i += 8) { const int k = k0 + i; tile[i][tx] = W[(size_t)k * N + n0 + tx] * (scale ? scale[k] : 1.0f); }
  __syncthreads();
  for (int i = ty; i < 32; i += 8) { const float v = tile[tx][i]; Wt[(size_t)(n0 + i) * K + k0 + tx] = F16 ? f2h(v) : f2bf(v); }
}
__global__ void k_conv_bf16(const float* __restrict__ a, u16* __restrict__ o, int n) { const int i = blockIdx.x * blockDim.x + threadIdx.x; if (i < n) o[i] = f2bf(a[i]); }
__global__ void k_conv_table(const float* __restrict__ a, u16* __restrict__ o, const float* __restrict__ colscale) {
  const size_t i = ((size_t)blockIdx.x * blockDim.x + threadIdx.x) * 4;
  const float4 v = *(const float4*)(a + i);
  float4 s = make_float4(1.f, 1.f, 1.f, 1.f);
  if (colscale) s = *(const float4*)(colscale + (i & (D_ - 1)));
  o[i] = f2h(v.x * s.x); o[i + 1] = f2h(v.y * s.y); o[i + 2] = f2h(v.z * s.z); o[i + 3] = f2h(v.w * s.w);
}
__global__ void k_rope_table(float* __restrict__ c, float* __restrict__ s) {
  const int i = blockIdx.x * blockDim.x + threadIdx.x;
  const int t = i >> 5, f = i & 31;
  const float freq = powf(10000.0f, -(float)f / 32.0f);
  const float ang = (float)t * freq;
  float sn, cs; sincosf(ang, &sn, &cs);
  c[i] = cs; s[i] = sn;
}

template <bool F16, class Epi> __global__ void __launch_bounds__(256) k_gemm_naive(const u16* __restrict__ A, const u16* __restrict__ Bt, int M, int N, int K, Epi E) {
  __shared__ float As[64][33], Bs[64][33];
  const int tid = threadIdx.x, tx = tid & 15, ty = tid >> 4, m0 = blockIdx.y * 64, n0 = blockIdx.x * 64;
  float acc[4][4];
#pragma unroll
  for (int i = 0; i < 4; ++i)
#pragma unroll
    for (int j = 0; j < 4; ++j) acc[i][j] = 0.f;
  const int lr = tid >> 2, lc = (tid & 3) * 8;
  for (int k0 = 0; k0 < K; k0 += 32) {
    const u16* ap = A + (size_t)(m0 + lr) * K + k0 + lc; const u16* bp = Bt + (size_t)(n0 + lr) * K + k0 + lc;
#pragma unroll
    for (int j = 0; j < 8; ++j) { As[lr][lc + j] = ld16<F16>(ap + j); Bs[lr][lc + j] = ld16<F16>(bp + j); }
    __syncthreads();
#pragma unroll 8
    for (int k = 0; k < 32; ++k) {
      float a[4], b[4];
#pragma unroll
      for (int i = 0; i < 4; ++i) { a[i] = As[ty * 4 + i][k]; b[i] = Bs[tx * 4 + i][k]; }
#pragma unroll
      for (int i = 0; i < 4; ++i)
#pragma unroll
        for (int j = 0; j < 4; ++j) acc[i][j] += a[i] * b[j];
    }
    __syncthreads();
  }
#pragma unroll
  for (int i = 0; i < 4; ++i)
#pragma unroll
    for (int j = 0; j < 4; ++j) E(m0 + ty * 4 + i, n0 + tx * 4 + j, acc[i][j]);
}
struct EpiInProj {
  u16 *rq, *rk, *rv, *rg, *sq, *sk, *sv, *ga, *gb;
  __device__ void operator()(int r, int c, float v) const {
    u16* b; int ld, c0;
    if (c < 512) { b = rq; ld = 512; c0 = 0; } else if (c < 1024) { b = rk; ld = 512; c0 = 512; } else if (c < 2048) { b = rv; ld = 1024; c0 = 1024; }
    else if (c < 3072) { b = rg; ld = 1024; c0 = 2048; } else if (c < 3584) { b = sq; ld = 512; c0 = 3072; } else if (c < 4096) { b = sk; ld = 512; c0 = 3584; }
    else if (c < 4608) { b = sv; ld = 512; c0 = 4096; } else if (c < 5632) { b = ga; ld = 1024; c0 = 4608; } else { b = gb; ld = 1024; c0 = 5632; }
    b[(size_t)r * ld + (c - c0)] = f2bf(v);
  }
};
struct EpiMixB { u16* mixed; const u16* gb; __device__ void operator()(int r, int c, float v) const { const size_t i = (size_t)r * D_ + c; mixed[i] = f2bf(sigmoidf_(bf2f(gb[i])) * v); } };
struct EpiMixA { u16* mixed; const u16* ga; __device__ void operator()(int r, int c, float v) const { const size_t i = (size_t)r * D_ + c; mixed[i] = f2bf(bf2f(mixed[i]) + sigmoidf_(bf2f(ga[i])) * v); } };
struct EpiOut { const float* x; float* x1; u16* x1h; __device__ void operator()(int r, int c, float v) const { const size_t i = (size_t)r * D_ + c; const float o = x[i] + v; x1[i] = o; x1h[i] = f2h(o); } };
struct EpiQ { const float* ssq; u16* q; __device__ void operator()(int r, int c, float v) const { const float rstd = rsqrtf(ssq[r] * (1.0f / D_) + 1e-6f); q[(size_t)r * 2048 + c] = f2bf(v * rstd); } };

__global__ void k_rowssq(const float* __restrict__ x1, float* __restrict__ ssq) {
  __shared__ float red[4];
  const int t = blockIdx.x, tid = threadIdx.x;
  const float4 v = ((const float4*)(x1 + (size_t)t * D_))[tid];
  float s = v.x * v.x + v.y * v.y + v.z * v.z + v.w * v.w;
  for (int o = 32; o > 0; o >>= 1) s += __shfl_xor(s, o);
  if ((tid & 63) == 0) red[tid >> 6] = s;
  __syncthreads();
  if (tid == 0) ssq[t] = red[0] + red[1] + red[2] + red[3];
}

__global__ void k_qknorm(u16* __restrict__ buf, const float* __restrict__ gain, const float* __restrict__ rc, const float* __restrict__ rs, int which) {
  const int i = blockIdx.x * blockDim.x + threadIdx.x;
  const int t = i >> 3, h = i & 7;
  u16* p = buf + (size_t)t * 512 + h * 64;
  float v[64]; float ss = 0.f;
#pragma unroll
  for (int d = 0; d < 64; ++d) { v[d] = bf2f(p[d]); ss += v[d] * v[d]; }
  const float r = rsqrtf(ss * (1.0f / 64.0f) + 1e-6f);
#pragma unroll
  for (int d = 0; d < 64; ++d) v[d] = v[d] * r * gain[d];
  if (which < 2) {
    const float sc = which == 1 ? 0.125f : 1.0f;
#pragma unroll
    for (int d = 0; d < 32; ++d) {
      const float c = rc[t * 32 + d], s = rs[t * 32 + d];
      const float a = v[d], b = v[d + 32];
      v[d] = (a * c - b * s) * sc; v[d + 32] = (a * s + b * c) * sc;
    }
  }
#pragma unroll
  for (int d = 0; d < 64; ++d) p[d] = f2bf(v[d]);
}

struct RetConst { float l2g[8]; };
__global__ void __launch_bounds__(256) k_ret_naive(const u16* __restrict__ rq, const u16* __restrict__ rk, const u16* __restrict__ rv, u16* __restrict__ rg,
                                                   const float* __restrict__ gn, RetConst rc) {
  __shared__ float red[64][4][2];
  const int h = blockIdx.y, t0 = blockIdx.x * 64, tid = threadIdx.x, tl = tid & 63, eq = tid >> 6, t = t0 + tl;
  float q[64], acc[32];
#pragma unroll
  for (int d = 0; d < 64; ++d) q[d] = bf2f(rq[(size_t)t * 512 + h * 64 + d]);
#pragma unroll
  for (int e = 0; e < 32; ++e) acc[e] = 0.f;
  const float l2g = rc.l2g[h];
  for (int s = 0; s <= t0 + 63; ++s) {
    const u16* kp = rk + (size_t)s * 512 + h * 64;
    float sc = 0.f;
#pragma unroll
    for (int d = 0; d < 64; ++d) sc += q[d] * bf2f(kp[d]);
    const float w = (s <= t) ? sc * exp2f((float)(t - s) * l2g) : 0.f;
    const u16* vp = rv + (size_t)s * 1024 + h * 128 + eq * 32;
#pragma unroll
    for (int e = 0; e < 32; ++e) acc[e] += w * bf2f(vp[e]);
  }
  float s1 = 0.f;
#pragma unroll
  for (int e = 0; e < 32; ++e) s1 += acc[e];
  red[tl][eq][0] = s1;
  __syncthreads();
  const float mu = (red[tl][0][0] + red[tl][1][0] + red[tl][2][0] + red[tl][3][0]) * (1.0f / 128.0f);
  float s2 = 0.f;
#pragma unroll
  for (int e = 0; e < 32; ++e) { const float d = acc[e] - mu; s2 += d * d; }
  red[tl][eq][1] = s2;
  __syncthreads();
  const float var = (red[tl][0][1] + red[tl][1][1] + red[tl][2][1] + red[tl][3][1]) * (1.0f / 128.0f);
  const float rstd = rsqrtf(var + 1e-6f);
  u16* gp = rg + (size_t)t * 1024 + h * 128 + eq * 32;
#pragma unroll
  for (int e = 0; e < 32; ++e) {
    const float g = bf2f(gp[e]);
    const float y = (acc[e] - mu) * rstd * gn[h * 128 + eq * 32 + e];
    gp[e] = f2bf(y * g * sigmoidf_(g));
  }
}

__global__ void __launch_bounds__(256) k_sb_naive(const u16* __restrict__ sq, const u16* __restrict__ sk, const u16* __restrict__ sv, u16* __restrict__ sb) {
  const int h = blockIdx.y, t0 = blockIdx.x * 64, tid = threadIdx.x, tl = tid & 63, eq = tid >> 6, t = t0 + tl;
  float q[64], acc[16];
#pragma unroll
  for (int d = 0; d < 64; ++d) q[d] = bf2f(sq[(size_t)t * 512 + h * 64 + d]);
#pragma unroll
  for (int e = 0; e < 16; ++e) acc[e] = 0.f;
  float later = 0.f;
  for (int s = t0 + 62; s >= 0; --s) {
    if (s < t0 && __all(later < -104.0f)) break;
    const u16* kp = sk + (size_t)s * 512 + h * 64;
    float z = 0.f;
#pragma unroll
    for (int d = 0; d < 64; ++d) z += q[d] * bf2f(kp[d]);
    z *= 0.125f;
    if (s < t) {
      const float sp = fmaxf(z, 0.f) + log1pf(__expf(-fabsf(z)));
      const float w = __expf((z - sp) + later);
      const u16* vp = sv + (size_t)s * 512 + h * 64 + eq * 16;
#pragma unroll
      for (int e = 0; e < 16; ++e) acc[e] += w * bf2f(vp[e]);
      later -= sp;
    }
  }
  u16* op = sb + (size_t)t * 512 + h * 64 + eq * 16;
#pragma unroll
  for (int e = 0; e < 16; ++e) op[e] = f2bf(acc[e]);
}

#define INS16(V, I, x, id) do { float _x = (x); int _i = (id); \
  _Pragma("unroll") for (int _j = 15; _j >= 1; --_j) { const bool _a = _x > V[_j - 1], _b = _x > V[_j]; \
    const float nv = _a ? V[_j - 1] : (_b ? _x : V[_j]); const int ni = _a ? I[_j - 1] : (_b ? _i : I[_j]); V[_j] = nv; I[_j] = ni; } \
  if (_x > V[0]) { V[0] = _x; I[0] = _i; } } while (0)
__global__ void __launch_bounds__(64) k_select_naive(const u16* __restrict__ q, const u16* __restrict__ k1, const u16* __restrict__ k2, u16* __restrict__ idx, float* __restrict__ gw) {
  __shared__ u16 ks[2][128 * 128];
  for (int i = threadIdx.x; i < 128 * 128; i += 64) { ks[0][i] = k1[i]; ks[1][i] = k2[i]; }
  __syncthreads();
  const int i = blockIdx.x * 64 + threadIdx.x, t = i >> 3, h = i & 7;
  float v1[16], v2[16]; int i1[16], i2[16];
#pragma unroll
  for (int j = 0; j < 16; ++j) { v1[j] = -3.0e38f; v2[j] = -3.0e38f; i1[j] = 0; i2[j] = 0; }
  const u16* qp = q + (size_t)t * 2048 + h * 256;
  for (int n = 0; n < 128; ++n) {
    float s = 0.f;
    for (int d = 0; d < 128; ++d) s += bf2f(qp[d]) * bf2f(ks[0][n * 128 + d]);
    INS16(v1, i1, s, n);
  }
  for (int n = 0; n < 128; ++n) {
    float s = 0.f;
    for (int d = 0; d < 128; ++d) s += bf2f(qp[128 + d]) * bf2f(ks[1][n * 128 + d]);
    INS16(v2, i2, s, n);
  }
  float tv[16]; int ti[16];
#pragma unroll
  for (int j = 0; j < 16; ++j) { tv[j] = -3.0e38f; ti[j] = 0; }
#pragma unroll
  for (int a = 0; a < 16; ++a)
#pragma unroll
    for (int b = 0; b < 16; ++b)
      if ((a + 1) * (b + 1) <= 16) INS16(tv, ti, v1[a] + v2[b], i1[a] * 128 + i2[b]);
  float sum = 0.f, e[16];
#pragma unroll
  for (int j = 0; j < 16; ++j) { e[j] = __expf(tv[j] - tv[0]); sum += e[j]; }
  const float inv = 1.0f / sum;
#pragma unroll
  for (int j = 0; j < 16; ++j) { idx[(size_t)t * 128 + h * 16 + j] = (u16)ti[j]; gw[(size_t)t * 128 + h * 16 + j] = e[j] * inv; }
}

__device__ __forceinline__ float gelu_tanh(float x) { const float u = 0.7978845608028654f * (x + 0.044715f * x * x * x); return 0.5f * x * (1.0f + tanhf(u)); }
__global__ void __launch_bounds__(256) k_gather_naive(const u16* __restrict__ x1h, const float* __restrict__ ssq, const u16* __restrict__ idx, const float* __restrict__ gw,
                                                      const u16* __restrict__ u16t, const u16* __restrict__ v16t, float* __restrict__ out) {
  __shared__ float a_s[128]; __shared__ int e_s[128];
  const int t = blockIdx.x, tid = threadIdx.x, lane = tid & 63, w = tid >> 6;
  if (tid < 128) e_s[tid] = idx[(size_t)t * 128 + tid];
  __syncthreads();
  float xr[16];
#pragma unroll
  for (int j = 0; j < 16; ++j) xr[j] = h2f(x1h[(size_t)t * D_ + lane * 16 + j]);
  const float rstd = rsqrtf(ssq[t] * (1.0f / D_) + 1e-6f);
  for (int p = w; p < 128; p += 4) {
    const u16* up = u16t + (size_t)e_s[p] * D_ + lane * 16;
    float s = 0.f;
#pragma unroll
    for (int j = 0; j < 16; ++j) s += xr[j] * h2f(up[j]);
    for (int o = 32; o > 0; o >>= 1) s += __shfl_xor(s, o);
    if (lane == 0) a_s[p] = gelu_tanh(s * rstd) * gw[(size_t)t * 128 + p];
  }
  __syncthreads();
  float acc[4] = {0.f, 0.f, 0.f, 0.f};
  for (int p = 0; p < 128; ++p) {
    const u16* vp = v16t + (size_t)e_s[p] * D_ + tid * 4;
    const float a = a_s[p];
#pragma unroll
    for (int j = 0; j < 4; ++j) acc[j] += a * h2f(vp[j]);
  }
  float* op = out + (size_t)t * D_ + tid * 4;
#pragma unroll
  for (int j = 0; j < 4; ++j) op[j] += acc[j];
}


namespace pg8 {
#define PG8_LAS __attribute__((address_space(3)))
typedef short bf16x8 __attribute__((ext_vector_type(8)));
typedef _Float16 f16x8 __attribute__((ext_vector_type(8)));
typedef float f32x4 __attribute__((ext_vector_type(4)));
typedef unsigned u32x4 __attribute__((ext_vector_type(4)));
constexpr int BM = 256, BK = 64, HALF = 128, HTB = HALF * BK * 2, STAGE_BYTES = 8 * HTB, NXCD = 8, WGM = 8;
__host__ __device__ __forceinline__ int lds_byte(int r, int c) { const int st = (r >> 4) * 2 + (c >> 5), rr = r & 15, cc = c & 31, ob = rr * 64 + cc * 2; return st * 1024 + (ob ^ (((ob >> 9) & 1) << 5)); }
__host__ __device__ __forceinline__ void stage_rc(int b, int& R, int& C) { const int st = b / 1024, sb = b % 1024, swz = sb ^ (((sb >> 9) & 1) << 5); R = (st >> 1) * 16 + swz / 64; C = (st & 1) * 32 + (swz % 64) / 2; }
__host__ __device__ __forceinline__ int perm32(int rho) { const int n = rho >> 4, i = rho & 15; return 8 * (i >> 2) + 4 * n + (i & 3); }
struct Unit { int pm, pn; };
struct Gemm { const u16* A; const u16* Bt; int M, N, K, pad; };
struct StaticOrder {
  int nM, nN, nwg, G, c;
  __host__ __device__ void init(int M, int N, int G_, int c_) { nM = M / BM; nN = N / BM; nwg = nM * nN; G = G_; c = c_; }
  __host__ __device__ bool next(int i, Unit& u) const {
    const long L = (long)i * G + c; if (L >= nwg) return false;
    int wgid = (int)L; { const int q = nwg / NXCD, r = nwg % NXCD, xcd = wgid % NXCD, off = wgid / NXCD; wgid = (xcd < r ? xcd * (q + 1) : r * (q + 1) + (xcd - r) * q) + off; }
    const int nig = WGM * nN, gid = wgid / nig, fm = gid * WGM, gsz = (nM - fm) < WGM ? (nM - fm) : WGM;
    u.pm = fm + ((wgid % nig) % gsz); u.pn = (wgid % nig) / gsz; return true;
  }
};
__device__ __forceinline__ unsigned cvt_pk_bf16(float lo, float hi) { unsigned r; asm volatile("v_cvt_pk_bf16_f32 %0, %1, %2" : "=v"(r) : "v"(lo), "v"(hi)); return r; }
__device__ __forceinline__ unsigned cvt_pk_f16(float lo, float hi) { typedef _Float16 h2 __attribute__((ext_vector_type(2))); h2 v; v.x = (_Float16)lo; v.y = (_Float16)hi; return __builtin_bit_cast(unsigned, v); }

template <bool F16, class Epi>
__device__ __forceinline__ void gemm_phase(PG8_LAS unsigned char* lds, const Gemm g, const StaticOrder& S, const Epi& E) {
  const int tid = threadIdx.x, wid = __builtin_amdgcn_readfirstlane(tid >> 6), lane = tid & 63, wr = wid >> 2, wc = wid & 3, fr = lane & 15, fq = lane >> 4;
  const int K = g.K, nt = K / BK;
  unsigned voffA[2], voffB[2];
#pragma unroll
  for (int i = 0; i < 2; ++i) { int R, C; stage_rc(tid * 16 + i * 8192, R, C); const int Rb = ((R & ~31) + perm32(R & 31));
    voffA[i] = (unsigned)(R * K + C) * 2u; voffB[i] = (unsigned)(Rb * K + C) * 2u; }
  const size_t kstep = (size_t)(BK * 2);
  const size_t hstep = (size_t)HALF * K * 2;
  const size_t tstep = 2 * hstep;
  const unsigned ldsw = (unsigned)wid * 1024u;
  const int aoff = lds_byte(wr * 64 + fr, fq * 8), boff = lds_byte(wc * 32 + fr, fq * 8);
#define PG8_SA(b, h) (((b) * 2 + (h)) * HTB)
#define PG8_SB(b, h) ((4 + (b) * 2 + (h)) * HTB)
#define PG8_STAGE(bufoff, gbase, voff) do { _Pragma("unroll") for (int _i = 0; _i < 2; ++_i) \
    __builtin_amdgcn_global_load_lds((const unsigned*)((const char*)(gbase) + (voff)[_i]), (PG8_LAS unsigned*)(lds + (bufoff) + ldsw + _i * 8192), 16, 0, 0); } while (0)
#define PG8_LDA(dst, b, h) do { _Pragma("unroll") for (int m = 0; m < 4; ++m) _Pragma("unroll") for (int k = 0; k < 2; ++k) dst[m][k] = *(const PG8_LAS bf16x8*)(lds + PG8_SA(b, h) + aoff + m * 2048 + k * 1024); } while (0)
#define PG8_LDB(dst, b, h) do { _Pragma("unroll") for (int n = 0; n < 2; ++n) _Pragma("unroll") for (int k = 0; k < 2; ++k) dst[n][k] = *(const PG8_LAS bf16x8*)(lds + PG8_SB(b, h) + boff + n * 2048 + k * 1024); } while (0)
#define PG8_MMA(ai, bj, At, Bt) do { __builtin_amdgcn_s_setprio(1); _Pragma("unroll") for (int m = 0; m < 4; ++m) _Pragma("unroll") for (int n = 0; n < 2; ++n) _Pragma("unroll") for (int k = 0; k < 2; ++k) { \
    if constexpr (F16) acc[ai][bj][m][n] = __builtin_amdgcn_mfma_f32_16x16x32_f16(__builtin_bit_cast(f16x8, Bt[n][k]), __builtin_bit_cast(f16x8, At[m][k]), acc[ai][bj][m][n], 0, 0, 0); \
    else acc[ai][bj][m][n] = __builtin_amdgcn_mfma_f32_16x16x32_bf16(Bt[n][k], At[m][k], acc[ai][bj][m][n], 0, 0, 0); } __builtin_amdgcn_s_setprio(0); } while (0)
#define PG8_WAIT_V(n) asm volatile("s_waitcnt vmcnt(" #n ")" ::: "memory")
#define PG8_WAIT_L(n) asm volatile("s_waitcnt lgkmcnt(" #n ")" ::: "memory")
#define PG8_BAR __builtin_amdgcn_s_barrier()
#define PG8_SCHED __builtin_amdgcn_sched_barrier(0)
  Unit cur, nxt; int ui = 0;
  if (!S.next(0, cur)) return;
  f32x4 acc[2][2][4][2];
#pragma unroll
  for (int a = 0; a < 2; ++a)
#pragma unroll
    for (int b = 0; b < 2; ++b)
#pragma unroll
      for (int m = 0; m < 4; ++m)
#pragma unroll
        for (int n = 0; n < 2; ++n) acc[a][b][m][n] = (f32x4){0.f, 0.f, 0.f, 0.f};
  bf16x8 At[4][2], B0[2][2], B1[2][2];
  const char* cA = (const char*)g.A + (size_t)cur.pm * tstep; const char* cB = (const char*)g.Bt + (size_t)cur.pn * tstep;
  PG8_STAGE(PG8_SB(0, 0), cB, voffB); PG8_STAGE(PG8_SA(0, 0), cA, voffA); PG8_STAGE(PG8_SB(0, 1), cB + hstep, voffB); PG8_STAGE(PG8_SA(0, 1), cA + hstep, voffA);
  if (wr == 1) PG8_BAR;
  PG8_WAIT_V(4); PG8_BAR;
  PG8_STAGE(PG8_SB(1, 0), cB + kstep, voffB); PG8_STAGE(PG8_SA(1, 0), cA + kstep, voffA); PG8_STAGE(PG8_SB(1, 1), cB + hstep + kstep, voffB);
  PG8_WAIT_V(6); PG8_BAR;
  for (;;) {
    const bool has_next = S.next(ui + 1, nxt);
    const char* nA = has_next ? (const char*)g.A + (size_t)nxt.pm * tstep : cA; const char* nB = has_next ? (const char*)g.Bt + (size_t)nxt.pn * tstep : cB;
    for (int t = 0; t < nt; t += 2) {
      const bool last = (t == nt - 2);
      const char* a1 = cA + (size_t)(t + 1) * kstep;
      const char* a2 = last ? nA : cA + (size_t)(t + 2) * kstep; const char* b2 = last ? nB : cB + (size_t)(t + 2) * kstep;
      const char* a3 = a2 + kstep; const char* b3 = b2 + kstep;
      PG8_LDB(B0, 0, 0); PG8_SCHED; PG8_LDA(At, 0, 0); PG8_STAGE(PG8_SA(1, 1), a1 + hstep, voffA);
      PG8_WAIT_L(8); PG8_BAR; PG8_WAIT_L(0); PG8_MMA(0, 0, At, B0); PG8_BAR; PG8_SCHED;
      PG8_LDB(B1, 0, 1); PG8_STAGE(PG8_SB(0, 0), b2, voffB);
      PG8_BAR; PG8_WAIT_L(0); PG8_MMA(0, 1, At, B1); PG8_BAR;
      PG8_LDA(At, 0, 1); PG8_STAGE(PG8_SA(0, 0), a2, voffA);
      PG8_BAR; PG8_WAIT_L(0); PG8_MMA(1, 0, At, B0); PG8_BAR; PG8_SCHED;
      PG8_STAGE(PG8_SB(0, 1), b2 + hstep, voffB);
      PG8_WAIT_V(6); PG8_BAR; PG8_MMA(1, 1, At, B1); PG8_BAR;
      PG8_LDB(B0, 1, 0); PG8_SCHED; PG8_LDA(At, 1, 0); PG8_STAGE(PG8_SA(0, 1), a2 + hstep, voffA);
      PG8_WAIT_L(8); PG8_BAR; PG8_WAIT_L(0); PG8_MMA(0, 0, At, B0); PG8_BAR; PG8_SCHED;
      PG8_LDB(B1, 1, 1); PG8_STAGE(PG8_SB(1, 0), b3, voffB);
      PG8_BAR; PG8_WAIT_L(0); PG8_MMA(0, 1, At, B1); PG8_BAR;
      PG8_LDA(At, 1, 1); PG8_STAGE(PG8_SA(1, 0), a3, voffA);
      PG8_BAR; PG8_WAIT_L(0); PG8_MMA(1, 0, At, B0); PG8_BAR; PG8_SCHED;
      PG8_STAGE(PG8_SB(1, 1), b3 + hstep, voffB);
      PG8_WAIT_V(6); PG8_BAR; PG8_MMA(1, 1, At, B1); PG8_BAR;
    }
    E(acc, cur, wr, wc, fr, fq);
    if (!has_next) break;
#pragma unroll
    for (int a = 0; a < 2; ++a)
#pragma unroll
      for (int b = 0; b < 2; ++b)
#pragma unroll
        for (int m = 0; m < 4; ++m)
#pragma unroll
          for (int n = 0; n < 2; ++n) acc[a][b][m][n] = (f32x4){0.f, 0.f, 0.f, 0.f};
    cur = nxt; cA = nA; cB = nB; ++ui;
  }
  PG8_WAIT_V(0);
  if (wr == 0) PG8_BAR;
  PG8_BAR;
#undef PG8_SA
#undef PG8_SB
#undef PG8_STAGE
#undef PG8_LDA
#undef PG8_LDB
#undef PG8_MMA
#undef PG8_WAIT_V
#undef PG8_WAIT_L
#undef PG8_BAR
#undef PG8_SCHED
}
}

typedef pg8::f32x4 f32x4; typedef pg8::u32x4 u32x4;
template <class F> __device__ __forceinline__ void epi_walk(const f32x4 (&acc)[2][2][4][2], const pg8::Unit& u, int wr, int wc, int fr, int fq, F&& f) {
  const int row0 = u.pm * 256 + wr * 64 + fr, col0 = u.pn * 256 + wc * 32 + 8 * fq;
#pragma unroll
  for (int ai = 0; ai < 2; ++ai)
#pragma unroll
    for (int m = 0; m < 4; ++m)
#pragma unroll
      for (int bj = 0; bj < 2; ++bj) f(row0 + ai * 128 + m * 16, col0 + bj * 128, acc[ai][bj][m][0], acc[ai][bj][m][1]);
}
__device__ __forceinline__ u32x4 pack8_bf16(f32x4 v0, f32x4 v1) { u32x4 w; w.x = pg8::cvt_pk_bf16(v0[0], v0[1]); w.y = pg8::cvt_pk_bf16(v0[2], v0[3]); w.z = pg8::cvt_pk_bf16(v1[0], v1[1]); w.w = pg8::cvt_pk_bf16(v1[2], v1[3]); return w; }
__device__ __forceinline__ u32x4 pack8_f16(f32x4 v0, f32x4 v1) { u32x4 w; w.x = pg8::cvt_pk_f16(v0[0], v0[1]); w.y = pg8::cvt_pk_f16(v0[2], v0[3]); w.z = pg8::cvt_pk_f16(v1[0], v1[1]); w.w = pg8::cvt_pk_f16(v1[2], v1[3]); return w; }
__device__ __forceinline__ void unpack8_bf16(u32x4 w, float (&f)[8]) {
  f[0] = __uint_as_float(w.x << 16); f[1] = __uint_as_float(w.x & 0xffff0000u); f[2] = __uint_as_float(w.y << 16); f[3] = __uint_as_float(w.y & 0xffff0000u);
  f[4] = __uint_as_float(w.z << 16); f[5] = __uint_as_float(w.z & 0xffff0000u); f[6] = __uint_as_float(w.w << 16); f[7] = __uint_as_float(w.w & 0xffff0000u); }

struct FEpiInProj {
  u16 *rq, *rk, *rv, *rg, *sq, *sk, *sv, *ga, *gb;
  __device__ __forceinline__ void operator()(const f32x4 (&acc)[2][2][4][2], const pg8::Unit& u, int wr, int wc, int fr, int fq) const {
    const int c = u.pn * 256; u16* b; int ld, c0;
    if (c < 512) { b = rq; ld = 512; c0 = 0; } else if (c < 1024) { b = rk; ld = 512; c0 = 512; } else if (c < 2048) { b = rv; ld = 1024; c0 = 1024; }
    else if (c < 3072) { b = rg; ld = 1024; c0 = 2048; } else if (c < 3584) { b = sq; ld = 512; c0 = 3072; } else if (c < 4096) { b = sk; ld = 512; c0 = 3584; }
    else if (c < 4608) { b = sv; ld = 512; c0 = 4096; } else if (c < 5632) { b = ga; ld = 1024; c0 = 4608; } else { b = gb; ld = 1024; c0 = 5632; }
    epi_walk(acc, u, wr, wc, fr, fq, [&](int row, int col, f32x4 v0, f32x4 v1) { *(u32x4*)(b + (size_t)row * ld + (col - c0)) = pack8_bf16(v0, v1); });
  }
};
struct FEpiMixB { u16* mixed; const u16* gb;
  __device__ __forceinline__ void operator()(const f32x4 (&acc)[2][2][4][2], const pg8::Unit& u, int wr, int wc, int fr, int fq) const {
    epi_walk(acc, u, wr, wc, fr, fq, [&](int row, int col, f32x4 v0, f32x4 v1) { const size_t i = (size_t)row * D_ + col; float g[8]; unpack8_bf16(*(const u32x4*)(gb + i), g); f32x4 a, b2;
      a[0] = sigmoidf_(g[0]) * v0[0]; a[1] = sigmoidf_(g[1]) * v0[1]; a[2] = sigmoidf_(g[2]) * v0[2]; a[3] = sigmoidf_(g[3]) * v0[3];
      b2[0] = sigmoidf_(g[4]) * v1[0]; b2[1] = sigmoidf_(g[5]) * v1[1]; b2[2] = sigmoidf_(g[6]) * v1[2]; b2[3] = sigmoidf_(g[7]) * v1[3];
      *(u32x4*)(mixed + i) = pack8_bf16(a, b2); });
  }
};
struct FEpiMixA { u16* mixed; const u16* ga;
  __device__ __forceinline__ void operator()(const f32x4 (&acc)[2][2][4][2], const pg8::Unit& u, int wr, int wc, int fr, int fq) const {
    epi_walk(acc, u, wr, wc, fr, fq, [&](int row, int col, f32x4 v0, f32x4 v1) { const size_t i = (size_t)row * D_ + col; float g[8], o[8]; unpack8_bf16(*(const u32x4*)(ga + i), g); unpack8_bf16(*(const u32x4*)(mixed + i), o); f32x4 a, b2;
      a[0] = o[0] + sigmoidf_(g[0]) * v0[0]; a[1] = o[1] + sigmoidf_(g[1]) * v0[1]; a[2] = o[2] + sigmoidf_(g[2]) * v0[2]; a[3] = o[3] + sigmoidf_(g[3]) * v0[3];
      b2[0] = o[4] + sigmoidf_(g[4]) * v1[0]; b2[1] = o[5] + sigmoidf_(g[5]) * v1[1]; b2[2] = o[6] + sigmoidf_(g[6]) * v1[2]; b2[3] = o[7] + sigmoidf_(g[7]) * v1[3];
      *(u32x4*)(mixed + i) = pack8_bf16(a, b2); });
  }
};
struct FEpiOut { const float* x; float* x1; u16* x1h; float* ssq;
  __device__ __forceinline__ void operator()(const f32x4 (&acc)[2][2][4][2], const pg8::Unit& u, int wr, int wc, int fr, int fq) const {
    const int row0 = u.pm * 256 + wr * 64 + fr, col0 = u.pn * 256 + wc * 32 + 8 * fq;
#pragma unroll
    for (int ai = 0; ai < 2; ++ai)
#pragma unroll
      for (int m = 0; m < 4; ++m) {
        const int row = row0 + ai * 128 + m * 16; float ss = 0.f;
#pragma unroll
        for (int bj = 0; bj < 2; ++bj) {
          const size_t i = (size_t)row * D_ + col0 + bj * 128;
          f32x4 a = *(const f32x4*)(x + i) + acc[ai][bj][m][0], b2 = *(const f32x4*)(x + i + 4) + acc[ai][bj][m][1];
          *(f32x4*)(x1 + i) = a; *(f32x4*)(x1 + i + 4) = b2; *(u32x4*)(x1h + i) = pack8_f16(a, b2);
          ss += a[0] * a[0] + a[1] * a[1] + a[2] * a[2] + a[3] * a[3] + b2[0] * b2[0] + b2[1] * b2[1] + b2[2] * b2[2] + b2[3] * b2[3];
        }
        ss += __shfl_xor(ss, 16); ss += __shfl_xor(ss, 32);
        if (fq == 0) atomicAdd(ssq + row, ss);
      }
  }
};
struct FEpiQ { const float* ssq; u16* q;
  __device__ __forceinline__ void operator()(const f32x4 (&acc)[2][2][4][2], const pg8::Unit& u, int wr, int wc, int fr, int fq) const {
    epi_walk(acc, u, wr, wc, fr, fq, [&](int row, int col, f32x4 v0, f32x4 v1) { const float rstd = rsqrtf(ssq[row] * (1.0f / D_) + 1e-6f); *(u32x4*)(q + (size_t)row * 2048 + col) = pack8_bf16(v0 * rstd, v1 * rstd); });
  }
};
template <bool F16, class Epi> __global__ __launch_bounds__(512, 2) void k_gemm_fast(pg8::Gemm g, Epi E) {
  extern __shared__ __attribute__((aligned(16))) unsigned char shm[];
  pg8::StaticOrder S; S.init(g.M, g.N, (int)gridDim.x, (int)blockIdx.x);
  pg8::gemm_phase<F16, Epi>((PG8_LAS unsigned char*)shm, g, S, E);
}
template <bool F16, class Epi> static void launch_gemm(const u16* A, const u16* Bt, int M, int N, int K, const Epi& E, hipStream_t stream) {
  (void)hipFuncSetAttribute((const void*)k_gemm_fast<F16, Epi>, hipFuncAttributeMaxDynamicSharedMemorySize, pg8::STAGE_BYTES);
  pg8::Gemm g{A, Bt, M, N, K, 0};
  hipLaunchKernelGGL((k_gemm_fast<F16, Epi>), dim3(256), dim3(512), pg8::STAGE_BYTES, stream, g, E);
}

extern "C" void kernel_launch(void* const* d_in, const int* in_sizes, int n_in, void* d_out, int out_size, void* d_ws, size_t ws_size, hipStream_t stream) {
  if (ws_size < WS_NEED) return;
  const float* x = (const float*)d_in[0]; const float* norm_attn = (const float*)d_in[1]; const float* w_in = (const float*)d_in[2];
  const float* ret_q_norm = (const float*)d_in[3]; const float* ret_k_norm = (const float*)d_in[4]; const float* ret_gn = (const float*)d_in[5];
  const float* sb_q_norm = (const float*)d_in[6]; const float* sb_k_norm = (const float*)d_in[7]; const float* w_bra = (const float*)d_in[8];
  const float* w_brb = (const float*)d_in[9]; const float* w_out = (const float*)d_in[10]; const float* norm_ffn = (const float*)d_in[11];
  const float* w_q = (const float*)d_in[12]; const float* sk1 = (const float*)d_in[13]; const float* sk2 = (const float*)d_in[14];
  const float* peer_u = (const float*)d_in[15]; const float* peer_v = (const float*)d_in[16];
  char* ws = (char*)d_ws; char* dob = (char*)d_out; float* out = (float*)d_out;
  u16* XN = (u16*)(dob + DO_XN); u16* WINT = (u16*)(dob + DO_WINT); u16* SB = (u16*)(dob + DO_SB); u16* WBRAT = (u16*)(dob + DO_WBRAT); u16* WBRBT = (u16*)(dob + DO_WBRBT);
  u16* WOUTT = (u16*)(ws + WS_WOUTT); u16* WQT = (u16*)(ws + WS_WQT); u16* K1 = (u16*)(ws + WS_K1); u16* K2 = (u16*)(ws + WS_K2);
  float* RC = (float*)(ws + WS_ROPE_C); float* RS = (float*)(ws + WS_ROPE_S); float* SSQ = (float*)(ws + WS_SSQ);
  u16* RQ = (u16*)(ws + WS_RQ); u16* RK = (u16*)(ws + WS_RK); u16* RV = (u16*)(ws + WS_RV); u16* SQ = (u16*)(ws + WS_SQ); u16* SK = (u16*)(ws + WS_SK);
  u16* SV = (u16*)(ws + WS_SV); u16* RG = (u16*)(ws + WS_RG); u16* GA = (u16*)(ws + WS_GA); u16* GB = (u16*)(ws + WS_GB);
  u16* IDX = (u16*)(ws + WS_IDX); float* GW = (float*)(ws + WS_G);
  u16* U16 = (u16*)(ws + WS_U16); u16* V16 = (u16*)(ws + WS_V16); u16* MIXED = (u16*)(ws + WS_MIXED); u16* X1H = (u16*)(ws + WS_X1H); u16* Q = (u16*)(ws + WS_Q);

  k_rms_x<<<S_, 256, 0, stream>>>(x, norm_attn, XN);
  k_transpose<false><<<dim3(6656 / 32, 1024 / 32), 256, 0, stream>>>(w_in, WINT, 1024, 6656, nullptr);
  k_transpose<false><<<dim3(1024 / 32, 1024 / 32), 256, 0, stream>>>(w_bra, WBRAT, 1024, 1024, nullptr);
  k_transpose<false><<<dim3(1024 / 32, 512 / 32), 256, 0, stream>>>(w_brb, WBRBT, 512, 1024, nullptr);
  k_transpose<false><<<dim3(1024 / 32, 1024 / 32), 256, 0, stream>>>(w_out, WOUTT, 1024, 1024, nullptr);
  k_transpose<true><<<dim3(2048 / 32, 1024 / 32), 256, 0, stream>>>(w_q, WQT, 1024, 2048, norm_ffn);
  k_conv_bf16<<<64, 256, 0, stream>>>(sk1, K1, 16384);
  k_conv_bf16<<<64, 256, 0, stream>>>(sk2, K2, 16384);
  k_rope_table<<<S_ * 32 / 256, 256, 0, stream>>>(RC, RS);
  { FEpiInProj e{RQ, RK, RV, RG, SQ, SK, SV, GA, GB}; launch_gemm<false>(XN, WINT, S_, 6656, 1024, e, stream); }
  k_qknorm<<<S_ * 8 / 256, 256, 0, stream>>>(RQ, ret_q_norm, RC, RS, 0);
  k_qknorm<<<S_ * 8 / 256, 256, 0, stream>>>(RK, ret_k_norm, RC, RS, 1);
  k_qknorm<<<S_ * 8 / 256, 256, 0, stream>>>(SQ, sb_q_norm, RC, RS, 2);
  k_qknorm<<<S_ * 8 / 256, 256, 0, stream>>>(SK, sb_k_norm, RC, RS, 3);
  { RetConst rc; for (int h = 0; h < 8; ++h) rc.l2g[h] = (float)log2(1.0 - exp2(-5.0 - (double)h));
    k_ret_naive<<<dim3(S_ / 64, 8), 256, 0, stream>>>(RQ, RK, RV, RG, ret_gn, rc); }
  k_sb_naive<<<dim3(S_ / 64, 8), 256, 0, stream>>>(SQ, SK, SV, SB);
  k_conv_table<<<S_ * D_ / 4 / 256, 256, 0, stream>>>(peer_u, U16, norm_ffn);
  k_conv_table<<<S_ * D_ / 4 / 256, 256, 0, stream>>>(peer_v, V16, nullptr);
  { FEpiMixB e{MIXED, GB}; launch_gemm<false>(SB, WBRBT, S_, 1024, 512, e, stream); }
  { FEpiMixA e{MIXED, GA}; launch_gemm<false>(RG, WBRAT, S_, 1024, 1024, e, stream); }
  (void)hipMemsetAsync(SSQ, 0, S_ * 4, stream);
  { FEpiOut e{x, out, X1H, SSQ}; launch_gemm<false>(MIXED, WOUTT, S_, 1024, 1024, e, stream); }
  { FEpiQ e{SSQ, Q}; launch_gemm<true>(X1H, WQT, S_, 2048, 1024, e, stream); }
  k_select_naive<<<S_ * 8 / 64, 64, 0, stream>>>(Q, K1, K2, IDX, GW);
  k_gather_naive<<<S_, 256, 0, stream>>>(X1H, SSQ, IDX, GW, U16, V16, out);
}
```

```cpp
#include <hip/hip_runtime.h>
#include <stdint.h>

typedef unsigned short u16;
#define S_ 16384
#define D_ 1024
#define MB_ ((size_t)1 << 20)

#define WS_WOUTT (1 * MB_)
#define WS_WQT (3 * MB_)
#define WS_K1 (7 * MB_)
#define WS_K2 (7 * MB_ + 65536)
#define WS_ROPE_C (8 * MB_)
#define WS_ROPE_S (10 * MB_)
#define WS_SSQ (12 * MB_)
#define WS_RQ (16 * MB_)
#define WS_RK (32 * MB_)
#define WS_RV (48 * MB_)
#define WS_SQ (80 * MB_)
#define WS_SK (96 * MB_)
#define WS_SV (112 * MB_)
#define WS_RG (128 * MB_)
#define WS_GA (160 * MB_)
#define WS_GB (192 * MB_)
#define WS_IDX (224 * MB_)
#define WS_G (232 * MB_)
#define WS_NEED (248 * MB_)
#define WS_U16 WS_RQ
#define WS_V16 WS_RV
#define WS_MIXED WS_SQ
#define WS_X1H WS_RG
#define WS_Q WS_GA
#define DO_XN (0 * MB_)
#define DO_WINT (32 * MB_)
#define DO_SB (32 * MB_)
#define DO_WBRAT (60 * MB_)
#define DO_WBRBT (62 * MB_)

__device__ __forceinline__ u16 f2bf(float f) { unsigned u = __float_as_uint(f); u += 0x7FFFu + ((u >> 16) & 1u); return (u16)(u >> 16); }
__device__ __forceinline__ float bf2f(u16 b) { return __uint_as_float(((unsigned)b) << 16); }
__device__ __forceinline__ u16 f2h(float f) { _Float16 h = (_Float16)f; return *(u16*)&h; }
__device__ __forceinline__ float h2f(u16 b) { _Float16 h = *(_Float16*)&b; return (float)h; }
template <bool F16> __device__ __forceinline__ float ld16(const u16* p) { return F16 ? h2f(*p) : bf2f(*p); }
__device__ __forceinline__ float sigmoidf_(float x) { return 1.0f / (1.0f + __expf(-x)); }

__global__ void k_rms_x(const float* __restrict__ x, const float* __restrict__ g, u16* __restrict__ xn) {
  __shared__ float red[4];
  const int t = blockIdx.x, tid = threadIdx.x;
  const float4 v = ((const float4*)(x + (size_t)t * D_))[tid];
  float s = v.x * v.x + v.y * v.y + v.z * v.z + v.w * v.w;
  for (int o = 32; o > 0; o >>= 1) s += __shfl_xor(s, o);
  if ((tid & 63) == 0) red[tid >> 6] = s;
  __syncthreads();
  s = red[0] + red[1] + red[2] + red[3];
  const float r = rsqrtf(s * (1.0f / D_) + 1e-6f);
  const float4 gg = ((const float4*)g)[tid];
  u16* o = xn + (size_t)t * D_ + tid * 4;
  o[0] = f2bf(v.x * r * gg.x); o[1] = f2bf(v.y * r * gg.y); o[2] = f2bf(v.z * r * gg.z); o[3] = f2bf(v.w * r * gg.w);
}

template <bool F16> __global__ void k_transpose(const float* __restrict__ W, u16* __restrict__ Wt, int K, int N, const float* __restrict__ scale) {
  __shared__ float tile[32][33];
  const int k0 = blockIdx.y * 32, n0 = blockIdx.x * 32, tx = threadIdx.x & 31, ty = threadIdx.x >> 5;
  for (int i = ty; i < 32; i += 8) { const int k = k0 + i; tile[i][tx] = W[(size_t)k * N + n0 + tx] * (scale ? scale[k] : 1.0f); }
  __syncthreads();
  for (int i = ty; i < 32; i += 8) { const float v = tile[tx][i]; Wt[(size_t)(n0 + i) * K + k0 + tx] = F16 ? f2h(v) : f2bf(v); }
}
__global__ void k_conv_bf16(const float* __restrict__ a, u16* __restrict__ o, int n) { const int i = blockIdx.x * blockDim.x + threadIdx.x; if (i < n) o[i] = f2bf(a[i]); }
__global__ void k_conv_table(const float* __restrict__ a, u16* __restrict__ o, const float* __restrict__ colscale) {
  const size_t i = ((size_t)blockIdx.x * blockDim.x + threadIdx.x) * 4;
  const float4 v = *(const float4*)(a + i);
  float4 s = make_float4(1.f, 1.f, 1.f, 1.f);
  if (colscale) s = *(const float4*)(colscale + (i & (D_ - 1)));
  o[i] = f2h(v.x * s.x); o[i + 1] = f2h(v.y * s.y); o[i + 2] = f2h(v.z * s.z); o[i + 3] = f2h(v.w * s.w);
}
__global__ void k_rope_table(float* __restrict__ c, float* __restrict__ s) {
  const int i = blockIdx.x * blockDim.x + threadIdx.x;
  const int t = i >> 5, f = i & 31;
  const float freq = powf(10000.0f, -(float)f / 32.0f);
  const float ang = (float)t * freq;
  float sn, cs; sincosf(ang, &sn, &cs);
  c[i] = cs; s[i] = sn;
}

template <bool F16, class Epi> __global__ void __launch_bounds__(256) k_gemm_naive(const u16* __restrict__ A, const u16* __restrict__ Bt, int M, int N, int K, Epi E) {
  __shared__ float As[64][33], Bs[64][33];
  const int tid = threadIdx.x, tx = tid & 15, ty = tid >> 4, m0 = blockIdx.y * 64, n0 = blockIdx.x * 64;
  float acc[4][4];
#pragma unroll
  for (int i = 0; i < 4; ++i)
#pragma unroll
    for (int j = 0; j < 4; ++j) acc[i][j] = 0.f;
  const int lr = tid >> 2, lc = (tid & 3) * 8;
  for (int k0 = 0; k0 < K; k0 += 32) {
    const u16* ap = A + (size_t)(m0 + lr) * K + k0 + lc; const u16* bp = Bt + (size_t)(n0 + lr) * K + k0 + lc;
#pragma unroll
    for (int j = 0; j < 8; ++j) { As[lr][lc + j] = ld16<F16>(ap + j); Bs[lr][lc + j] = ld16<F16>(bp + j); }
    __syncthreads();
#pragma unroll 8
    for (int k = 0; k < 32; ++k) {
      float a[4], b[4];
#pragma unroll
      for (int i = 0; i < 4; ++i) { a[i] = As[ty * 4 + i][k]; b[i] = Bs[tx * 4 + i][k]; }
#pragma unroll
      for (int i = 0; i < 4; ++i)
#pragma unroll
        for (int j = 0; j < 4; ++j) acc[i][j] += a[i] * b[j];
    }
    __syncthreads();
  }
#pragma unroll
  for (int i = 0; i < 4; ++i)
#pragma unroll
    for (int j = 0; j < 4; ++j) E(m0 + ty * 4 + i, n0 + tx * 4 + j, acc[i][j]);
}
struct EpiInProj {
  u16 *rq, *rk, *rv, *rg, *sq, *sk, *sv, *ga, *gb;
  __device__ void operator()(int r, int c, float v) const {
    u16* b; int ld, c0;
    if (c < 512) { b = rq; ld = 512; c0 = 0; } else if (c < 1024) { b = rk; ld = 512; c0 = 512; } else if (c < 2048) { b = rv; ld = 1024; c0 = 1024; }
    else if (c < 3072) { b = rg; ld = 1024; c0 = 2048; } else if (c < 3584) { b = sq; ld = 512; c0 = 3072; } else if (c < 4096) { b = sk; ld = 512; c0 = 3584; }
    else if (c < 4608) { b = sv; ld = 512; c0 = 4096; } else if (c < 5632) { b = ga; ld = 1024; c0 = 4608; } else { b = gb; ld = 1024; c0 = 5632; }
    b[(size_t)r * ld + (c - c0)] = f2bf(v);
  }
};
struct EpiMixB { u16* mixed; const u16* gb; __device__ void operator()(int r, int c, float v) const { const size_t i = (size_t)r * D_ + c; mixed[i] = f2bf(sigmoidf_(bf2f(gb[i])) * v); } };
struct EpiMixA { u16* mixed; const u16* ga; __device__ void operator()(int r, int c, float v) const { const size_t i = (size_t)r * D_ + c; mixed[i] = f2bf(bf2f(mixed[i]) + sigmoidf_(bf2f(ga[i])) * v); } };
struct EpiOut { const float* x; float* x1; u16* x1h; __device__ void operator()(int r, int c, float v) const { const size_t i = (size_t)r * D_ + c; const float o = x[i] + v; x1[i] = o; x1h[i] = f2h(o); } };
struct EpiQ { const float* ssq; u16* q; __device__ void operator()(int r, int c, float v) const { const float rstd = rsqrtf(ssq[r] * (1.0f / D_) + 1e-6f); q[(size_t)r * 2048 + c] = f2bf(v * rstd); } };

__global__ void k_rowssq(const float* __restrict__ x1, float* __restrict__ ssq) {
  __shared__ float red[4];
  const int t = blockIdx.x, tid = threadIdx.x;
  const float4 v = ((const float4*)(x1 + (size_t)t * D_))[tid];
  float s = v.x * v.x + v.y * v.y + v.z * v.z + v.w * v.w;
  for (int o = 32; o > 0; o >>= 1) s += __shfl_xor(s, o);
  if ((tid & 63) == 0) red[tid >> 6] = s;
  __syncthreads();
  if (tid == 0) ssq[t] = red[0] + red[1] + red[2] + red[3];
}

__global__ void k_qknorm(u16* __restrict__ buf, const float* __restrict__ gain, const float* __restrict__ rc, const float* __restrict__ rs, int which) {
  const int i = blockIdx.x * blockDim.x + threadIdx.x;
  const int t = i >> 3, h = i & 7;
  u16* p = buf + (size_t)t * 512 + h * 64;
  float v[64]; float ss = 0.f;
#pragma unroll
  for (int d = 0; d < 64; ++d) { v[d] = bf2f(p[d]); ss += v[d] * v[d]; }
  const float r = rsqrtf(ss * (1.0f / 64.0f) + 1e-6f);
#pragma unroll
  for (int d = 0; d < 64; ++d) v[d] = v[d] * r * gain[d];
  if (which < 2) {
    const float sc = which == 1 ? 0.125f : 1.0f;
#pragma unroll
    for (int d = 0; d < 32; ++d) {
      const float c = rc[t * 32 + d], s = rs[t * 32 + d];
      const float a = v[d], b = v[d + 32];
      v[d] = (a * c - b * s) * sc; v[d + 32] = (a * s + b * c) * sc;
    }
  }
#pragma unroll
  for (int d = 0; d < 64; ++d) p[d] = f2bf(v[d]);
}

struct RetConst { float l2g[8]; };
__global__ void __launch_bounds__(256) k_ret_naive(const u16* __restrict__ rq, const u16* __restrict__ rk, const u16* __restrict__ rv, u16* __restrict__ rg,
                                                   const float* __restrict__ gn, RetConst rc) {
  __shared__ float red[64][4][2];
  const int h = blockIdx.y, t0 = blockIdx.x * 64, tid = threadIdx.x, tl = tid & 63, eq = tid >> 6, t = t0 + tl;
  float q[64], acc[32];
#pragma unroll
  for (int d = 0; d < 64; ++d) q[d] = bf2f(rq[(size_t)t * 512 + h * 64 + d]);
#pragma unroll
  for (int e = 0; e < 32; ++e) acc[e] = 0.f;
  const float l2g = rc.l2g[h];
  for (int s = 0; s <= t0 + 63; ++s) {
    const u16* kp = rk + (size_t)s * 512 + h * 64;
    float sc = 0.f;
#pragma unroll
    for (int d = 0; d < 64; ++d) sc += q[d] * bf2f(kp[d]);
    const float w = (s <= t) ? sc * exp2f((float)(t - s) * l2g) : 0.f;
    const u16* vp = rv + (size_t)s * 1024 + h * 128 + eq * 32;
#pragma unroll
    for (int e = 0; e < 32; ++e) acc[e] += w * bf2f(vp[e]);
  }
  float s1 = 0.f;
#pragma unroll
  for (int e = 0; e < 32; ++e) s1 += acc[e];
  red[tl][eq][0] = s1;
  __syncthreads();
  const float mu = (red[tl][0][0] + red[tl][1][0] + red[tl][2][0] + red[tl][3][0]) * (1.0f / 128.0f);
  float s2 = 0.f;
#pragma unroll
  for (int e = 0; e < 32; ++e) { const float d = acc[e] - mu; s2 += d * d; }
  red[tl][eq][1] = s2;
  __syncthreads();
  const float var = (red[tl][0][1] + red[tl][1][1] + red[tl][2][1] + red[tl][3][1]) * (1.0f / 128.0f);
  const float rstd = rsqrtf(var + 1e-6f);
  u16* gp = rg + (size_t)t * 1024 + h * 128 + eq * 32;
#pragma unroll
  for (int e = 0; e < 32; ++e) {
    const float g = bf2f(gp[e]);
    const float y = (acc[e] - mu) * rstd * gn[h * 128 + eq * 32 + e];
    gp[e] = f2bf(y * g * sigmoidf_(g));
  }
}

__global__ void __launch_bounds__(256) k_sb_naive(const u16* __restrict__ sq, const u16* __restrict__ sk, const u16* __restrict__ sv, u16* __restrict__ sb) {
  const int h = blockIdx.y, t0 = blockIdx.x * 64, tid = threadIdx.x, tl = tid & 63, eq = tid >> 6, t = t0 + tl;
  float q[64], acc[16];
#pragma unroll
  for (int d = 0; d < 64; ++d) q[d] = bf2f(sq[(size_t)t * 512 + h * 64 + d]);
#pragma unroll
  for (int e = 0; e < 16; ++e) acc[e] = 0.f;
  float later = 0.f;
  for (int s = t0 + 62; s >= 0; --s) {
    if (s < t0 && __all(later < -104.0f)) break;
    const u16* kp = sk + (size_t)s * 512 + h * 64;
    float z = 0.f;
#pragma unroll
    for (int d = 0; d < 64; ++d) z += q[d] * bf2f(kp[d]);
    z *= 0.125f;
    if (s < t) {
      const float sp = fmaxf(z, 0.f) + log1pf(__expf(-fabsf(z)));
      const float w = __expf((z - sp) + later);
      const u16* vp = sv + (size_t)s * 512 + h * 64 + eq * 16;
#pragma unroll
      for (int e = 0; e < 16; ++e) acc[e] += w * bf2f(vp[e]);
      later -= sp;
    }
  }
  u16* op = sb + (size_t)t * 512 + h * 64 + eq * 16;
#pragma unroll
  for (int e = 0; e < 16; ++e) op[e] = f2bf(acc[e]);
}

#define INS16(V, I, x, id) do { float _x = (x); int _i = (id); \
  _Pragma("unroll") for (int _j = 15; _j >= 1; --_j) { const bool _a = _x > V[_j - 1], _b = _x > V[_j]; \
    const float nv = _a ? V[_j - 1] : (_b ? _x : V[_j]); const int ni = _a ? I[_j - 1] : (_b ? _i : I[_j]); V[_j] = nv; I[_j] = ni; } \
  if (_x > V[0]) { V[0] = _x; I[0] = _i; } } while (0)
__global__ void __launch_bounds__(64) k_select_naive(const u16* __restrict__ q, const u16* __restrict__ k1, const u16* __restrict__ k2, u16* __restrict__ idx, float* __restrict__ gw) {
  __shared__ u16 ks[2][128 * 128];
  for (int i = threadIdx.x; i < 128 * 128; i += 64) { ks[0][i] = k1[i]; ks[1][i] = k2[i]; }
  __syncthreads();
  const int i = blockIdx.x * 64 + threadIdx.x, t = i >> 3, h = i & 7;
  float v1[16], v2[16]; int i1[16], i2[16];
#pragma unroll
  for (int j = 0; j < 16; ++j) { v1[j] = -3.0e38f; v2[j] = -3.0e38f; i1[j] = 0; i2[j] = 0; }
  const u16* qp = q + (size_t)t * 2048 + h * 256;
  for (int n = 0; n < 128; ++n) {
    float s = 0.f;
    for (int d = 0; d < 128; ++d) s += bf2f(qp[d]) * bf2f(ks[0][n * 128 + d]);
    INS16(v1, i1, s, n);
  }
  for (int n = 0; n < 128; ++n) {
    float s = 0.f;
    for (int d = 0; d < 128; ++d) s += bf2f(qp[128 + d]) * bf2f(ks[1][n * 128 + d]);
    INS16(v2, i2, s, n);
  }
  float tv[16]; int ti[16];
#pragma unroll
  for (int j = 0; j < 16; ++j) { tv[j] = -3.0e38f; ti[j] = 0; }
#pragma unroll
  for (int a = 0; a < 16; ++a)
#pragma unroll
    for (int b = 0; b < 16; ++b)
      if ((a + 1) * (b + 1) <= 16) INS16(tv, ti, v1[a] + v2[b], i1[a] * 128 + i2[b]);
  float sum = 0.f, e[16];
#pragma unroll
  for (int j = 0; j < 16; ++j) { e[j] = __expf(tv[j] - tv[0]); sum += e[j]; }
  const float inv = 1.0f / sum;
#pragma unroll
  for (int j = 0; j < 16; ++j) { idx[(size_t)t * 128 + h * 16 + j] = (u16)ti[j]; gw[(size_t)t * 128 + h * 16 + j] = e[j] * inv; }
}

__device__ __forceinline__ float gelu_tanh(float x) { const float u = 0.7978845608028654f * (x + 0.044715f * x * x * x); return 0.5f * x * (1.0f + tanhf(u)); }
__global__ void __launch_bounds__(256) k_gather_naive(const u16* __restrict__ x1h, const float* __restrict__ ssq, const u16* __restrict__ idx, const float* __restrict__ gw,
                                                      const u16* __restrict__ u16t, const u16* __restrict__ v16t, float* __restrict__ out) {
  __shared__ float a_s[128]; __shared__ int e_s[128];
  const int t = blockIdx.x, tid = threadIdx.x, lane = tid & 63, w = tid >> 6;
  if (tid < 128) e_s[tid] = idx[(size_t)t * 128 + tid];
  __syncthreads();
  float xr[16];
#pragma unroll
  for (int j = 0; j < 16; ++j) xr[j] = h2f(x1h[(size_t)t * D_ + lane * 16 + j]);
  const float rstd = rsqrtf(ssq[t] * (1.0f / D_) + 1e-6f);
  for (int p = w; p < 128; p += 4) {
    const u16* up = u16t + (size_t)e_s[p] * D_ + lane * 16;
    float s = 0.f;
#pragma unroll
    for (int j = 0; j < 16; ++j) s += xr[j] * h2f(up[j]);
    for (int o = 32; o > 0; o >>= 1) s += __shfl_xor(s, o);
    if (lane == 0) a_s[p] = gelu_tanh(s * rstd) * gw[(size_t)t * 128 + p];
  }
  __syncthreads();
  float acc[4] = {0.f, 0.f, 0.f, 0.f};
  for (int p = 0; p < 128; ++p) {
    const u16* vp = v16t + (size_t)e_s[p] * D_ + tid * 4;
    const float a = a_s[p];
#pragma unroll
    for (int j = 0; j < 4; ++j) acc[j] += a * h2f(vp[j]);
  }
  float* op = out + (size_t)t * D_ + tid * 4;
#pragma unroll
  for (int j = 0; j < 4; ++j) op[j] += acc[j];
}


namespace pg8 {
#define PG8_LAS __attribute__((address_space(3)))
typedef short bf16x8 __attribute__((ext_vector_type(8)));
typedef _Float16 f16x8 __attribute__((ext_vector_type(8)));
typedef float f32x4 __attribute__((ext_vector_type(4)));
typedef unsigned u32x4 __attribute__((ext_vector_type(4)));
constexpr int BM = 256, BK = 64, HALF = 128, HTB = HALF * BK * 2, STAGE_BYTES = 8 * HTB, NXCD = 8, WGM = 8;
__host__ __device__ __forceinline__ int lds_byte(int r, int c) { const int st = (r >> 4) * 2 + (c >> 5), rr = r & 15, cc = c & 31, ob = rr * 64 + cc * 2; return st * 1024 + (ob ^ (((ob >> 9) & 1) << 5)); }
__host__ __device__ __forceinline__ void stage_rc(int b, int& R, int& C) { const int st = b / 1024, sb = b % 1024, swz = sb ^ (((sb >> 9) & 1) << 5); R = (st >> 1) * 16 + swz / 64; C = (st & 1) * 32 + (swz % 64) / 2; }
__host__ __device__ __forceinline__ int perm32(int rho) { const int n = rho >> 4, i = rho & 15; return 8 * (i >> 2) + 4 * n + (i & 3); }
struct Unit { int pm, pn; };
struct Gemm { const u16* A; const u16* Bt; int M, N, K, pad; };
struct StaticOrder {
  int nM, nN, nwg, G, c;
  __host__ __device__ void init(int M, int N, int G_, int c_) { nM = M / BM; nN = N / BM; nwg = nM * nN; G = G_; c = c_; }
  __host__ __device__ bool next(int i, Unit& u) const {
    const long L = (long)i * G + c; if (L >= nwg) return false;
    int wgid = (int)L; { const int q = nwg / NXCD, r = nwg % NXCD, xcd = wgid % NXCD, off = wgid / NXCD; wgid = (xcd < r ? xcd * (q + 1) : r * (q + 1) + (xcd - r) * q) + off; }
    const int nig = WGM * nN, gid = wgid / nig, fm = gid * WGM, gsz = (nM - fm) < WGM ? (nM - fm) : WGM;
    u.pm = fm + ((wgid % nig) % gsz); u.pn = (wgid % nig) / gsz; return true;
  }
};
__device__ __forceinline__ unsigned cvt_pk_bf16(float lo, float hi) { unsigned r; asm volatile("v_cvt_pk_bf16_f32 %0, %1, %2" : "=v"(r) : "v"(lo), "v"(hi)); return r; }
__device__ __forceinline__ unsigned cvt_pk_f16(float lo, float hi) { typedef _Float16 h2 __attribute__((ext_vector_type(2))); h2 v; v.x = (_Float16)lo; v.y = (_Float16)hi; return __builtin_bit_cast(unsigned, v); }

template <bool F16, class Epi>
__device__ __forceinline__ void gemm_phase(PG8_LAS unsigned char* lds, const Gemm g, const StaticOrder& S, const Epi& E) {
  const int tid = threadIdx.x, wid = __builtin_amdgcn_readfirstlane(tid >> 6), lane = tid & 63, wr = wid >> 2, wc = wid & 3, fr = lane & 15, fq = lane >> 4;
  const int K = g.K, nt = K / BK;
  unsigned voffA[2], voffB[2];
#pragma unroll
  for (int i = 0; i < 2; ++i) { int R, C; stage_rc(tid * 16 + i * 8192, R, C); const int Rb = ((R & ~31) + perm32(R & 31));
    voffA[i] = (unsigned)(R * K + C) * 2u; voffB[i] = (unsigned)(Rb * K + C) * 2u; }
  const size_t kstep = (size_t)(BK * 2);
  const size_t hstep = (size_t)HALF * K * 2;
  const size_t tstep = 2 * hstep;
  const unsigned ldsw = (unsigned)wid * 1024u;
  const int aoff = lds_byte(wr * 64 + fr, fq * 8), boff = lds_byte(wc * 32 + fr, fq * 8);
#define PG8_SA(b, h) (((b) * 2 + (h)) * HTB)
#define PG8_SB(b, h) ((4 + (b) * 2 + (h)) * HTB)
#define PG8_STAGE(bufoff, gbase, voff) do { _Pragma("unroll") for (int _i = 0; _i < 2; ++_i) \
    __builtin_amdgcn_global_load_lds((const unsigned*)((const char*)(gbase) + (voff)[_i]), (PG8_LAS unsigned*)(lds + (bufoff) + ldsw + _i * 8192), 16, 0, 0); } while (0)
#define PG8_LDA(dst, b, h) do { _Pragma("unroll") for (int m = 0; m < 4; ++m) _Pragma("unroll") for (int k = 0; k < 2; ++k) dst[m][k] = *(const PG8_LAS bf16x8*)(lds + PG8_SA(b, h) + aoff + m * 2048 + k * 1024); } while (0)
#define PG8_LDB(dst, b, h) do { _Pragma("unroll") for (int n = 0; n < 2; ++n) _Pragma("unroll") for (int k = 0; k < 2; ++k) dst[n][k] = *(const PG8_LAS bf16x8*)(lds + PG8_SB(b, h) + boff + n * 2048 + k * 1024); } while (0)
#define PG8_MMA(ai, bj, At, Bt) do { __builtin_amdgcn_s_setprio(1); _Pragma("unroll") for (int m = 0; m < 4; ++m) _Pragma("unroll") for (int n = 0; n < 2; ++n) _Pragma("unroll") for (int k = 0; k < 2; ++k) { \
    if constexpr (F16) acc[ai][bj][m][n] = __builtin_amdgcn_mfma_f32_16x16x32_f16(__builtin_bit_cast(f16x8, Bt[n][k]), __builtin_bit_cast(f16x8, At[m][k]), acc[ai][bj][m][n], 0, 0, 0); \
    else acc[ai][bj][m][n] = __builtin_amdgcn_mfma_f32_16x16x32_bf16(Bt[n][k], At[m][k], acc[ai][bj][m][n], 0, 0, 0); } __builtin_amdgcn_s_setprio(0); } while (0)
#define PG8_WAIT_V(n) asm volatile("s_waitcnt vmcnt(" #n ")" ::: "memory")
#define PG8_WAIT_L(n) asm volatile("s_waitcnt lgkmcnt(" #n ")" ::: "memory")
#define PG8_BAR __builtin_amdgcn_s_barrier()
#define PG8_SCHED __builtin_amdgcn_sched_barrier(0)
  Unit cur, nxt; int ui = 0;
  if (!S.next(0, cur)) return;
  f32x4 acc[2][2][4][2];
#pragma unroll
  for (int a = 0; a < 2; ++a)
#pragma unroll
    for (int b = 0; b < 2; ++b)
#pragma unroll
      for (int m = 0; m < 4; ++m)
#pragma unroll
        for (int n = 0; n < 2; ++n) acc[a][b][m][n] = (f32x4){0.f, 0.f, 0.f, 0.f};
  bf16x8 At[4][2], B0[2][2], B1[2][2];
  const char* cA = (const char*)g.A + (size_t)cur.pm * tstep; const char* cB = (const char*)g.Bt + (size_t)cur.pn * tstep;
  PG8_STAGE(PG8_SB(0, 0), cB, voffB); PG8_STAGE(PG8_SA(0, 0), cA, voffA); PG8_STAGE(PG8_SB(0, 1), cB + hstep, voffB); PG8_STAGE(PG8_SA(0, 1), cA + hstep, voffA);
  if (wr == 1) PG8_BAR;
  PG8_WAIT_V(4); PG8_BAR;
  PG8_STAGE(PG8_SB(1, 0), cB + kstep, voffB); PG8_STAGE(PG8_SA(1, 0), cA + kstep, voffA); PG8_STAGE(PG8_SB(1, 1), cB + hstep + kstep, voffB);
  PG8_WAIT_V(6); PG8_BAR;
  for (;;) {
    const bool has_next = S.next(ui + 1, nxt);
    const char* nA = has_next ? (const char*)g.A + (size_t)nxt.pm * tstep : cA; const char* nB = has_next ? (const char*)g.Bt + (size_t)nxt.pn * tstep : cB;
    for (int t = 0; t < nt; t += 2) {
      const bool last = (t == nt - 2);
      const char* a1 = cA + (size_t)(t + 1) * kstep;
      const char* a2 = last ? nA : cA + (size_t)(t + 2) * kstep; const char* b2 = last ? nB : cB + (size_t)(t + 2) * kstep;
      const char* a3 = a2 + kstep; const char* b3 = b2 + kstep;
      PG8_LDB(B0, 0, 0); PG8_SCHED; PG8_LDA(At, 0, 0); PG8_STAGE(PG8_SA(1, 1), a1 + hstep, voffA);
      PG8_WAIT_L(8); PG8_BAR; PG8_WAIT_L(0); PG8_MMA(0, 0, At, B0); PG8_BAR; PG8_SCHED;
      PG8_LDB(B1, 0, 1); PG8_STAGE(PG8_SB(0, 0), b2, voffB);
      PG8_BAR; PG8_WAIT_L(0); PG8_MMA(0, 1, At, B1); PG8_BAR;
      PG8_LDA(At, 0, 1); PG8_STAGE(PG8_SA(0, 0), a2, voffA);
      PG8_BAR; PG8_WAIT_L(0); PG8_MMA(1, 0, At, B0); PG8_BAR; PG8_SCHED;
      PG8_STAGE(PG8_SB(0, 1), b2 + hstep, voffB);
      PG8_WAIT_V(6); PG8_BAR; PG8_MMA(1, 1, At, B1); PG8_BAR;
      PG8_LDB(B0, 1, 0); PG8_SCHED; PG8_LDA(At, 1, 0); PG8_STAGE(PG8_SA(0, 1), a2 + hstep, voffA);
      PG8_WAIT_L(8); PG8_BAR; PG8_WAIT_L(0); PG8_MMA(0, 0, At, B0); PG8_BAR; PG8_SCHED;
      PG8_LDB(B1, 1, 1); PG8_STAGE(PG8_SB(1, 0), b3, voffB);
      PG8_BAR; PG8_WAIT_L(0); PG8_MMA(0, 1, At, B1); PG8_BAR;
      PG8_LDA(At, 1, 1); PG8_STAGE(PG8_SA(1, 0), a3, voffA);
      PG8_BAR; PG8_WAIT_L(0); PG8_MMA(1, 0, At, B0); PG8_BAR; PG8_SCHED;
      PG8_STAGE(PG8_SB(1, 1), b3 + hstep, voffB);
      PG8_WAIT_V(6); PG8_BAR; PG8_MMA(1, 1, At, B1); PG8_BAR;
    }
    E(acc, cur, wr, wc, fr, fq);
    if (!has_next) break;
#pragma unroll
    for (int a = 0; a < 2; ++a)
#pragma unroll
      for (int b = 0; b < 2; ++b)
#pragma unroll
        for (int m = 0; m < 4; ++m)
#pragma unroll
          for (int n = 0; n < 2; ++n) acc[a][b][m][n] = (f32x4){0.f, 0.f, 0.f, 0.f};
    cur = nxt; cA = nA; cB = nB; ++ui;
  }
  PG8_WAIT_V(0);
  if (wr == 0) PG8_BAR;
  PG8_BAR;
#undef PG8_SA
#undef PG8_SB
#undef PG8_STAGE
#undef PG8_LDA
#undef PG8_LDB
#undef PG8_MMA
#undef PG8_WAIT_V
#undef PG8_WAIT_L
#undef PG8_BAR
#undef PG8_SCHED
}
}

typedef pg8::f32x4 f32x4; typedef pg8::u32x4 u32x4;
template <class F> __device__ __forceinline__ void epi_walk(const f32x4 (&acc)[2][2][4][2], const pg8::Unit& u, int wr, int wc, int fr, int fq, F&& f) {
  const int row0 = u.pm * 256 + wr * 64 + fr, col0 = u.pn * 256 + wc * 32 + 8 * fq;
#pragma unroll
  for (int ai = 0; ai < 2; ++ai)
#pragma unroll
    for (int m = 0; m < 4; ++m)
#pragma unroll
      for (int bj = 0; bj < 2; ++bj) f(row0 + ai * 128 + m * 16, col0 + bj * 128, acc[ai][bj][m][0], acc[ai][bj][m][1]);
}
__device__ __forceinline__ u32x4 pack8_bf16(f32x4 v0, f32x4 v1) { u32x4 w; w.x = pg8::cvt_pk_bf16(v0[0], v0[1]); w.y = pg8::cvt_pk_bf16(v0[2], v0[3]); w.z = pg8::cvt_pk_bf16(v1[0], v1[1]); w.w = pg8::cvt_pk_bf16(v1[2], v1[3]); return w; }
__device__ __forceinline__ u32x4 pack8_f16(f32x4 v0, f32x4 v1) { u32x4 w; w.x = pg8::cvt_pk_f16(v0[0], v0[1]); w.y = pg8::cvt_pk_f16(v0[2], v0[3]); w.z = pg8::cvt_pk_f16(v1[0], v1[1]); w.w = pg8::cvt_pk_f16(v1[2], v1[3]); return w; }
__device__ __forceinline__ void unpack8_bf16(u32x4 w, float (&f)[8]) {
  f[0] = __uint_as_float(w.x << 16); f[1] = __uint_as_float(w.x & 0xffff0000u); f[2] = __uint_as_float(w.y << 16); f[3] = __uint_as_float(w.y & 0xffff0000u);
  f[4] = __uint_as_float(w.z << 16); f[5] = __uint_as_float(w.z & 0xffff0000u); f[6] = __uint_as_float(w.w << 16); f[7] = __uint_as_float(w.w & 0xffff0000u); }

struct FEpiInProj {
  u16 *rq, *rk, *rv, *rg, *sq, *sk, *sv, *ga, *gb;
  __device__ __forceinline__ void operator()(const f32x4 (&acc)[2][2][4][2], const pg8::Unit& u, int wr, int wc, int fr, int fq) const {
    const int c = u.pn * 256; u16* b; int ld, c0;
    if (c < 512) { b = rq; ld = 512; c0 = 0; } else if (c < 1024) { b = rk; ld = 512; c0 = 512; } else if (c < 2048) { b = rv; ld = 1024; c0 = 1024; }
    else if (c < 3072) { b = rg; ld = 1024; c0 = 2048; } else if (c < 3584) { b = sq; ld = 512; c0 = 3072; } else if (c < 4096) { b = sk; ld = 512; c0 = 3584; }
    else if (c < 4608) { b = sv; ld = 512; c0 = 4096; } else if (c < 5632) { b = ga; ld = 1024; c0 = 4608; } else { b = gb; ld = 1024; c0 = 5632; }
    epi_walk(acc, u, wr, wc, fr, fq, [&](int row, int col, f32x4 v0, f32x4 v1) { *(u32x4*)(b + (size_t)row * ld + (col - c0)) = pack8_bf16(v0, v1); });
  }
};
struct FEpiMixB { u16* mixed; const u16* gb;
  __device__ __forceinline__ void operator()(const f32x4 (&acc)[2][2][4][2], const pg8::Unit& u, int wr, int wc, int fr, int fq) const {
    epi_walk(acc, u, wr, wc, fr, fq, [&](int row, int col, f32x4 v0, f32x4 v1) { const size_t i = (size_t)row * D_ + col; float g[8]; unpack8_bf16(*(const u32x4*)(gb + i), g); f32x4 a, b2;
      a[0] = sigmoidf_(g[0]) * v0[0]; a[1] = sigmoidf_(g[1]) * v0[1]; a[2] = sigmoidf_(g[2]) * v0[2]; a[3] = sigmoidf_(g[3]) * v0[3];
      b2[0] = sigmoidf_(g[4]) * v1[0]; b2[1] = sigmoidf_(g[5]) * v1[1]; b2[2] = sigmoidf_(g[6]) * v1[2]; b2[3] = sigmoidf_(g[7]) * v1[3];
      *(u32x4*)(mixed + i) = pack8_bf16(a, b2); });
  }
};
struct FEpiMixA { u16* mixed; const u16* ga;
  __device__ __forceinline__ void operator()(const f32x4 (&acc)[2][2][4][2], const pg8::Unit& u, int wr, int wc, int fr, int fq) const {
    epi_walk(acc, u, wr, wc, fr, fq, [&](int row, int col, f32x4 v0, f32x4 v1) { const size_t i = (size_t)row * D_ + col; float g[8], o[8]; unpack8_bf16(*(const u32x4*)(ga + i), g); unpack8_bf16(*(const u32x4*)(mixed + i), o); f32x4 a, b2;
      a[0] = o[0] + sigmoidf_(g[0]) * v0[0]; a[1] = o[1] + sigmoidf_(g[1]) * v0[1]; a[2] = o[2] + sigmoidf_(g[2]) * v0[2]; a[3] = o[3] + sigmoidf_(g[3]) * v0[3];
      b2[0] = o[4] + sigmoidf_(g[4]) * v1[0]; b2[1] = o[5] + sigmoidf_(g[5]) * v1[1]; b2[2] = o[6] + sigmoidf_(g[6]) * v1[2]; b2[3] = o[7] + sigmoidf_(g[7]) * v1[3];
      *(u32x4*)(mixed + i) = pack8_bf16(a, b2); });
  }
};
struct FEpiOut { const float* x; float* x1; u16* x1h; float* ssq;
  __device__ __forceinline__ void operator()(const f32x4 (&acc)[2][2][4][2], const pg8::Unit& u, int wr, int wc, int fr, int fq) const {
    const int row0 = u.pm * 256 + wr * 64 + fr, col0 = u.pn * 256 + wc * 32 + 8 * fq;
#pragma unroll
    for (int ai = 0; ai < 2; ++ai)
#pragma unroll
      for (int m = 0; m < 4; ++m) {
        const int row = row0 + ai * 128 + m * 16; float ss = 0.f;
#pragma unroll
        for (int bj = 0; bj < 2; ++bj) {
          const size_t i = (size_t)row * D_ + col0 + bj * 128;
          f32x4 a = *(const f32x4*)(x + i) + acc[ai][bj][m][0], b2 = *(const f32x4*)(x + i + 4) + acc[ai][bj][m][1];
          *(f32x4*)(x1 + i) = a; *(f32x4*)(x1 + i + 4) = b2; *(u32x4*)(x1h + i) = pack8_f16(a, b2);
          ss += a[0] * a[0] + a[1] * a[1] + a[2] * a[2] + a[3] * a[3] + b2[0] * b2[0] + b2[1] * b2[1] + b2[2] * b2[2] + b2[3] * b2[3];
        }
        ss += __shfl_xor(ss, 16); ss += __shfl_xor(ss, 32);
        if (fq == 0) atomicAdd(ssq + row, ss);
      }
  }
};
struct FEpiQ { const float* ssq; u16* q;
  __device__ __forceinline__ void operator()(const f32x4 (&acc)[2][2][4][2], const pg8::Unit& u, int wr, int wc, int fr, int fq) const {
    epi_walk(acc, u, wr, wc, fr, fq, [&](int row, int col, f32x4 v0, f32x4 v1) { const float rstd = rsqrtf(ssq[row] * (1.0f / D_) + 1e-6f); *(u32x4*)(q + (size_t)row * 2048 + col) = pack8_bf16(v0 * rstd, v1 * rstd); });
  }
};

#define LAS __attribute__((address_space(3)))
typedef short s16x8 __attribute__((ext_vector_type(8)));
typedef short s16x4 __attribute__((ext_vector_type(4)));
typedef float f32x16 __attribute__((ext_vector_type(16)));
typedef float f32x2 __attribute__((ext_vector_type(2)));
typedef __bf16 bf16x2_t __attribute__((ext_vector_type(2)));
typedef _Float16 h16x2 __attribute__((ext_vector_type(2)));
__device__ __forceinline__ unsigned pk_bf16(float lo, float hi) { f32x2 v = {lo, hi}; return __builtin_bit_cast(unsigned, __builtin_convertvector(v, bf16x2_t)); }
__device__ __forceinline__ unsigned pk_f16(float lo, float hi) { f32x2 v = {lo, hi}; return __builtin_bit_cast(unsigned, __builtin_convertvector(v, h16x2)); }
#define MFMA32(a, b, c) __builtin_amdgcn_mfma_f32_32x32x16_bf16((a), (b), (c), 0, 0, 0)
#define MFMA16(a, b, c) __builtin_amdgcn_mfma_f32_16x16x32_bf16((a), (b), (c), 0, 0, 0)

struct Params {
  const float *x, *norm_attn, *w_in, *ret_q_norm, *ret_k_norm, *ret_gn, *sb_q_norm, *sb_k_norm, *w_bra, *w_brb, *w_out, *norm_ffn, *w_q, *sk1, *sk2, *peer_u, *peer_v;
  float* out; char* ws;
  float l2g[8];
};

template <bool F16> __device__ __forceinline__ void transpose_tile(const float* __restrict__ W, u16* __restrict__ Wt, int K, int N, int k0, int n0, const float* __restrict__ scale, float* tile  ) {
  const int tid = threadIdx.x;
  { const int r = tid >> 4, c4 = tid & 15;
#pragma unroll
    for (int hh = 0; hh < 2; ++hh) { const int k = k0 + r + 32 * hh; float4 v = *(const float4*)(W + (size_t)k * N + n0 + 4 * c4); const float s = scale ? scale[k] : 1.0f;
      float* tp = tile + (r + 32 * hh) * 65 + 4 * c4; tp[0] = v.x * s; tp[1] = v.y * s; tp[2] = v.z * s; tp[3] = v.w * s; } }
  __syncthreads();
  { const int n = tid >> 3, kc = tid & 7; float f[8];
#pragma unroll
    for (int i = 0; i < 8; ++i) f[i] = tile[(8 * kc + i) * 65 + n];
    u32x4 w;
    if (F16) { w.x = pk_f16(f[0], f[1]); w.y = pk_f16(f[2], f[3]); w.z = pk_f16(f[4], f[5]); w.w = pk_f16(f[6], f[7]); }
    else { w.x = pk_bf16(f[0], f[1]); w.y = pk_bf16(f[2], f[3]); w.z = pk_bf16(f[4], f[5]); w.w = pk_bf16(f[6], f[7]); }
    *(u32x4*)(Wt + (size_t)(n0 + n) * K + k0 + 8 * kc) = w; }
  __syncthreads();
}
__device__ __forceinline__ void phase_prologue(const Params& p, unsigned char* smem, char* dob) {
  const int tid = threadIdx.x, lane = tid & 63, w = tid >> 6, G = gridDim.x, b = blockIdx.x;
  u16* XN = (u16*)(dob + DO_XN);
  for (int t = b * 8 + w; t < S_; t += G * 8) {
    const float* xp = p.x + (size_t)t * D_ + lane * 16;
    float4 v[4]; float ss = 0.f;
#pragma unroll
    for (int i = 0; i < 4; ++i) { v[i] = *(const float4*)(xp + 4 * i); ss += v[i].x * v[i].x + v[i].y * v[i].y + v[i].z * v[i].z + v[i].w * v[i].w; }
#pragma unroll
    for (int o = 32; o > 0; o >>= 1) ss += __shfl_xor(ss, o);
    const float r = rsqrtf(ss * (1.0f / D_) + 1e-6f);
    const float* gp = p.norm_attn + lane * 16; u32x4 o0, o1; float4 g0 = *(const float4*)gp, g1 = *(const float4*)(gp + 4), g2 = *(const float4*)(gp + 8), g3 = *(const float4*)(gp + 12);
    o0.x = pk_bf16(v[0].x * r * g0.x, v[0].y * r * g0.y); o0.y = pk_bf16(v[0].z * r * g0.z, v[0].w * r * g0.w); o0.z = pk_bf16(v[1].x * r * g1.x, v[1].y * r * g1.y); o0.w = pk_bf16(v[1].z * r * g1.z, v[1].w * r * g1.w);
    o1.x = pk_bf16(v[2].x * r * g2.x, v[2].y * r * g2.y); o1.y = pk_bf16(v[2].z * r * g2.z, v[2].w * r * g2.w); o1.z = pk_bf16(v[3].x * r * g3.x, v[3].y * r * g3.y); o1.w = pk_bf16(v[3].z * r * g3.z, v[3].w * r * g3.w);
    u16* op = XN + (size_t)t * D_ + lane * 16; *(u32x4*)op = o0; *(u32x4*)(op + 8) = o1;
  }
  float* tile = (float*)smem;
  for (int j = b; j < 2816; j += G) {
    if (j < 1664) { transpose_tile<false>(p.w_in, (u16*)(dob + DO_WINT), 1024, 6656, (j / 104) * 64, (j % 104) * 64, nullptr, tile); }
    else if (j < 1920) { const int q = j - 1664; transpose_tile<false>(p.w_bra, (u16*)(dob + DO_WBRAT), 1024, 1024, (q / 16) * 64, (q % 16) * 64, nullptr, tile); }
    else if (j < 2048) { const int q = j - 1920; transpose_tile<false>(p.w_brb, (u16*)(dob + DO_WBRBT), 512, 1024, (q / 16) * 64, (q % 16) * 64, nullptr, tile); }
    else if (j < 2304) { const int q = j - 2048; transpose_tile<false>(p.w_out, (u16*)(p.ws + WS_WOUTT), 1024, 1024, (q / 16) * 64, (q % 16) * 64, nullptr, tile); }
    else { const int q = j - 2304; transpose_tile<true>(p.w_q, (u16*)(p.ws + WS_WQT), 1024, 2048, (q / 32) * 64, (q % 32) * 64, p.norm_ffn, tile); }
  }
  const int gt = b * 512 + tid, GT = G * 512;
  for (int i = gt; i < 16384; i += GT) { ((u16*)(p.ws + WS_K1))[i] = f2bf(p.sk1[i]); ((u16*)(p.ws + WS_K2))[i] = f2bf(p.sk2[i]); ((float*)(p.ws + WS_SSQ))[i] = 0.f; }
  for (int i = gt; i < S_ * 32; i += GT) { const int t = i >> 5, f = i & 31; const float freq = powf(10000.0f, -(float)f / 32.0f); float sn, cs; sincosf((float)t * freq, &sn, &cs);
    ((float*)(p.ws + WS_ROPE_C))[i] = cs; ((float*)(p.ws + WS_ROPE_S))[i] = sn; }
}

__device__ __forceinline__ void phase_conv_tables(const Params& p) {
  const size_t gt = (size_t)blockIdx.x * 512 + threadIdx.x, GT = (size_t)gridDim.x * 512;
  u16* U16 = (u16*)(p.ws + WS_U16); u16* V16 = (u16*)(p.ws + WS_V16);
  for (size_t c = gt; c < (size_t)S_ * D_ / 8; c += GT) {
    const size_t i = c * 8; const int col = (int)(i & (D_ - 1));
    const float4 a0 = *(const float4*)(p.peer_u + i), a1 = *(const float4*)(p.peer_u + i + 4), s0 = *(const float4*)(p.norm_ffn + col), s1 = *(const float4*)(p.norm_ffn + col + 4);
    u32x4 w; w.x = pk_f16(a0.x * s0.x, a0.y * s0.y); w.y = pk_f16(a0.z * s0.z, a0.w * s0.w); w.z = pk_f16(a1.x * s1.x, a1.y * s1.y); w.w = pk_f16(a1.z * s1.z, a1.w * s1.w);
    *(u32x4*)(U16 + i) = w;
    const float4 b0 = *(const float4*)(p.peer_v + i), b1 = *(const float4*)(p.peer_v + i + 4);
    u32x4 y; y.x = pk_f16(b0.x, b0.y); y.y = pk_f16(b0.z, b0.w); y.z = pk_f16(b1.x, b1.y); y.w = pk_f16(b1.z, b1.w);
    *(u32x4*)(V16 + i) = y;
  }
}

#define SEL_KSTR 272
#define INSERT16(V, x) do { const float _x = (x); _Pragma("unroll") for (int _j = 15; _j >= 1; --_j) V[_j] = __builtin_amdgcn_fmed3f(V[_j - 1], V[_j], _x); V[0] = fmaxf(V[0], _x); } while (0)
#define MERGE16(V) do { float _c[16]; _Pragma("unroll") for (int _i = 0; _i < 16; ++_i) _c[_i] = __shfl_xor(V[_i], 32); \
  _Pragma("unroll") for (int _i = 0; _i < 16; ++_i) V[_i] = fmaxf(V[_i], _c[15 - _i]); \
  _Pragma("unroll") for (int _k = 8; _k >= 1; _k >>= 1) { _Pragma("unroll") for (int _i = 0; _i < 16; ++_i) if ((_i & _k) == 0) { const float _hi = fmaxf(V[_i], V[_i + _k]), _lo = fminf(V[_i], V[_i + _k]); V[_i] = _hi; V[_i + _k] = _lo; } } } while (0)
__device__ __forceinline__ void select_side(const u16* __restrict__ qrow  , LAS unsigned char* ks, int lane, float (&V)[16]) {
  const int hh = lane >> 5, r = lane & 31;
  s16x8 bq[8];
#pragma unroll
  for (int k = 0; k < 8; ++k) bq[k] = *(const s16x8*)(qrow + 16 * k + 8 * hh);
#pragma unroll
  for (int j = 0; j < 16; ++j) V[j] = -3.0e38f;
#pragma unroll
  for (int a = 0; a < 4; ++a) {
    f32x16 acc;
#pragma unroll
    for (int i = 0; i < 16; ++i) acc[i] = 0.f;
#pragma unroll
    for (int k = 0; k < 8; ++k) { const s16x8 af = *(const LAS s16x8*)(ks + (32 * a + r) * SEL_KSTR + (16 * k + 8 * hh) * 2); acc = MFMA32(af, bq[k], acc); }
#pragma unroll
    for (int i = 0; i < 16; ++i) { const int n = 32 * a + (i & 3) + 8 * (i >> 2) + 4 * hh; const float key = __uint_as_float((__float_as_uint(acc[i]) & 0xFFFFFF80u) | (unsigned)n); INSERT16(V, key); }
  }
  MERGE16(V);
}
__device__ __forceinline__ void phase_select(const Params& p, unsigned char* smem) {
  const int tid = threadIdx.x, lane = tid & 63, w = tid >> 6, hh = lane >> 5;
  LAS unsigned char* lds = (LAS unsigned char*)smem;
  LAS unsigned char* k1s = lds; LAS unsigned char* k2s = lds + 128 * SEL_KSTR; LAS unsigned* scr = (LAS unsigned*)(lds + 2 * 128 * SEL_KSTR + w * 4096);
  const u16* K1 = (const u16*)(p.ws + WS_K1); const u16* K2 = (const u16*)(p.ws + WS_K2); const u16* Q = (const u16*)(p.ws + WS_Q);
  u16* IDX = (u16*)(p.ws + WS_IDX); float* GW = (float*)(p.ws + WS_G);
  for (int c = tid; c < 2048; c += 512) { const int n = c >> 4, ch = c & 15;
    *(LAS u32x4*)(k1s + n * SEL_KSTR + ch * 16) = *(const u32x4*)(K1 + n * 128 + ch * 8); *(LAS u32x4*)(k2s + n * SEL_KSTR + ch * 16) = *(const u32x4*)(K2 + n * 128 + ch * 8); }
  __syncthreads();
  for (int wi = blockIdx.x * 8 + w; wi < 4096; wi += gridDim.x * 8) {
    const int tb = wi >> 3, h = wi & 7, t = tb * 32 + (lane & 31);
    const u16* qrow = Q + (size_t)t * 2048 + h * 256;
    float v1[16], v2[16];
    select_side(qrow, k1s, lane, v1);
    select_side(qrow + 128, k2s, lane, v2);
    if (hh == 0) {
#pragma unroll
      for (int i = 0; i < 16; ++i) { scr[(lane & 31) * 32 + i] = __float_as_uint(v1[i]); scr[(lane & 31) * 32 + 16 + i] = __float_as_uint(v2[i]); } }
    float c[16];
#pragma unroll
    for (int j = 0; j < 16; ++j) c[j] = -3.0e38f;
    { int ci = 0; float pend = 0.f; unsigned pcode = 0;
#pragma unroll
      for (int a = 0; a < 16; ++a)
#pragma unroll
        for (int bb = 0; bb < 16; ++bb) if ((a + 1) * (bb + 1) <= 16) {
          const float s = v1[a] + v2[bb]; const unsigned code = (unsigned)(a * 16 + bb);
          if ((ci & 1) == 0) { pend = s; pcode = code; }
          else { const float x = hh ? s : pend; const unsigned cd = hh ? code : pcode; INSERT16(c, __uint_as_float((__float_as_uint(x) & 0xFFFFFF00u) | cd)); }
          ++ci; }
    }
    MERGE16(c);
    float sum = 0.f, e[16];
#pragma unroll
    for (int j = 0; j < 16; ++j) { e[j] = __expf(c[j] - c[0]); sum += e[j]; }
    const float inv = 1.0f / sum;
    unsigned ids[8]; float gs[8];
#pragma unroll
    for (int j = 0; j < 8; ++j) { float cl = c[j], ch = c[8 + j], el = e[j], eh = e[8 + j]; asm volatile("" : "+v"(cl), "+v"(ch), "+v"(el), "+v"(eh));
      const float cj = hh ? ch : cl; const unsigned code = __float_as_uint(cj) & 0xFFu; gs[j] = (hh ? eh : el) * inv;
      const unsigned k1 = scr[(lane & 31) * 32 + (code >> 4)], k2 = scr[(lane & 31) * 32 + 16 + (code & 15)]; ids[j] = (k1 & 127u) * 128u + (k2 & 127u); }
    u32x4 iw; iw.x = ids[0] | (ids[1] << 16); iw.y = ids[2] | (ids[3] << 16); iw.z = ids[4] | (ids[5] << 16); iw.w = ids[6] | (ids[7] << 16);
    *(u32x4*)(IDX + (size_t)t * 128 + h * 16 + 8 * hh) = iw;
    float* gp = GW + (size_t)t * 128 + h * 16 + 8 * hh; *(f32x4*)gp = (f32x4){gs[0], gs[1], gs[2], gs[3]}; *(f32x4*)(gp + 4) = (f32x4){gs[4], gs[5], gs[6], gs[7]};
  }
}

__device__ __forceinline__ float gelu_tanh_f(float x) { const float u = 0.7978845608028654f * (x + 0.044715f * x * x * x); const float e = __expf(2.0f * u); return x * (1.0f - 1.0f / (e + 1.0f)); }
__device__ __forceinline__ void phase_gather(const Params& p) {
  const int tid = threadIdx.x, lane = tid & 63, w = tid >> 6;
  const u16* X1H = (const u16*)(p.ws + WS_X1H); const u16* IDX = (const u16*)(p.ws + WS_IDX); const float* GW = (const float*)(p.ws + WS_G);
  const u16* U16 = (const u16*)(p.ws + WS_U16); const u16* V16 = (const u16*)(p.ws + WS_V16); const float* SSQ = (const float*)(p.ws + WS_SSQ);
  for (int t = blockIdx.x * 8 + w; t < S_; t += gridDim.x * 8) {
    const u32x4 xa = *(const u32x4*)(X1H + (size_t)t * D_ + 8 * lane), xb = *(const u32x4*)(X1H + (size_t)t * D_ + 512 + 8 * lane);
    const unsigned idp = *(const unsigned*)(IDX + (size_t)t * 128 + 2 * lane);
    const f32x2 gp = *(const f32x2*)(GW + (size_t)t * 128 + 2 * lane);
    const float rstd = rsqrtf(SSQ[t] * (1.0f / D_) + 1e-6f);
    float h0 = 0.f, h1 = 0.f;
#pragma unroll 4
    for (int pr = 0; pr < 128; ++pr) {
      const unsigned ew = __builtin_amdgcn_readlane(idp, pr >> 1); const unsigned e = (pr & 1) ? (ew >> 16) : (ew & 0xFFFFu);
      const u16* up = U16 + (size_t)e * D_ + 8 * lane;
      const u32x4 ua = *(const u32x4*)up, ub = *(const u32x4*)(up + 512);
      float s = 0.f;
      { const unsigned uu[8] = {ua.x, ua.y, ua.z, ua.w, ub.x, ub.y, ub.z, ub.w}; const unsigned xx[8] = {xa.x, xa.y, xa.z, xa.w, xb.x, xb.y, xb.z, xb.w};
#pragma unroll
        for (int i = 0; i < 8; ++i) { const unsigned ui = uu[i], xi = xx[i]; s = __builtin_amdgcn_fdot2(__builtin_bit_cast(h16x2, ui), __builtin_bit_cast(h16x2, xi), s, false); } }
#pragma unroll
      for (int o = 32; o > 0; o >>= 1) s += __shfl_xor(s, o);
      if ((pr >> 1) == lane) { if (pr & 1) h1 = s; else h0 = s; }
    }
    const float a0 = gelu_tanh_f(h0 * rstd) * gp.x, a1 = gelu_tanh_f(h1 * rstd) * gp.y;
    float acc[16];
#pragma unroll
    for (int i = 0; i < 16; ++i) acc[i] = 0.f;
#pragma unroll 4
    for (int pr = 0; pr < 128; ++pr) {
      const unsigned ew = __builtin_amdgcn_readlane(idp, pr >> 1); const unsigned e = (pr & 1) ? (ew >> 16) : (ew & 0xFFFFu);
      const float a = __uint_as_float(__builtin_amdgcn_readlane((pr & 1) ? __float_as_uint(a1) : __float_as_uint(a0), pr >> 1));
      const u16* vp = V16 + (size_t)e * D_ + 8 * lane;
      const u32x4 va = *(const u32x4*)vp, vb = *(const u32x4*)(vp + 512);
      const unsigned wv[8] = {va.x, va.y, va.z, va.w, vb.x, vb.y, vb.z, vb.w};
#pragma unroll
      for (int i = 0; i < 8; ++i) { const h16x2 hv = __builtin_bit_cast(h16x2, wv[i]); acc[2 * i] = fmaf((float)hv.x, a, acc[2 * i]); acc[2 * i + 1] = fmaf((float)hv.y, a, acc[2 * i + 1]); }
    }
    float* op = p.out + (size_t)t * D_ + 8 * lane;
    f32x4 o0 = *(f32x4*)op, o1 = *(f32x4*)(op + 4), o2 = *(f32x4*)(op + 512), o3 = *(f32x4*)(op + 516);
    o0 += (f32x4){acc[0], acc[1], acc[2], acc[3]}; o1 += (f32x4){acc[4], acc[5], acc[6], acc[7]}; o2 += (f32x4){acc[8], acc[9], acc[10], acc[11]}; o3 += (f32x4){acc[12], acc[13], acc[14], acc[15]};
    *(f32x4*)op = o0; *(f32x4*)(op + 4) = o1; *(f32x4*)(op + 512) = o2; *(f32x4*)(op + 516) = o3;
  }
}

#define LDS_BYTES 147456
template <int PH> __global__ __launch_bounds__(512, 2) void k_phase(Params p) {
  extern __shared__ __attribute__((aligned(16))) unsigned char smem[];
  if (PH == 0) phase_prologue(p, smem, (char*)p.out);
  if (PH == 1) phase_conv_tables(p);
  if (PH == 7) phase_select(p, smem);
  if (PH == 8) phase_gather(p);
}
template <int PH> static void launch_phase(const Params& p, hipStream_t stream) {
  (void)hipFuncSetAttribute((const void*)k_phase<PH>, hipFuncAttributeMaxDynamicSharedMemorySize, LDS_BYTES);
  hipLaunchKernelGGL((k_phase<PH>), dim3(256), dim3(512), LDS_BYTES, stream, p);
}

template <bool F16, class Epi> __global__ __launch_bounds__(512, 2) void k_gemm_fast(pg8::Gemm g, Epi E) {
  extern __shared__ __attribute__((aligned(16))) unsigned char shm[];
  pg8::StaticOrder S; S.init(g.M, g.N, (int)gridDim.x, (int)blockIdx.x);
  pg8::gemm_phase<F16, Epi>((PG8_LAS unsigned char*)shm, g, S, E);
}
template <bool F16, class Epi> static void launch_gemm(const u16* A, const u16* Bt, int M, int N, int K, const Epi& E, hipStream_t stream) {
  (void)hipFuncSetAttribute((const void*)k_gemm_fast<F16, Epi>, hipFuncAttributeMaxDynamicSharedMemorySize, pg8::STAGE_BYTES);
  pg8::Gemm g{A, Bt, M, N, K, 0};
  hipLaunchKernelGGL((k_gemm_fast<F16, Epi>), dim3(256), dim3(512), pg8::STAGE_BYTES, stream, g, E);
}

extern "C" void kernel_launch(void* const* d_in, const int* in_sizes, int n_in, void* d_out, int out_size, void* d_ws, size_t ws_size, hipStream_t stream) {
  if (ws_size < WS_NEED) return;
  const float* x = (const float*)d_in[0]; const float* norm_attn = (const float*)d_in[1]; const float* w_in = (const float*)d_in[2];
  const float* ret_q_norm = (const float*)d_in[3]; const float* ret_k_norm = (const float*)d_in[4]; const float* ret_gn = (const float*)d_in[5];
  const float* sb_q_norm = (const float*)d_in[6]; const float* sb_k_norm = (const float*)d_in[7]; const float* w_bra = (const float*)d_in[8];
  const float* w_brb = (const float*)d_in[9]; const float* w_out = (const float*)d_in[10]; const float* norm_ffn = (const float*)d_in[11];
  const float* w_q = (const float*)d_in[12]; const float* sk1 = (const float*)d_in[13]; const float* sk2 = (const float*)d_in[14];
  const float* peer_u = (const float*)d_in[15]; const float* peer_v = (const float*)d_in[16];
  char* ws = (char*)d_ws; char* dob = (char*)d_out; float* out = (float*)d_out;
  u16* XN = (u16*)(dob + DO_XN); u16* WINT = (u16*)(dob + DO_WINT); u16* SB = (u16*)(dob + DO_SB); u16* WBRAT = (u16*)(dob + DO_WBRAT); u16* WBRBT = (u16*)(dob + DO_WBRBT);
  u16* WOUTT = (u16*)(ws + WS_WOUTT); u16* WQT = (u16*)(ws + WS_WQT); u16* K1 = (u16*)(ws + WS_K1); u16* K2 = (u16*)(ws + WS_K2);
  float* RC = (float*)(ws + WS_ROPE_C); float* RS = (float*)(ws + WS_ROPE_S); float* SSQ = (float*)(ws + WS_SSQ);
  u16* RQ = (u16*)(ws + WS_RQ); u16* RK = (u16*)(ws + WS_RK); u16* RV = (u16*)(ws + WS_RV); u16* SQ = (u16*)(ws + WS_SQ); u16* SK = (u16*)(ws + WS_SK);
  u16* SV = (u16*)(ws + WS_SV); u16* RG = (u16*)(ws + WS_RG); u16* GA = (u16*)(ws + WS_GA); u16* GB = (u16*)(ws + WS_GB);
  u16* IDX = (u16*)(ws + WS_IDX); float* GW = (float*)(ws + WS_G);
  u16* U16 = (u16*)(ws + WS_U16); u16* V16 = (u16*)(ws + WS_V16); u16* MIXED = (u16*)(ws + WS_MIXED); u16* X1H = (u16*)(ws + WS_X1H); u16* Q = (u16*)(ws + WS_Q);

  Params P{}; P.x = x; P.norm_attn = norm_attn; P.w_in = w_in; P.ret_q_norm = ret_q_norm; P.ret_k_norm = ret_k_norm; P.ret_gn = ret_gn; P.sb_q_norm = sb_q_norm; P.sb_k_norm = sb_k_norm;
  P.w_bra = w_bra; P.w_brb = w_brb; P.w_out = w_out; P.norm_ffn = norm_ffn; P.w_q = w_q; P.sk1 = sk1; P.sk2 = sk2; P.peer_u = peer_u; P.peer_v = peer_v; P.out = out; P.ws = ws;
  for (int h = 0; h < 8; ++h) P.l2g[h] = (float)log2(1.0 - exp2(-5.0 - (double)h));
  launch_phase<0>(P, stream);
  { FEpiInProj e{RQ, RK, RV, RG, SQ, SK, SV, GA, GB}; launch_gemm<false>(XN, WINT, S_, 6656, 1024, e, stream); }
  k_qknorm<<<S_ * 8 / 256, 256, 0, stream>>>(RQ, ret_q_norm, RC, RS, 0);
  k_qknorm<<<S_ * 8 / 256, 256, 0, stream>>>(RK, ret_k_norm, RC, RS, 1);
  k_qknorm<<<S_ * 8 / 256, 256, 0, stream>>>(SQ, sb_q_norm, RC, RS, 2);
  k_qknorm<<<S_ * 8 / 256, 256, 0, stream>>>(SK, sb_k_norm, RC, RS, 3);
  { RetConst rc; for (int h = 0; h < 8; ++h) rc.l2g[h] = (float)log2(1.0 - exp2(-5.0 - (double)h));
    k_ret_naive<<<dim3(S_ / 64, 8), 256, 0, stream>>>(RQ, RK, RV, RG, ret_gn, rc); }
  k_sb_naive<<<dim3(S_ / 64, 8), 256, 0, stream>>>(SQ, SK, SV, SB);
  launch_phase<1>(P, stream);
  { FEpiMixB e{MIXED, GB}; launch_gemm<false>(SB, WBRBT, S_, 1024, 512, e, stream); }
  { FEpiMixA e{MIXED, GA}; launch_gemm<false>(RG, WBRAT, S_, 1024, 1024, e, stream); }
  { FEpiOut e{x, out, X1H, SSQ}; launch_gemm<false>(MIXED, WOUTT, S_, 1024, 1024, e, stream); }
  { FEpiQ e{SSQ, Q}; launch_gemm<true>(X1H, WQT, S_, 2048, 1024, e, stream); }
  launch_phase<7>(P, stream);
  launch_phase<8>(P, stream);
}
```

```cpp
#include <hip/hip_runtime.h>
#include <stdint.h>

typedef unsigned short u16;
#define S_ 16384
#define D_ 1024
#define MB_ ((size_t)1 << 20)

#define WS_WOUTT (1 * MB_)
#define WS_WQT (3 * MB_)
#define WS_K1 (7 * MB_)
#define WS_K2 (7 * MB_ + 65536)
#define WS_ROPE_C (8 * MB_)
#define WS_ROPE_S (10 * MB_)
#define WS_SSQ (12 * MB_)
#define WS_RQ (16 * MB_)
#define WS_RK (32 * MB_)
#define WS_RV (48 * MB_)
#define WS_SQ (80 * MB_)
#define WS_SK (96 * MB_)
#define WS_SV (112 * MB_)
#define WS_RG (128 * MB_)
#define WS_GA (160 * MB_)
#define WS_GB (192 * MB_)
#define WS_IDX (224 * MB_)
#define WS_G (232 * MB_)
#define WS_NEED (256 * MB_)
#define WS_U16 WS_RQ
#define WS_V16 WS_RV
#define WS_MIXED WS_SQ
#define WS_X1H WS_RG
#define WS_Q WS_GA
#define DO_XN (0 * MB_)
#define DO_WINT (32 * MB_)
#define DO_SB (32 * MB_)
#define DO_WBRAT (60 * MB_)
#define DO_WBRBT (62 * MB_)

__device__ __forceinline__ u16 f2bf(float f) { unsigned u = __float_as_uint(f); u += 0x7FFFu + ((u >> 16) & 1u); return (u16)(u >> 16); }
__device__ __forceinline__ float bf2f(u16 b) { return __uint_as_float(((unsigned)b) << 16); }
__device__ __forceinline__ u16 f2h(float f) { _Float16 h = (_Float16)f; return *(u16*)&h; }
__device__ __forceinline__ float h2f(u16 b) { _Float16 h = *(_Float16*)&b; return (float)h; }
template <bool F16> __device__ __forceinline__ float ld16(const u16* p) { return F16 ? h2f(*p) : bf2f(*p); }
__device__ __forceinline__ float sigmoidf_(float x) { return 1.0f / (1.0f + __expf(-x)); }

__global__ void k_rms_x(const float* __restrict__ x, const float* __restrict__ g, u16* __restrict__ xn) {
  __shared__ float red[4];
  const int t = blockIdx.x, tid = threadIdx.x;
  const float4 v = ((const float4*)(x + (size_t)t * D_))[tid];
  float s = v.x * v.x + v.y * v.y + v.z * v.z + v.w * v.w;
  for (int o = 32; o > 0; o >>= 1) s += __shfl_xor(s, o);
  if ((tid & 63) == 0) red[tid >> 6] = s;
  __syncthreads();
  s = red[0] + red[1] + red[2] + red[3];
  const float r = rsqrtf(s * (1.0f / D_) + 1e-6f);
  const float4 gg = ((const float4*)g)[tid];
  u16* o = xn + (size_t)t * D_ + tid * 4;
  o[0] = f2bf(v.x * r * gg.x); o[1] = f2bf(v.y * r * gg.y); o[2] = f2bf(v.z * r * gg.z); o[3] = f2bf(v.w * r * gg.w);
}

template <bool F16> __global__ void k_transpose(const float* __restrict__ W, u16* __restrict__ Wt, int K, int N, const float* __restrict__ scale) {
  __shared__ float tile[32][33];
  const int k0 = blockIdx.y * 32, n0 = blockIdx.x * 32, tx = threadIdx.x & 31, ty = threadIdx.x >> 5;
  for (int i = ty; i < 32; i += 8) { const int k = k0 + i; tile[i][tx] = W[(size_t)k * N + n0 + tx] * (scale ? scale[k] : 1.0f); }
  __syncthreads();
  for (int i = ty; i < 32; i += 8) { const float v = tile[tx][i]; Wt[(size_t)(n0 + i) * K + k0 + tx] = F16 ? f2h(v) : f2bf(v); }
}
__global__ void k_conv_bf16(const float* __restrict__ a, u16* __restrict__ o, int n) { const int i = blockIdx.x * blockDim.x + threadIdx.x; if (i < n) o[i] = f2bf(a[i]); }
__global__ void k_conv_table(const float* __restrict__ a, u16* __restrict__ o, const float* __restrict__ colscale) {
  const size_t i = ((size_t)blockIdx.x * blockDim.x + threadIdx.x) * 4;
  const float4 v = *(const float4*)(a + i);
  float4 s = make_float4(1.f, 1.f, 1.f, 1.f);
  if (colscale) s = *(const float4*)(colscale + (i & (D_ - 1)));
  o[i] = f2h(v.x * s.x); o[i + 1] = f2h(v.y * s.y); o[i + 2] = f2h(v.z * s.z); o[i + 3] = f2h(v.w * s.w);
}
__global__ void k_rope_table(float* __restrict__ c, float* __restrict__ s) {
  const int i = blockIdx.x * blockDim.x + threadIdx.x;
  const int t = i >> 5, f = i & 31;
  const float freq = powf(10000.0f, -(float)f / 32.0f);
  const float ang = (float)t * freq;
  float sn, cs; sincosf(ang, &sn, &cs);
  c[i] = cs; s[i] = sn;
}

template <bool F16, class Epi> __global__ void __launch_bounds__(256) k_gemm_naive(const u16* __restrict__ A, const u16* __restrict__ Bt, int M, int N, int K, Epi E) {
  __shared__ float As[64][33], Bs[64][33];
  const int tid = threadIdx.x, tx = tid & 15, ty = tid >> 4, m0 = blockIdx.y * 64, n0 = blockIdx.x * 64;
  float acc[4][4];
#pragma unroll
  for (int i = 0; i < 4; ++i)
#pragma unroll
    for (int j = 0; j < 4; ++j) acc[i][j] = 0.f;
  const int lr = tid >> 2, lc = (tid & 3) * 8;
  for (int k0 = 0; k0 < K; k0 += 32) {
    const u16* ap = A + (size_t)(m0 + lr) * K + k0 + lc; const u16* bp = Bt + (size_t)(n0 + lr) * K + k0 + lc;
#pragma unroll
    for (int j = 0; j < 8; ++j) { As[lr][lc + j] = ld16<F16>(ap + j); Bs[lr][lc + j] = ld16<F16>(bp + j); }
    __syncthreads();
#pragma unroll 8
    for (int k = 0; k < 32; ++k) {
      float a[4], b[4];
#pragma unroll
      for (int i = 0; i < 4; ++i) { a[i] = As[ty * 4 + i][k]; b[i] = Bs[tx * 4 + i][k]; }
#pragma unroll
      for (int i = 0; i < 4; ++i)
#pragma unroll
        for (int j = 0; j < 4; ++j) acc[i][j] += a[i] * b[j];
    }
    __syncthreads();
  }
#pragma unroll
  for (int i = 0; i < 4; ++i)
#pragma unroll
    for (int j = 0; j < 4; ++j) E(m0 + ty * 4 + i, n0 + tx * 4 + j, acc[i][j]);
}
struct EpiInProj {
  u16 *rq, *rk, *rv, *rg, *sq, *sk, *sv, *ga, *gb;
  __device__ void operator()(int r, int c, float v) const {
    u16* b; int ld, c0;
    if (c < 512) { b = rq; ld = 512; c0 = 0; } else if (c < 1024) { b = rk; ld = 512; c0 = 512; } else if (c < 2048) { b = rv; ld = 1024; c0 = 1024; }
    else if (c < 3072) { b = rg; ld = 1024; c0 = 2048; } else if (c < 3584) { b = sq; ld = 512; c0 = 3072; } else if (c < 4096) { b = sk; ld = 512; c0 = 3584; }
    else if (c < 4608) { b = sv; ld = 512; c0 = 4096; } else if (c < 5632) { b = ga; ld = 1024; c0 = 4608; } else { b = gb; ld = 1024; c0 = 5632; }
    b[(size_t)r * ld + (c - c0)] = f2bf(v);
  }
};
struct EpiMixB { u16* mixed; const u16* gb; __device__ void operator()(int r, int c, float v) const { const size_t i = (size_t)r * D_ + c; mixed[i] = f2bf(sigmoidf_(bf2f(gb[i])) * v); } };
struct EpiMixA { u16* mixed; const u16* ga; __device__ void operator()(int r, int c, float v) const { const size_t i = (size_t)r * D_ + c; mixed[i] = f2bf(bf2f(mixed[i]) + sigmoidf_(bf2f(ga[i])) * v); } };
struct EpiOut { const float* x; float* x1; u16* x1h; __device__ void operator()(int r, int c, float v) const { const size_t i = (size_t)r * D_ + c; const float o = x[i] + v; x1[i] = o; x1h[i] = f2h(o); } };
struct EpiQ { const float* ssq; u16* q; __device__ void operator()(int r, int c, float v) const { const float rstd = rsqrtf(ssq[r] * (1.0f / D_) + 1e-6f); q[(size_t)r * 2048 + c] = f2bf(v * rstd); } };

__global__ void k_rowssq(const float* __restrict__ x1, float* __restrict__ ssq) {
  __shared__ float red[4];
  const int t = blockIdx.x, tid = threadIdx.x;
  const float4 v = ((const float4*)(x1 + (size_t)t * D_))[tid];
  float s = v.x * v.x + v.y * v.y + v.z * v.z + v.w * v.w;
  for (int o = 32; o > 0; o >>= 1) s += __shfl_xor(s, o);
  if ((tid & 63) == 0) red[tid >> 6] = s;
  __syncthreads();
  if (tid == 0) ssq[t] = red[0] + red[1] + red[2] + red[3];
}

__global__ void k_qknorm(u16* __restrict__ buf, const float* __restrict__ gain, const float* __restrict__ rc, const float* __restrict__ rs, int which) {
  const int i = blockIdx.x * blockDim.x + threadIdx.x;
  const int t = i >> 3, h = i & 7;
  u16* p = buf + (size_t)t * 512 + h * 64;
  float v[64]; float ss = 0.f;
#pragma unroll
  for (int d = 0; d < 64; ++d) { v[d] = bf2f(p[d]); ss += v[d] * v[d]; }
  const float r = rsqrtf(ss * (1.0f / 64.0f) + 1e-6f);
#pragma unroll
  for (int d = 0; d < 64; ++d) v[d] = v[d] * r * gain[d];
  if (which < 2) {
    const float sc = which == 1 ? 0.125f : 1.0f;
#pragma unroll
    for (int d = 0; d < 32; ++d) {
      const float c = rc[t * 32 + d], s = rs[t * 32 + d];
      const float a = v[d], b = v[d + 32];
      v[d] = (a * c - b * s) * sc; v[d + 32] = (a * s + b * c) * sc;
    }
  }
#pragma unroll
  for (int d = 0; d < 64; ++d) p[d] = f2bf(v[d]);
}

struct RetConst { float l2g[8]; };
__global__ void __launch_bounds__(256) k_ret_naive(const u16* __restrict__ rq, const u16* __restrict__ rk, const u16* __restrict__ rv, u16* __restrict__ rg,
                                                   const float* __restrict__ gn, RetConst rc) {
  __shared__ float red[64][4][2];
  const int h = blockIdx.y, t0 = blockIdx.x * 64, tid = threadIdx.x, tl = tid & 63, eq = tid >> 6, t = t0 + tl;
  float q[64], acc[32];
#pragma unroll
  for (int d = 0; d < 64; ++d) q[d] = bf2f(rq[(size_t)t * 512 + h * 64 + d]);
#pragma unroll
  for (int e = 0; e < 32; ++e) acc[e] = 0.f;
  const float l2g = rc.l2g[h];
  for (int s = 0; s <= t0 + 63; ++s) {
    const u16* kp = rk + (size_t)s * 512 + h * 64;
    float sc = 0.f;
#pragma unroll
    for (int d = 0; d < 64; ++d) sc += q[d] * bf2f(kp[d]);
    const float w = (s <= t) ? sc * exp2f((float)(t - s) * l2g) : 0.f;
    const u16* vp = rv + (size_t)s * 1024 + h * 128 + eq * 32;
#pragma unroll
    for (int e = 0; e < 32; ++e) acc[e] += w * bf2f(vp[e]);
  }
  float s1 = 0.f;
#pragma unroll
  for (int e = 0; e < 32; ++e) s1 += acc[e];
  red[tl][eq][0] = s1;
  __syncthreads();
  const float mu = (red[tl][0][0] + red[tl][1][0] + red[tl][2][0] + red[tl][3][0]) * (1.0f / 128.0f);
  float s2 = 0.f;
#pragma unroll
  for (int e = 0; e < 32; ++e) { const float d = acc[e] - mu; s2 += d * d; }
  red[tl][eq][1] = s2;
  __syncthreads();
  const float var = (red[tl][0][1] + red[tl][1][1] + red[tl][2][1] + red[tl][3][1]) * (1.0f / 128.0f);
  const float rstd = rsqrtf(var + 1e-6f);
  u16* gp = rg + (size_t)t * 1024 + h * 128 + eq * 32;
#pragma unroll
  for (int e = 0; e < 32; ++e) {
    const float g = bf2f(gp[e]);
    const float y = (acc[e] - mu) * rstd * gn[h * 128 + eq * 32 + e];
    gp[e] = f2bf(y * g * sigmoidf_(g));
  }
}

__global__ void __launch_bounds__(256) k_sb_naive(const u16* __restrict__ sq, const u16* __restrict__ sk, const u16* __restrict__ sv, u16* __restrict__ sb) {
  const int h = blockIdx.y, t0 = blockIdx.x * 64, tid = threadIdx.x, tl = tid & 63, eq = tid >> 6, t = t0 + tl;
  float q[64], acc[16];
#pragma unroll
  for (int d = 0; d < 64; ++d) q[d] = bf2f(sq[(size_t)t * 512 + h * 64 + d]);
#pragma unroll
  for (int e = 0; e < 16; ++e) acc[e] = 0.f;
  float later = 0.f;
  for (int s = t0 + 62; s >= 0; --s) {
    if (s < t0 && __all(later < -104.0f)) break;
    const u16* kp = sk + (size_t)s * 512 + h * 64;
    float z = 0.f;
#pragma unroll
    for (int d = 0; d < 64; ++d) z += q[d] * bf2f(kp[d]);
    z *= 0.125f;
    if (s < t) {
      const float sp = fmaxf(z, 0.f) + log1pf(__expf(-fabsf(z)));
      const float w = __expf((z - sp) + later);
      const u16* vp = sv + (size_t)s * 512 + h * 64 + eq * 16;
#pragma unroll
      for (int e = 0; e < 16; ++e) acc[e] += w * bf2f(vp[e]);
      later -= sp;
    }
  }
  u16* op = sb + (size_t)t * 512 + h * 64 + eq * 16;
#pragma unroll
  for (int e = 0; e < 16; ++e) op[e] = f2bf(acc[e]);
}

#define INS16(V, I, x, id) do { float _x = (x); int _i = (id); \
  _Pragma("unroll") for (int _j = 15; _j >= 1; --_j) { const bool _a = _x > V[_j - 1], _b = _x > V[_j]; \
    const float nv = _a ? V[_j - 1] : (_b ? _x : V[_j]); const int ni = _a ? I[_j - 1] : (_b ? _i : I[_j]); V[_j] = nv; I[_j] = ni; } \
  if (_x > V[0]) { V[0] = _x; I[0] = _i; } } while (0)
__global__ void __launch_bounds__(64) k_select_naive(const u16* __restrict__ q, const u16* __restrict__ k1, const u16* __restrict__ k2, u16* __restrict__ idx, float* __restrict__ gw) {
  __shared__ u16 ks[2][128 * 128];
  for (int i = threadIdx.x; i < 128 * 128; i += 64) { ks[0][i] = k1[i]; ks[1][i] = k2[i]; }
  __syncthreads();
  const int i = blockIdx.x * 64 + threadIdx.x, t = i >> 3, h = i & 7;
  float v1[16], v2[16]; int i1[16], i2[16];
#pragma unroll
  for (int j = 0; j < 16; ++j) { v1[j] = -3.0e38f; v2[j] = -3.0e38f; i1[j] = 0; i2[j] = 0; }
  const u16* qp = q + (size_t)t * 2048 + h * 256;
  for (int n = 0; n < 128; ++n) {
    float s = 0.f;
    for (int d = 0; d < 128; ++d) s += bf2f(qp[d]) * bf2f(ks[0][n * 128 + d]);
    INS16(v1, i1, s, n);
  }
  for (int n = 0; n < 128; ++n) {
    float s = 0.f;
    for (int d = 0; d < 128; ++d) s += bf2f(qp[128 + d]) * bf2f(ks[1][n * 128 + d]);
    INS16(v2, i2, s, n);
  }
  float tv[16]; int ti[16];
#pragma unroll
  for (int j = 0; j < 16; ++j) { tv[j] = -3.0e38f; ti[j] = 0; }
#pragma unroll
  for (int a = 0; a < 16; ++a)
#pragma unroll
    for (int b = 0; b < 16; ++b)
      if ((a + 1) * (b + 1) <= 16) INS16(tv, ti, v1[a] + v2[b], i1[a] * 128 + i2[b]);
  float sum = 0.f, e[16];
#pragma unroll
  for (int j = 0; j < 16; ++j) { e[j] = __expf(tv[j] - tv[0]); sum += e[j]; }
  const float inv = 1.0f / sum;
#pragma unroll
  for (int j = 0; j < 16; ++j) { idx[(size_t)t * 128 + h * 16 + j] = (u16)ti[j]; gw[(size_t)t * 128 + h * 16 + j] = e[j] * inv; }
}

__device__ __forceinline__ float gelu_tanh(float x) { const float u = 0.7978845608028654f * (x + 0.044715f * x * x * x); return 0.5f * x * (1.0f + tanhf(u)); }
__global__ void __launch_bounds__(256) k_gather_naive(const u16* __restrict__ x1h, const float* __restrict__ ssq, const u16* __restrict__ idx, const float* __restrict__ gw,
                                                      const u16* __restrict__ u16t, const u16* __restrict__ v16t, float* __restrict__ out) {
  __shared__ float a_s[128]; __shared__ int e_s[128];
  const int t = blockIdx.x, tid = threadIdx.x, lane = tid & 63, w = tid >> 6;
  if (tid < 128) e_s[tid] = idx[(size_t)t * 128 + tid];
  __syncthreads();
  float xr[16];
#pragma unroll
  for (int j = 0; j < 16; ++j) xr[j] = h2f(x1h[(size_t)t * D_ + lane * 16 + j]);
  const float rstd = rsqrtf(ssq[t] * (1.0f / D_) + 1e-6f);
  for (int p = w; p < 128; p += 4) {
    const u16* up = u16t + (size_t)e_s[p] * D_ + lane * 16;
    float s = 0.f;
#pragma unroll
    for (int j = 0; j < 16; ++j) s += xr[j] * h2f(up[j]);
    for (int o = 32; o > 0; o >>= 1) s += __shfl_xor(s, o);
    if (lane == 0) a_s[p] = gelu_tanh(s * rstd) * gw[(size_t)t * 128 + p];
  }
  __syncthreads();
  float acc[4] = {0.f, 0.f, 0.f, 0.f};
  for (int p = 0; p < 128; ++p) {
    const u16* vp = v16t + (size_t)e_s[p] * D_ + tid * 4;
    const float a = a_s[p];
#pragma unroll
    for (int j = 0; j < 4; ++j) acc[j] += a * h2f(vp[j]);
  }
  float* op = out + (size_t)t * D_ + tid * 4;
#pragma unroll
  for (int j = 0; j < 4; ++j) op[j] += acc[j];
}


namespace pg8 {
#define PG8_LAS __attribute__((address_space(3)))
typedef short bf16x8 __attribute__((ext_vector_type(8)));
typedef _Float16 f16x8 __attribute__((ext_vector_type(8)));
typedef float f32x4 __attribute__((ext_vector_type(4)));
typedef unsigned u32x4 __attribute__((ext_vector_type(4)));
constexpr int BM = 256, BK = 64, HALF = 128, HTB = HALF * BK * 2, STAGE_BYTES = 8 * HTB, NXCD = 8, WGM = 8;
__host__ __device__ __forceinline__ int lds_byte(int r, int c) { const int st = (r >> 4) * 2 + (c >> 5), rr = r & 15, cc = c & 31, ob = rr * 64 + cc * 2; return st * 1024 + (ob ^ (((ob >> 9) & 1) << 5)); }
__host__ __device__ __forceinline__ void stage_rc(int b, int& R, int& C) { const int st = b / 1024, sb = b % 1024, swz = sb ^ (((sb >> 9) & 1) << 5); R = (st >> 1) * 16 + swz / 64; C = (st & 1) * 32 + (swz % 64) / 2; }
__host__ __device__ __forceinline__ int perm32(int rho) { const int n = rho >> 4, i = rho & 15; return 8 * (i >> 2) + 4 * n + (i & 3); }
struct Unit { int pm, pn; };
struct Gemm { const u16* A; const u16* Bt; int M, N, K, pad; };
struct StaticOrder {
  int nM, nN, nwg, G, c;
  __host__ __device__ void init(int M, int N, int G_, int c_) { nM = M / BM; nN = N / BM; nwg = nM * nN; G = G_; c = c_; }
  __host__ __device__ bool next(int i, Unit& u) const {
    const long L = (long)i * G + c; if (L >= nwg) return false;
    int wgid = (int)L; { const int q = nwg / NXCD, r = nwg % NXCD, xcd = wgid % NXCD, off = wgid / NXCD; wgid = (xcd < r ? xcd * (q + 1) : r * (q + 1) + (xcd - r) * q) + off; }
    const int nig = WGM * nN, gid = wgid / nig, fm = gid * WGM, gsz = (nM - fm) < WGM ? (nM - fm) : WGM;
    u.pm = fm + ((wgid % nig) % gsz); u.pn = (wgid % nig) / gsz; return true;
  }
};
__device__ __forceinline__ unsigned cvt_pk_bf16(float lo, float hi) { unsigned r; asm volatile("v_cvt_pk_bf16_f32 %0, %1, %2" : "=v"(r) : "v"(lo), "v"(hi)); return r; }
__device__ __forceinline__ unsigned cvt_pk_f16(float lo, float hi) { typedef _Float16 h2 __attribute__((ext_vector_type(2))); h2 v; v.x = (_Float16)lo; v.y = (_Float16)hi; return __builtin_bit_cast(unsigned, v); }

template <bool F16, class Epi>
__device__ __forceinline__ void gemm_phase(PG8_LAS unsigned char* lds, const Gemm g, const StaticOrder& S, const Epi& E) {
  const int tid = threadIdx.x, wid = __builtin_amdgcn_readfirstlane(tid >> 6), lane = tid & 63, wr = wid >> 2, wc = wid & 3, fr = lane & 15, fq = lane >> 4;
  const int K = g.K, nt = K / BK;
  unsigned voffA[2], voffB[2];
#pragma unroll
  for (int i = 0; i < 2; ++i) { int R, C; stage_rc(tid * 16 + i * 8192, R, C); const int Rb = ((R & ~31) + perm32(R & 31));
    voffA[i] = (unsigned)(R * K + C) * 2u; voffB[i] = (unsigned)(Rb * K + C) * 2u; }
  const size_t kstep = (size_t)(BK * 2);
  const size_t hstep = (size_t)HALF * K * 2;
  const size_t tstep = 2 * hstep;
  const unsigned ldsw = (unsigned)wid * 1024u;
  const int aoff = lds_byte(wr * 64 + fr, fq * 8), boff = lds_byte(wc * 32 + fr, fq * 8);
#define PG8_SA(b, h) (((b) * 2 + (h)) * HTB)
#define PG8_SB(b, h) ((4 + (b) * 2 + (h)) * HTB)
#define PG8_STAGE(bufoff, gbase, voff) do { _Pragma("unroll") for (int _i = 0; _i < 2; ++_i) \
    __builtin_amdgcn_global_load_lds((const unsigned*)((const char*)(gbase) + (voff)[_i]), (PG8_LAS unsigned*)(lds + (bufoff) + ldsw + _i * 8192), 16, 0, 0); } while (0)
#define PG8_LDA(dst, b, h) do { _Pragma("unroll") for (int m = 0; m < 4; ++m) _Pragma("unroll") for (int k = 0; k < 2; ++k) dst[m][k] = *(const PG8_LAS bf16x8*)(lds + PG8_SA(b, h) + aoff + m * 2048 + k * 1024); } while (0)
#define PG8_LDB(dst, b, h) do { _Pragma("unroll") for (int n = 0; n < 2; ++n) _Pragma("unroll") for (int k = 0; k < 2; ++k) dst[n][k] = *(const PG8_LAS bf16x8*)(lds + PG8_SB(b, h) + boff + n * 2048 + k * 1024); } while (0)
#define PG8_MMA(ai, bj, At, Bt) do { __builtin_amdgcn_s_setprio(1); _Pragma("unroll") for (int m = 0; m < 4; ++m) _Pragma("unroll") for (int n = 0; n < 2; ++n) _Pragma("unroll") for (int k = 0; k < 2; ++k) { \
    if constexpr (F16) acc[ai][bj][m][n] = __builtin_amdgcn_mfma_f32_16x16x32_f16(__builtin_bit_cast(f16x8, Bt[n][k]), __builtin_bit_cast(f16x8, At[m][k]), acc[ai][bj][m][n], 0, 0, 0); \
    else acc[ai][bj][m][n] = __builtin_amdgcn_mfma_f32_16x16x32_bf16(Bt[n][k], At[m][k], acc[ai][bj][m][n], 0, 0, 0); } __builtin_amdgcn_s_setprio(0); } while (0)
#define PG8_WAIT_V(n) asm volatile("s_waitcnt vmcnt(" #n ")" ::: "memory")
#define PG8_WAIT_L(n) asm volatile("s_waitcnt lgkmcnt(" #n ")" ::: "memory")
#define PG8_BAR __builtin_amdgcn_s_barrier()
#define PG8_SCHED __builtin_amdgcn_sched_barrier(0)
  Unit cur, nxt; int ui = 0;
  if (!S.next(0, cur)) return;
  f32x4 acc[2][2][4][2];
#pragma unroll
  for (int a = 0; a < 2; ++a)
#pragma unroll
    for (int b = 0; b < 2; ++b)
#pragma unroll
      for (int m = 0; m < 4; ++m)
#pragma unroll
        for (int n = 0; n < 2; ++n) acc[a][b][m][n] = (f32x4){0.f, 0.f, 0.f, 0.f};
  bf16x8 At[4][2], B0[2][2], B1[2][2];
  const char* cA = (const char*)g.A + (size_t)cur.pm * tstep; const char* cB = (const char*)g.Bt + (size_t)cur.pn * tstep;
  PG8_STAGE(PG8_SB(0, 0), cB, voffB); PG8_STAGE(PG8_SA(0, 0), cA, voffA); PG8_STAGE(PG8_SB(0, 1), cB + hstep, voffB); PG8_STAGE(PG8_SA(0, 1), cA + hstep, voffA);
  if (wr == 1) PG8_BAR;
  PG8_WAIT_V(4); PG8_BAR;
  PG8_STAGE(PG8_SB(1, 0), cB + kstep, voffB); PG8_STAGE(PG8_SA(1, 0), cA + kstep, voffA); PG8_STAGE(PG8_SB(1, 1), cB + hstep + kstep, voffB);
  PG8_WAIT_V(6); PG8_BAR;
  for (;;) {
    const bool has_next = S.next(ui + 1, nxt);
    const char* nA = has_next ? (const char*)g.A + (size_t)nxt.pm * tstep : cA; const char* nB = has_next ? (const char*)g.Bt + (size_t)nxt.pn * tstep : cB;
    for (int t = 0; t < nt; t += 2) {
      const bool last = (t == nt - 2);
      const char* a1 = cA + (size_t)(t + 1) * kstep;
      const char* a2 = last ? nA : cA + (size_t)(t + 2) * kstep; const char* b2 = last ? nB : cB + (size_t)(t + 2) * kstep;
      const char* a3 = a2 + kstep; const char* b3 = b2 + kstep;
      PG8_LDB(B0, 0, 0); PG8_SCHED; PG8_LDA(At, 0, 0); PG8_STAGE(PG8_SA(1, 1), a1 + hstep, voffA);
      PG8_WAIT_L(8); PG8_BAR; PG8_WAIT_L(0); PG8_MMA(0, 0, At, B0); PG8_BAR; PG8_SCHED;
      PG8_LDB(B1, 0, 1); PG8_STAGE(PG8_SB(0, 0), b2, voffB);
      PG8_BAR; PG8_WAIT_L(0); PG8_MMA(0, 1, At, B1); PG8_BAR;
      PG8_LDA(At, 0, 1); PG8_STAGE(PG8_SA(0, 0), a2, voffA);
      PG8_BAR; PG8_WAIT_L(0); PG8_MMA(1, 0, At, B0); PG8_BAR; PG8_SCHED;
      PG8_STAGE(PG8_SB(0, 1), b2 + hstep, voffB);
      PG8_WAIT_V(6); PG8_BAR; PG8_MMA(1, 1, At, B1); PG8_BAR;
      PG8_LDB(B0, 1, 0); PG8_SCHED; PG8_LDA(At, 1, 0); PG8_STAGE(PG8_SA(0, 1), a2 + hstep, voffA);
      PG8_WAIT_L(8); PG8_BAR; PG8_WAIT_L(0); PG8_MMA(0, 0, At, B0); PG8_BAR; PG8_SCHED;
      PG8_LDB(B1, 1, 1); PG8_STAGE(PG8_SB(1, 0), b3, voffB);
      PG8_BAR; PG8_WAIT_L(0); PG8_MMA(0, 1, At, B1); PG8_BAR;
      PG8_LDA(At, 1, 1); PG8_STAGE(PG8_SA(1, 0), a3, voffA);
      PG8_BAR; PG8_WAIT_L(0); PG8_MMA(1, 0, At, B0); PG8_BAR; PG8_SCHED;
      PG8_STAGE(PG8_SB(1, 1), b3 + hstep, voffB);
      PG8_WAIT_V(6); PG8_BAR; PG8_MMA(1, 1, At, B1); PG8_BAR;
    }
    E(acc, cur, wr, wc, fr, fq);
    if (!has_next) break;
#pragma unroll
    for (int a = 0; a < 2; ++a)
#pragma unroll
      for (int b = 0; b < 2; ++b)
#pragma unroll
        for (int m = 0; m < 4; ++m)
#pragma unroll
          for (int n = 0; n < 2; ++n) acc[a][b][m][n] = (f32x4){0.f, 0.f, 0.f, 0.f};
    cur = nxt; cA = nA; cB = nB; ++ui;
  }
  PG8_WAIT_V(0);
  if (wr == 0) PG8_BAR;
  PG8_BAR;
#undef PG8_SA
#undef PG8_SB
#undef PG8_STAGE
#undef PG8_LDA
#undef PG8_LDB
#undef PG8_MMA
#undef PG8_WAIT_V
#undef PG8_WAIT_L
#undef PG8_BAR
#undef PG8_SCHED
}
}

typedef pg8::f32x4 f32x4; typedef pg8::u32x4 u32x4;
template <class F> __device__ __forceinline__ void epi_walk(const f32x4 (&acc)[2][2][4][2], const pg8::Unit& u, int wr, int wc, int fr, int fq, F&& f) {
  const int row0 = u.pm * 256 + wr * 64 + fr, col0 = u.pn * 256 + wc * 32 + 8 * fq;
#pragma unroll
  for (int ai = 0; ai < 2; ++ai)
#pragma unroll
    for (int m = 0; m < 4; ++m)
#pragma unroll
      for (int bj = 0; bj < 2; ++bj) f(row0 + ai * 128 + m * 16, col0 + bj * 128, acc[ai][bj][m][0], acc[ai][bj][m][1]);
}
__device__ __forceinline__ u32x4 pack8_bf16(f32x4 v0, f32x4 v1) { u32x4 w; w.x = pg8::cvt_pk_bf16(v0[0], v0[1]); w.y = pg8::cvt_pk_bf16(v0[2], v0[3]); w.z = pg8::cvt_pk_bf16(v1[0], v1[1]); w.w = pg8::cvt_pk_bf16(v1[2], v1[3]); return w; }
__device__ __forceinline__ u32x4 pack8_f16(f32x4 v0, f32x4 v1) { u32x4 w; w.x = pg8::cvt_pk_f16(v0[0], v0[1]); w.y = pg8::cvt_pk_f16(v0[2], v0[3]); w.z = pg8::cvt_pk_f16(v1[0], v1[1]); w.w = pg8::cvt_pk_f16(v1[2], v1[3]); return w; }
__device__ __forceinline__ void unpack8_bf16(u32x4 w, float (&f)[8]) {
  f[0] = __uint_as_float(w.x << 16); f[1] = __uint_as_float(w.x & 0xffff0000u); f[2] = __uint_as_float(w.y << 16); f[3] = __uint_as_float(w.y & 0xffff0000u);
  f[4] = __uint_as_float(w.z << 16); f[5] = __uint_as_float(w.z & 0xffff0000u); f[6] = __uint_as_float(w.w << 16); f[7] = __uint_as_float(w.w & 0xffff0000u); }

struct FEpiInProj {
  u16 *rq, *rk, *rv, *rg, *sq, *sk, *sv, *ga, *gb;
  __device__ __forceinline__ void operator()(const f32x4 (&acc)[2][2][4][2], const pg8::Unit& u, int wr, int wc, int fr, int fq) const {
    const int c = u.pn * 256; u16* b; int ld, c0;
    if (c < 512) { b = rq; ld = 512; c0 = 0; } else if (c < 1024) { b = rk; ld = 512; c0 = 512; } else if (c < 2048) { b = rv; ld = 1024; c0 = 1024; }
    else if (c < 3072) { b = rg; ld = 1024; c0 = 2048; } else if (c < 3584) { b = sq; ld = 512; c0 = 3072; } else if (c < 4096) { b = sk; ld = 512; c0 = 3584; }
    else if (c < 4608) { b = sv; ld = 512; c0 = 4096; } else if (c < 5632) { b = ga; ld = 1024; c0 = 4608; } else { b = gb; ld = 1024; c0 = 5632; }
    epi_walk(acc, u, wr, wc, fr, fq, [&](int row, int col, f32x4 v0, f32x4 v1) { *(u32x4*)(b + (size_t)row * ld + (col - c0)) = pack8_bf16(v0, v1); });
  }
};
struct FEpiMixB { u16* mixed; const u16* gb;
  __device__ __forceinline__ void operator()(const f32x4 (&acc)[2][2][4][2], const pg8::Unit& u, int wr, int wc, int fr, int fq) const {
    epi_walk(acc, u, wr, wc, fr, fq, [&](int row, int col, f32x4 v0, f32x4 v1) { const size_t i = (size_t)row * D_ + col; float g[8]; unpack8_bf16(*(const u32x4*)(gb + i), g); f32x4 a, b2;
      a[0] = sigmoidf_(g[0]) * v0[0]; a[1] = sigmoidf_(g[1]) * v0[1]; a[2] = sigmoidf_(g[2]) * v0[2]; a[3] = sigmoidf_(g[3]) * v0[3];
      b2[0] = sigmoidf_(g[4]) * v1[0]; b2[1] = sigmoidf_(g[5]) * v1[1]; b2[2] = sigmoidf_(g[6]) * v1[2]; b2[3] = sigmoidf_(g[7]) * v1[3];
      *(u32x4*)(mixed + i) = pack8_bf16(a, b2); });
  }
};
struct FEpiMixA { u16* mixed; const u16* ga;
  __device__ __forceinline__ void operator()(const f32x4 (&acc)[2][2][4][2], const pg8::Unit& u, int wr, int wc, int fr, int fq) const {
    epi_walk(acc, u, wr, wc, fr, fq, [&](int row, int col, f32x4 v0, f32x4 v1) { const size_t i = (size_t)row * D_ + col; float g[8], o[8]; unpack8_bf16(*(const u32x4*)(ga + i), g); unpack8_bf16(*(const u32x4*)(mixed + i), o); f32x4 a, b2;
      a[0] = o[0] + sigmoidf_(g[0]) * v0[0]; a[1] = o[1] + sigmoidf_(g[1]) * v0[1]; a[2] = o[2] + sigmoidf_(g[2]) * v0[2]; a[3] = o[3] + sigmoidf_(g[3]) * v0[3];
      b2[0] = o[4] + sigmoidf_(g[4]) * v1[0]; b2[1] = o[5] + sigmoidf_(g[5]) * v1[1]; b2[2] = o[6] + sigmoidf_(g[6]) * v1[2]; b2[3] = o[7] + sigmoidf_(g[7]) * v1[3];
      *(u32x4*)(mixed + i) = pack8_bf16(a, b2); });
  }
};
struct FEpiOut { const float* x; float* x1; u16* x1h; float* ssq;
  __device__ __forceinline__ void operator()(const f32x4 (&acc)[2][2][4][2], const pg8::Unit& u, int wr, int wc, int fr, int fq) const {
    const int row0 = u.pm * 256 + wr * 64 + fr, col0 = u.pn * 256 + wc * 32 + 8 * fq;
#pragma unroll
    for (int ai = 0; ai < 2; ++ai)
#pragma unroll
      for (int m = 0; m < 4; ++m) {
        const int row = row0 + ai * 128 + m * 16; float ss = 0.f;
#pragma unroll
        for (int bj = 0; bj < 2; ++bj) {
          const size_t i = (size_t)row * D_ + col0 + bj * 128;
          f32x4 a = *(const f32x4*)(x + i) + acc[ai][bj][m][0], b2 = *(const f32x4*)(x + i + 4) + acc[ai][bj][m][1];
          *(f32x4*)(x1 + i) = a; *(f32x4*)(x1 + i + 4) = b2; *(u32x4*)(x1h + i) = pack8_f16(a, b2);
          ss += a[0] * a[0] + a[1] * a[1] + a[2] * a[2] + a[3] * a[3] + b2[0] * b2[0] + b2[1] * b2[1] + b2[2] * b2[2] + b2[3] * b2[3];
        }
        ss += __shfl_xor(ss, 16); ss += __shfl_xor(ss, 32);
        if (fq == 0) atomicAdd(ssq + row, ss);
      }
  }
};
struct FEpiQ { const float* ssq; u16* q;
  __device__ __forceinline__ void operator()(const f32x4 (&acc)[2][2][4][2], const pg8::Unit& u, int wr, int wc, int fr, int fq) const {
    epi_walk(acc, u, wr, wc, fr, fq, [&](int row, int col, f32x4 v0, f32x4 v1) { const float rstd = rsqrtf(ssq[row] * (1.0f / D_) + 1e-6f); *(u32x4*)(q + (size_t)row * 2048 + col) = pack8_bf16(v0 * rstd, v1 * rstd); });
  }
};

#define LAS __attribute__((address_space(3)))
typedef short s16x8 __attribute__((ext_vector_type(8)));
typedef short s16x4 __attribute__((ext_vector_type(4)));
typedef float f32x16 __attribute__((ext_vector_type(16)));
typedef float f32x2 __attribute__((ext_vector_type(2)));
typedef __bf16 bf16x2_t __attribute__((ext_vector_type(2)));
typedef _Float16 h16x2 __attribute__((ext_vector_type(2)));
__device__ __forceinline__ unsigned pk_bf16(float lo, float hi) { f32x2 v = {lo, hi}; return __builtin_bit_cast(unsigned, __builtin_convertvector(v, bf16x2_t)); }
__device__ __forceinline__ unsigned pk_f16(float lo, float hi) { f32x2 v = {lo, hi}; return __builtin_bit_cast(unsigned, __builtin_convertvector(v, h16x2)); }
#define MFMA32(a, b, c) __builtin_amdgcn_mfma_f32_32x32x16_bf16((a), (b), (c), 0, 0, 0)
#define MFMA16(a, b, c) __builtin_amdgcn_mfma_f32_16x16x32_bf16((a), (b), (c), 0, 0, 0)

struct Params {
  const float *x, *norm_attn, *w_in, *ret_q_norm, *ret_k_norm, *ret_gn, *sb_q_norm, *sb_k_norm, *w_bra, *w_brb, *w_out, *norm_ffn, *w_q, *sk1, *sk2, *peer_u, *peer_v;
  float* out; char* ws;
  float l2g[8];
};

template <bool F16> __device__ __forceinline__ void transpose_tile(const float* __restrict__ W, u16* __restrict__ Wt, int K, int N, int k0, int n0, const float* __restrict__ scale, float* tile  ) {
  const int tid = threadIdx.x;
  { const int r = tid >> 4, c4 = tid & 15;
#pragma unroll
    for (int hh = 0; hh < 2; ++hh) { const int k = k0 + r + 32 * hh; float4 v = *(const float4*)(W + (size_t)k * N + n0 + 4 * c4); const float s = scale ? scale[k] : 1.0f;
      float* tp = tile + (r + 32 * hh) * 65 + 4 * c4; tp[0] = v.x * s; tp[1] = v.y * s; tp[2] = v.z * s; tp[3] = v.w * s; } }
  __syncthreads();
  { const int n = tid >> 3, kc = tid & 7; float f[8];
#pragma unroll
    for (int i = 0; i < 8; ++i) f[i] = tile[(8 * kc + i) * 65 + n];
    u32x4 w;
    if (F16) { w.x = pk_f16(f[0], f[1]); w.y = pk_f16(f[2], f[3]); w.z = pk_f16(f[4], f[5]); w.w = pk_f16(f[6], f[7]); }
    else { w.x = pk_bf16(f[0], f[1]); w.y = pk_bf16(f[2], f[3]); w.z = pk_bf16(f[4], f[5]); w.w = pk_bf16(f[6], f[7]); }
    *(u32x4*)(Wt + (size_t)(n0 + n) * K + k0 + 8 * kc) = w; }
  __syncthreads();
}
__device__ __forceinline__ void phase_prologue(const Params& p, unsigned char* smem, char* dob) {
  const int tid = threadIdx.x, lane = tid & 63, w = tid >> 6, G = gridDim.x, b = blockIdx.x;
  u16* XN = (u16*)(dob + DO_XN);
  for (int t = b * 8 + w; t < S_; t += G * 8) {
    const float* xp = p.x + (size_t)t * D_ + lane * 16;
    float4 v[4]; float ss = 0.f;
#pragma unroll
    for (int i = 0; i < 4; ++i) { v[i] = *(const float4*)(xp + 4 * i); ss += v[i].x * v[i].x + v[i].y * v[i].y + v[i].z * v[i].z + v[i].w * v[i].w; }
#pragma unroll
    for (int o = 32; o > 0; o >>= 1) ss += __shfl_xor(ss, o);
    const float r = rsqrtf(ss * (1.0f / D_) + 1e-6f);
    const float* gp = p.norm_attn + lane * 16; u32x4 o0, o1; float4 g0 = *(const float4*)gp, g1 = *(const float4*)(gp + 4), g2 = *(const float4*)(gp + 8), g3 = *(const float4*)(gp + 12);
    o0.x = pk_bf16(v[0].x * r * g0.x, v[0].y * r * g0.y); o0.y = pk_bf16(v[0].z * r * g0.z, v[0].w * r * g0.w); o0.z = pk_bf16(v[1].x * r * g1.x, v[1].y * r * g1.y); o0.w = pk_bf16(v[1].z * r * g1.z, v[1].w * r * g1.w);
    o1.x = pk_bf16(v[2].x * r * g2.x, v[2].y * r * g2.y); o1.y = pk_bf16(v[2].z * r * g2.z, v[2].w * r * g2.w); o1.z = pk_bf16(v[3].x * r * g3.x, v[3].y * r * g3.y); o1.w = pk_bf16(v[3].z * r * g3.z, v[3].w * r * g3.w);
    u16* op = XN + (size_t)t * D_ + lane * 16; *(u32x4*)op = o0; *(u32x4*)(op + 8) = o1;
  }
  float* tile = (float*)smem;
  for (int j = b; j < 2816; j += G) {
    if (j < 1664) { transpose_tile<false>(p.w_in, (u16*)(dob + DO_WINT), 1024, 6656, (j / 104) * 64, (j % 104) * 64, nullptr, tile); }
    else if (j < 1920) { const int q = j - 1664; transpose_tile<false>(p.w_bra, (u16*)(dob + DO_WBRAT), 1024, 1024, (q / 16) * 64, (q % 16) * 64, nullptr, tile); }
    else if (j < 2048) { const int q = j - 1920; transpose_tile<false>(p.w_brb, (u16*)(dob + DO_WBRBT), 512, 1024, (q / 16) * 64, (q % 16) * 64, nullptr, tile); }
    else if (j < 2304) { const int q = j - 2048; transpose_tile<false>(p.w_out, (u16*)(p.ws + WS_WOUTT), 1024, 1024, (q / 16) * 64, (q % 16) * 64, nullptr, tile); }
    else { const int q = j - 2304; transpose_tile<true>(p.w_q, (u16*)(p.ws + WS_WQT), 1024, 2048, (q / 32) * 64, (q % 32) * 64, p.norm_ffn, tile); }
  }
  const int gt = b * 512 + tid, GT = G * 512;
  for (int i = gt; i < 16384; i += GT) { ((u16*)(p.ws + WS_K1))[i] = f2bf(p.sk1[i]); ((u16*)(p.ws + WS_K2))[i] = f2bf(p.sk2[i]); ((float*)(p.ws + WS_SSQ))[i] = 0.f; }
  for (int i = gt; i < S_ * 32; i += GT) { const int t = i >> 5, f = i & 31; const float freq = powf(10000.0f, -(float)f / 32.0f); float sn, cs; sincosf((float)t * freq, &sn, &cs);
    ((float*)(p.ws + WS_ROPE_C))[i] = cs; ((float*)(p.ws + WS_ROPE_S))[i] = sn; }
}

__device__ __forceinline__ void phase_conv_tables(const Params& p) {
  const size_t gt = (size_t)blockIdx.x * 512 + threadIdx.x, GT = (size_t)gridDim.x * 512;
  u16* U16 = (u16*)(p.ws + WS_U16); u16* V16 = (u16*)(p.ws + WS_V16);
  for (size_t c = gt; c < (size_t)S_ * D_ / 8; c += GT) {
    const size_t i = c * 8; const int col = (int)(i & (D_ - 1));
    const float4 a0 = *(const float4*)(p.peer_u + i), a1 = *(const float4*)(p.peer_u + i + 4), s0 = *(const float4*)(p.norm_ffn + col), s1 = *(const float4*)(p.norm_ffn + col + 4);
    u32x4 w; w.x = pk_f16(a0.x * s0.x, a0.y * s0.y); w.y = pk_f16(a0.z * s0.z, a0.w * s0.w); w.z = pk_f16(a1.x * s1.x, a1.y * s1.y); w.w = pk_f16(a1.z * s1.z, a1.w * s1.w);
    *(u32x4*)(U16 + i) = w;
    const float4 b0 = *(const float4*)(p.peer_v + i), b1 = *(const float4*)(p.peer_v + i + 4);
    u32x4 y; y.x = pk_f16(b0.x, b0.y); y.y = pk_f16(b0.z, b0.w); y.z = pk_f16(b1.x, b1.y); y.w = pk_f16(b1.z, b1.w);
    *(u32x4*)(V16 + i) = y;
  }
}

#define SEL_KSTR 272
#define INSERT16(V, x) do { const float _x = (x); _Pragma("unroll") for (int _j = 15; _j >= 1; --_j) V[_j] = __builtin_amdgcn_fmed3f(V[_j - 1], V[_j], _x); V[0] = fmaxf(V[0], _x); } while (0)
#define MERGE16(V) do { float _c[16]; _Pragma("unroll") for (int _i = 0; _i < 16; ++_i) _c[_i] = __shfl_xor(V[_i], 32); \
  _Pragma("unroll") for (int _i = 0; _i < 16; ++_i) V[_i] = fmaxf(V[_i], _c[15 - _i]); \
  _Pragma("unroll") for (int _k = 8; _k >= 1; _k >>= 1) { _Pragma("unroll") for (int _i = 0; _i < 16; ++_i) if ((_i & _k) == 0) { const float _hi = fmaxf(V[_i], V[_i + _k]), _lo = fminf(V[_i], V[_i + _k]); V[_i] = _hi; V[_i + _k] = _lo; } } } while (0)
__device__ __forceinline__ void select_side(const u16* __restrict__ qrow  , LAS unsigned char* ks, int lane, float (&V)[16]) {
  const int hh = lane >> 5, r = lane & 31;
  s16x8 bq[8];
#pragma unroll
  for (int k = 0; k < 8; ++k) bq[k] = *(const s16x8*)(qrow + 16 * k + 8 * hh);
#pragma unroll
  for (int j = 0; j < 16; ++j) V[j] = -3.0e38f;
#pragma unroll
  for (int a = 0; a < 4; ++a) {
    f32x16 acc;
#pragma unroll
    for (int i = 0; i < 16; ++i) acc[i] = 0.f;
#pragma unroll
    for (int k = 0; k < 8; ++k) { const s16x8 af = *(const LAS s16x8*)(ks + (32 * a + r) * SEL_KSTR + (16 * k + 8 * hh) * 2); acc = MFMA32(af, bq[k], acc); }
#pragma unroll
    for (int i = 0; i < 16; ++i) { const int n = 32 * a + (i & 3) + 8 * (i >> 2) + 4 * hh; const float key = __uint_as_float((__float_as_uint(acc[i]) & 0xFFFFFF80u) | (unsigned)n); INSERT16(V, key); }
  }
  MERGE16(V);
}
__device__ __forceinline__ void phase_select(const Params& p, unsigned char* smem) {
  const int tid = threadIdx.x, lane = tid & 63, w = tid >> 6, hh = lane >> 5;
  LAS unsigned char* lds = (LAS unsigned char*)smem;
  LAS unsigned char* k1s = lds; LAS unsigned char* k2s = lds + 128 * SEL_KSTR; LAS unsigned* scr = (LAS unsigned*)(lds + 2 * 128 * SEL_KSTR + w * 4096);
  const u16* K1 = (const u16*)(p.ws + WS_K1); const u16* K2 = (const u16*)(p.ws + WS_K2); const u16* Q = (const u16*)(p.ws + WS_Q);
  u16* IDX = (u16*)(p.ws + WS_IDX); float* GW = (float*)(p.ws + WS_G);
  for (int c = tid; c < 2048; c += 512) { const int n = c >> 4, ch = c & 15;
    *(LAS u32x4*)(k1s + n * SEL_KSTR + ch * 16) = *(const u32x4*)(K1 + n * 128 + ch * 8); *(LAS u32x4*)(k2s + n * SEL_KSTR + ch * 16) = *(const u32x4*)(K2 + n * 128 + ch * 8); }
  __syncthreads();
  for (int wi = blockIdx.x * 8 + w; wi < 4096; wi += gridDim.x * 8) {
    const int tb = wi >> 3, h = wi & 7, t = tb * 32 + (lane & 31);
    const u16* qrow = Q + (size_t)t * 2048 + h * 256;
    float v1[16], v2[16];
    select_side(qrow, k1s, lane, v1);
    select_side(qrow + 128, k2s, lane, v2);
    if (hh == 0) {
#pragma unroll
      for (int i = 0; i < 16; ++i) { scr[(lane & 31) * 32 + i] = __float_as_uint(v1[i]); scr[(lane & 31) * 32 + 16 + i] = __float_as_uint(v2[i]); } }
    float c[16];
#pragma unroll
    for (int j = 0; j < 16; ++j) c[j] = -3.0e38f;
    { int ci = 0; float pend = 0.f; unsigned pcode = 0;
#pragma unroll
      for (int a = 0; a < 16; ++a)
#pragma unroll
        for (int bb = 0; bb < 16; ++bb) if ((a + 1) * (bb + 1) <= 16) {
          const float s = v1[a] + v2[bb]; const unsigned code = (unsigned)(a * 16 + bb);
          if ((ci & 1) == 0) { pend = s; pcode = code; }
          else { const float x = hh ? s : pend; const unsigned cd = hh ? code : pcode; INSERT16(c, __uint_as_float((__float_as_uint(x) & 0xFFFFFF00u) | cd)); }
          ++ci; }
    }
    MERGE16(c);
    float sum = 0.f, e[16];
#pragma unroll
    for (int j = 0; j < 16; ++j) { e[j] = __expf(c[j] - c[0]); sum += e[j]; }
    const float inv = 1.0f / sum;
    unsigned ids[8]; float gs[8];
#pragma unroll
    for (int j = 0; j < 8; ++j) { float cl = c[j], ch = c[8 + j], el = e[j], eh = e[8 + j]; asm volatile("" : "+v"(cl), "+v"(ch), "+v"(el), "+v"(eh));
      const float cj = hh ? ch : cl; const unsigned code = __float_as_uint(cj) & 0xFFu; gs[j] = (hh ? eh : el) * inv;
      const unsigned k1 = scr[(lane & 31) * 32 + (code >> 4)], k2 = scr[(lane & 31) * 32 + 16 + (code & 15)]; ids[j] = (k1 & 127u) * 128u + (k2 & 127u); }
    u32x4 iw; iw.x = ids[0] | (ids[1] << 16); iw.y = ids[2] | (ids[3] << 16); iw.z = ids[4] | (ids[5] << 16); iw.w = ids[6] | (ids[7] << 16);
    *(u32x4*)(IDX + (size_t)t * 128 + h * 16 + 8 * hh) = iw;
    float* gp = GW + (size_t)t * 128 + h * 16 + 8 * hh; *(f32x4*)gp = (f32x4){gs[0], gs[1], gs[2], gs[3]}; *(f32x4*)(gp + 4) = (f32x4){gs[4], gs[5], gs[6], gs[7]};
  }
}

__device__ __forceinline__ float gelu_tanh_f(float x) { const float u = 0.7978845608028654f * (x + 0.044715f * x * x * x); const float e = __expf(2.0f * u); return x * (1.0f - 1.0f / (e + 1.0f)); }
__device__ __forceinline__ void phase_gather(const Params& p) {
  const int tid = threadIdx.x, lane = tid & 63, w = tid >> 6;
  const u16* X1H = (const u16*)(p.ws + WS_X1H); const u16* IDX = (const u16*)(p.ws + WS_IDX); const float* GW = (const float*)(p.ws + WS_G);
  const u16* U16 = (const u16*)(p.ws + WS_U16); const u16* V16 = (const u16*)(p.ws + WS_V16); const float* SSQ = (const float*)(p.ws + WS_SSQ);
  for (int t = blockIdx.x * 8 + w; t < S_; t += gridDim.x * 8) {
    const u32x4 xa = *(const u32x4*)(X1H + (size_t)t * D_ + 8 * lane), xb = *(const u32x4*)(X1H + (size_t)t * D_ + 512 + 8 * lane);
    const unsigned idp = *(const unsigned*)(IDX + (size_t)t * 128 + 2 * lane);
    const f32x2 gp = *(const f32x2*)(GW + (size_t)t * 128 + 2 * lane);
    const float rstd = rsqrtf(SSQ[t] * (1.0f / D_) + 1e-6f);
    float h0 = 0.f, h1 = 0.f;
#pragma unroll 4
    for (int pr = 0; pr < 128; ++pr) {
      const unsigned ew = __builtin_amdgcn_readlane(idp, pr >> 1); const unsigned e = (pr & 1) ? (ew >> 16) : (ew & 0xFFFFu);
      const u16* up = U16 + (size_t)e * D_ + 8 * lane;
      const u32x4 ua = *(const u32x4*)up, ub = *(const u32x4*)(up + 512);
      float s = 0.f;
      { const unsigned uu[8] = {ua.x, ua.y, ua.z, ua.w, ub.x, ub.y, ub.z, ub.w}; const unsigned xx[8] = {xa.x, xa.y, xa.z, xa.w, xb.x, xb.y, xb.z, xb.w};
#pragma unroll
        for (int i = 0; i < 8; ++i) { const unsigned ui = uu[i], xi = xx[i]; s = __builtin_amdgcn_fdot2(__builtin_bit_cast(h16x2, ui), __builtin_bit_cast(h16x2, xi), s, false); } }
#pragma unroll
      for (int o = 32; o > 0; o >>= 1) s += __shfl_xor(s, o);
      if ((pr >> 1) == lane) { if (pr & 1) h1 = s; else h0 = s; }
    }
    const float a0 = gelu_tanh_f(h0 * rstd) * gp.x, a1 = gelu_tanh_f(h1 * rstd) * gp.y;
    float acc[16];
#pragma unroll
    for (int i = 0; i < 16; ++i) acc[i] = 0.f;
#pragma unroll 4
    for (int pr = 0; pr < 128; ++pr) {
      const unsigned ew = __builtin_amdgcn_readlane(idp, pr >> 1); const unsigned e = (pr & 1) ? (ew >> 16) : (ew & 0xFFFFu);
      const float a = __uint_as_float(__builtin_amdgcn_readlane((pr & 1) ? __float_as_uint(a1) : __float_as_uint(a0), pr >> 1));
      const u16* vp = V16 + (size_t)e * D_ + 8 * lane;
      const u32x4 va = *(const u32x4*)vp, vb = *(const u32x4*)(vp + 512);
      const unsigned wv[8] = {va.x, va.y, va.z, va.w, vb.x, vb.y, vb.z, vb.w};
#pragma unroll
      for (int i = 0; i < 8; ++i) { const h16x2 hv = __builtin_bit_cast(h16x2, wv[i]); acc[2 * i] = fmaf((float)hv.x, a, acc[2 * i]); acc[2 * i + 1] = fmaf((float)hv.y, a, acc[2 * i + 1]); }
    }
    float* op = p.out + (size_t)t * D_ + 8 * lane;
    f32x4 o0 = *(f32x4*)op, o1 = *(f32x4*)(op + 4), o2 = *(f32x4*)(op + 512), o3 = *(f32x4*)(op + 516);
    o0 += (f32x4){acc[0], acc[1], acc[2], acc[3]}; o1 += (f32x4){acc[4], acc[5], acc[6], acc[7]}; o2 += (f32x4){acc[8], acc[9], acc[10], acc[11]}; o3 += (f32x4){acc[12], acc[13], acc[14], acc[15]};
    *(f32x4*)op = o0; *(f32x4*)(op + 4) = o1; *(f32x4*)(op + 512) = o2; *(f32x4*)(op + 516) = o3;
  }
}


#define WS_ST16 (240 * MB_)
#define DO_KV (0 * MB_)
__device__ __forceinline__ s16x8 cat4(s16x4 x, s16x4 y) { return __builtin_shufflevector(x, y, 0, 1, 2, 3, 4, 5, 6, 7); }
__device__ __forceinline__ s16x4 tr32(LAS unsigned char* base, int st, int kb, int nb, int lane) {
  const int q = (lane & 15) >> 2, pp = lane & 3, blk = (lane >> 4) & 1;
  return __builtin_amdgcn_ds_read_tr16_b64_v4i16((LAS s16x4*)(base + (kb + q) * st + (nb + 16 * blk + 4 * pp) * 2));
}
__device__ __forceinline__ s16x4 tr16(LAS unsigned char* base, int st, int kb, int nb, int lane) {
  const int q = (lane & 15) >> 2, pp = lane & 3;
  return __builtin_amdgcn_ds_read_tr16_b64_v4i16((LAS s16x4*)(base + (kb + q) * st + (nb + 4 * pp) * 2));
}
__device__ __forceinline__ void norm16(u32x4 lo, u32x4 hi, int part, const float* __restrict__ gain, float (&a)[8], float (&b)[8]) {
  unpack8_bf16(lo, a); unpack8_bf16(hi, b);
  float ss = 0.f;
#pragma unroll
  for (int i = 0; i < 8; ++i) ss += a[i] * a[i] + b[i] * b[i];
  ss += __shfl_xor(ss, 1); ss += __shfl_xor(ss, 2);
  const float r = rsqrtf(ss * (1.0f / 64.0f) + 1e-6f);
  const f32x4 g0 = *(const f32x4*)(gain + 8 * part), g1 = *(const f32x4*)(gain + 8 * part + 4), g2 = *(const f32x4*)(gain + 32 + 8 * part), g3 = *(const f32x4*)(gain + 36 + 8 * part);
#pragma unroll
  for (int i = 0; i < 4; ++i) { a[i] *= r * g0[i]; a[4 + i] *= r * g1[i]; b[i] *= r * g2[i]; b[4 + i] *= r * g3[i]; }
}
__device__ __forceinline__ void rope16(float (&a)[8], float (&b)[8], const float* __restrict__ rc, const float* __restrict__ rs, int t, int part, float scale) {
  const f32x4 c0 = *(const f32x4*)(rc + t * 32 + 8 * part), c1 = *(const f32x4*)(rc + t * 32 + 8 * part + 4), s0 = *(const f32x4*)(rs + t * 32 + 8 * part), s1 = *(const f32x4*)(rs + t * 32 + 8 * part + 4);
#pragma unroll
  for (int i = 0; i < 8; ++i) { const float c = i < 4 ? c0[i & 3] : c1[i & 3], s = i < 4 ? s0[i & 3] : s1[i & 3]; const float x1 = a[i], x2 = b[i]; a[i] = (x1 * c - x2 * s) * scale; b[i] = (x1 * s + x2 * c) * scale; }
}
__device__ __forceinline__ void store_row16(LAS unsigned char* rowp, int part, const float (&a)[8], const float (&b)[8]) {
  u32x4 wa, wb; wa.x = pk_bf16(a[0], a[1]); wa.y = pk_bf16(a[2], a[3]); wa.z = pk_bf16(a[4], a[5]); wa.w = pk_bf16(a[6], a[7]);
  wb.x = pk_bf16(b[0], b[1]); wb.y = pk_bf16(b[2], b[3]); wb.z = pk_bf16(b[4], b[5]); wb.w = pk_bf16(b[6], b[7]);
  *(LAS u32x4*)(rowp + 16 * part) = wa; *(LAS u32x4*)(rowp + 64 + 16 * part) = wb;
}

__device__ __forceinline__ void kv_item(const Params& p, LAS unsigned char* lds, int item, float* __restrict__ KV) {
  const int tid = threadIdx.x, lane = tid & 63, w = __builtin_amdgcn_readfirstlane(tid >> 6), hh = lane >> 5, r = lane & 31;
  const int c = item >> 3, h = item & 7, t0 = c * 128;
  LAS unsigned char* Ks = lds; LAS unsigned char* Vs = lds + 128 * 192;
  const u16* RK = (const u16*)(p.ws + WS_RK); const u16* RV = (const u16*)(p.ws + WS_RV);
  const float* RC = (const float*)(p.ws + WS_ROPE_C); const float* RS = (const float*)(p.ws + WS_ROPE_S);
  { const int j = tid >> 2, part = tid & 3, t = t0 + j; const u16* pp = RK + (size_t)t * 512 + h * 64 + part * 8;
    float a[8], b[8]; norm16(*(const u32x4*)pp, *(const u32x4*)(pp + 32), part, p.ret_k_norm, a, b);
    rope16(a, b, RC, RS, t, part, 0.125f * exp2f((float)(127 - j) * p.l2g[h])); store_row16(Ks + j * 192, part, a, b); }
#pragma unroll
  for (int it = 0; it < 4; ++it) { const int q = tid + 512 * it, row = q >> 4, ch = q & 15;
    *(LAS u32x4*)(Vs + row * 320 + ch * 16) = *(const u32x4*)(RV + (size_t)(t0 + row) * 1024 + h * 128 + ch * 8); }
  __syncthreads();
  const int mb = w & 1, nb = w >> 1;
  f32x16 acc;
#pragma unroll
  for (int i = 0; i < 16; ++i) acc[i] = 0.f;
#pragma unroll
  for (int ks = 0; ks < 8; ++ks) { const int kb = 16 * ks + 8 * hh;
    const s16x8 af = cat4(tr32(Ks, 192, kb, 32 * mb, lane), tr32(Ks, 192, kb + 4, 32 * mb, lane));
    const s16x8 bf = cat4(tr32(Vs, 320, kb, 32 * nb, lane), tr32(Vs, 320, kb + 4, 32 * nb, lane));
    acc = MFMA32(af, bf, acc); }
  float* op = KV + ((size_t)(c * 8 + h) * 128 + 32 * nb + r) * 64 + 32 * mb + 4 * hh;
#pragma unroll
  for (int g4 = 0; g4 < 4; ++g4) *(f32x4*)(op + 8 * g4) = (f32x4){acc[4 * g4], acc[4 * g4 + 1], acc[4 * g4 + 2], acc[4 * g4 + 3]};
  __syncthreads();
}

__device__ __forceinline__ void phase_scan(const Params& p, unsigned char* smem, const float* __restrict__ KV) {
  const int tid = threadIdx.x, q = tid & 63, g = tid >> 6;
  f32x4* tot = (f32x4*)smem;
  u16* ST = (u16*)(p.ws + WS_ST16);
  for (int batch = blockIdx.x; batch < 256; batch += gridDim.x) {
    const int q4 = batch * 64 + q, h = q4 >> 11;
    const float cd = exp2f(128.0f * p.l2g[h]);
    f32x4 v[16];
#pragma unroll
    for (int i = 0; i < 16; ++i) v[i] = *(const f32x4*)(KV + ((size_t)(16 * g + i) * 16384 + q4) * 4);
    f32x4 run = (f32x4){0.f, 0.f, 0.f, 0.f};
#pragma unroll
    for (int i = 0; i < 16; ++i) { const f32x4 tmp = v[i]; v[i] = run; run = run * cd + tmp; }
    tot[g * 64 + q] = run;
    __syncthreads();
    float cd16 = cd; cd16 *= cd16; cd16 *= cd16; cd16 *= cd16; cd16 *= cd16;
    f32x4 C = (f32x4){0.f, 0.f, 0.f, 0.f};
    for (int gg = 0; gg < g; ++gg) C = C * cd16 + tot[gg * 64 + q];
    float pw = 1.0f;
#pragma unroll
    for (int i = 0; i < 16; ++i) { const f32x4 s = v[i] + C * pw; pw *= cd;
      uint2 o; o.x = pk_bf16(s[0], s[1]); o.y = pk_bf16(s[2], s[3]); *(uint2*)(ST + ((size_t)(16 * g + i) * 16384 + q4) * 4) = o; }
    __syncthreads();
  }
}

__device__ __forceinline__ void retout_item(const Params& p, LAS unsigned char* lds, int item) {
  const int tid = threadIdx.x, lane = tid & 63, w = __builtin_amdgcn_readfirstlane(tid >> 6), hh = lane >> 5, r = lane & 31;
  const int c = item >> 3, h = item & 7, t0 = c * 128;
  LAS unsigned char* Qs = lds; LAS unsigned char* Ks = lds + 18432; LAS unsigned char* STs = lds + 36864; LAS unsigned char* Vs = lds + 55296; LAS f32x2* red = (LAS f32x2*)(lds + 96256);
  const u16* RQ = (const u16*)(p.ws + WS_RQ); const u16* RK = (const u16*)(p.ws + WS_RK); const u16* RV = (const u16*)(p.ws + WS_RV); u16* RG = (u16*)(p.ws + WS_RG);
  const u16* ST = (const u16*)(p.ws + WS_ST16);
  const float* RC = (const float*)(p.ws + WS_ROPE_C); const float* RS = (const float*)(p.ws + WS_ROPE_S);
  const float l2g = p.l2g[h];
  { const int j = tid >> 2, part = tid & 3, t = t0 + j; float a[8], b[8];
    const u16* pq = RQ + (size_t)t * 512 + h * 64 + part * 8; norm16(*(const u32x4*)pq, *(const u32x4*)(pq + 32), part, p.ret_q_norm, a, b); rope16(a, b, RC, RS, t, part, 1.0f); store_row16(Qs + j * 144, part, a, b);
    const u16* pk = RK + (size_t)t * 512 + h * 64 + part * 8; norm16(*(const u32x4*)pk, *(const u32x4*)(pk + 32), part, p.ret_k_norm, a, b); rope16(a, b, RC, RS, t, part, 0.125f); store_row16(Ks + j * 144, part, a, b); }
#pragma unroll
  for (int it = 0; it < 2; ++it) { const int q = tid + 512 * it, row = q >> 3, ch = q & 7;
    *(LAS u32x4*)(STs + row * 144 + ch * 16) = *(const u32x4*)(ST + ((size_t)(c * 8 + h) * 128 + row) * 64 + ch * 8); }
#pragma unroll
  for (int it = 0; it < 4; ++it) { const int q = tid + 512 * it, row = q >> 4, ch = q & 15;
    *(LAS u32x4*)(Vs + row * 320 + ch * 16) = *(const u32x4*)(RV + (size_t)(t0 + row) * 1024 + h * 128 + ch * 8); }
  __syncthreads();
  const int ib = w >> 1, eh = w & 1;
  f32x16 acc[2];
#pragma unroll
  for (int et = 0; et < 2; ++et)
#pragma unroll
    for (int i = 0; i < 16; ++i) acc[et][i] = 0.f;
  s16x8 bq[4];
#pragma unroll
  for (int ks = 0; ks < 4; ++ks) bq[ks] = *(const LAS s16x8*)(Qs + (32 * ib + r) * 144 + (16 * ks + 8 * hh) * 2);
#pragma unroll
  for (int et = 0; et < 2; ++et)
#pragma unroll
    for (int ks = 0; ks < 4; ++ks) { const s16x8 af = *(const LAS s16x8*)(STs + (32 * (2 * eh + et) + r) * 144 + (16 * ks + 8 * hh) * 2); acc[et] = MFMA32(af, bq[ks], acc[et]); }
  { const float qd = exp2f((float)(32 * ib + r + 1) * l2g);
#pragma unroll
    for (int et = 0; et < 2; ++et)
#pragma unroll
      for (int i = 0; i < 16; ++i) acc[et][i] *= qd; }
  for (int jb = 0; jb <= ib; ++jb) {
    f32x16 sc;
#pragma unroll
    for (int i = 0; i < 16; ++i) sc[i] = 0.f;
#pragma unroll
    for (int ks = 0; ks < 4; ++ks) { const s16x8 af = *(const LAS s16x8*)(Ks + (32 * jb + r) * 144 + (16 * ks + 8 * hh) * 2); sc = MFMA32(af, bq[ks], sc); }
    float pv[16];
#pragma unroll
    for (int i = 0; i < 16; ++i) { const int jl = 32 * jb + (i & 3) + 8 * (i >> 2) + 4 * hh, diff = 32 * ib + r - jl; pv[i] = diff >= 0 ? sc[i] * exp2f((float)diff * l2g) : 0.f; }
#pragma unroll
    for (int s = 0; s < 2; ++s) {
      u32x4 bw; bw.x = pk_bf16(pv[8 * s], pv[8 * s + 1]); bw.y = pk_bf16(pv[8 * s + 2], pv[8 * s + 3]); bw.z = pk_bf16(pv[8 * s + 4], pv[8 * s + 5]); bw.w = pk_bf16(pv[8 * s + 6], pv[8 * s + 7]);
      const s16x8 bf = __builtin_bit_cast(s16x8, bw);
#pragma unroll
      for (int et = 0; et < 2; ++et) { const int kb = 32 * jb + 16 * s + 4 * hh, nb = 32 * (2 * eh + et);
        const s16x8 af = cat4(tr32(Vs, 320, kb, nb, lane), tr32(Vs, 320, kb + 8, nb, lane)); acc[et] = MFMA32(af, bf, acc[et]); }
    }
  }
  float s1 = 0.f, s2 = 0.f;
#pragma unroll
  for (int et = 0; et < 2; ++et)
#pragma unroll
    for (int i = 0; i < 16; ++i) { const float v = acc[et][i]; s1 += v; s2 += v * v; }
  s1 += __shfl_xor(s1, 32); s2 += __shfl_xor(s2, 32);
  if (hh == 0) red[(32 * ib + r) * 2 + eh] = (f32x2){s1, s2};
  __syncthreads();
  const f32x2 ra = red[(32 * ib + r) * 2], rb = red[(32 * ib + r) * 2 + 1];
  const float mu = (ra.x + rb.x) * (1.0f / 128.0f), var = fmaxf((ra.y + rb.y) * (1.0f / 128.0f) - mu * mu, 0.f), rstd = rsqrtf(var + 1e-6f);
  const int t = t0 + 32 * ib + r;
#pragma unroll
  for (int et = 0; et < 2; ++et)
#pragma unroll
    for (int g4 = 0; g4 < 4; ++g4) { const int col = h * 128 + 32 * (2 * eh + et) + 8 * g4 + 4 * hh;
      u16* gp = RG + (size_t)t * 1024 + col; const uint2 gw = *(const uint2*)gp; const f32x4 gn = *(const f32x4*)(p.ret_gn + col);
      const float g0 = __uint_as_float(gw.x << 16), g1 = __uint_as_float(gw.x & 0xffff0000u), g2 = __uint_as_float(gw.y << 16), g3 = __uint_as_float(gw.y & 0xffff0000u);
      const float y0 = (acc[et][4 * g4] - mu) * rstd * gn[0], y1 = (acc[et][4 * g4 + 1] - mu) * rstd * gn[1], y2 = (acc[et][4 * g4 + 2] - mu) * rstd * gn[2], y3 = (acc[et][4 * g4 + 3] - mu) * rstd * gn[3];
      uint2 o; o.x = pk_bf16(y0 * g0 * sigmoidf_(g0), y1 * g1 * sigmoidf_(g1)); o.y = pk_bf16(y2 * g2 * sigmoidf_(g2), y3 * g3 * sigmoidf_(g3)); *(uint2*)gp = o; }
  __syncthreads();
}

__device__ __forceinline__ void sb_item(const Params& p, LAS unsigned char* lds, int item, u16* __restrict__ SB) {
  const int tid = threadIdx.x, lane = tid & 63, w = __builtin_amdgcn_readfirstlane(tid >> 6), g = lane >> 4, lt = lane & 15;
  const int qb = item >> 3, h = item & 7, t0 = qb * 128;
  LAS unsigned char* Qs = lds; LAS unsigned* flags = (LAS unsigned*)(lds + 61440);
  const u16* SQ = (const u16*)(p.ws + WS_SQ); const u16* SK = (const u16*)(p.ws + WS_SK); const u16* SV = (const u16*)(p.ws + WS_SV);
  { const int j = tid >> 2, part = tid & 3, t = t0 + j; float a[8], b[8];
    const u16* pq = SQ + (size_t)t * 512 + h * 64 + part * 8; norm16(*(const u32x4*)pq, *(const u32x4*)(pq + 32), part, p.sb_q_norm, a, b); store_row16(Qs + j * 144, part, a, b); }
  u32x4 r0, r1;
  const bool kthr = tid < 256; const int krow = tid >> 2, kpart = tid & 3, vq = tid - 256;
#define SB_LOAD(kt) do { if (kthr) { const u16* pk = SK + (size_t)((kt) * 64 + krow) * 512 + h * 64 + kpart * 8; r0 = *(const u32x4*)pk; r1 = *(const u32x4*)(pk + 32); } \
    else { r0 = *(const u32x4*)(SV + (size_t)((kt) * 64 + (vq >> 3)) * 512 + h * 64 + (vq & 7) * 8); r1 = *(const u32x4*)(SV + (size_t)((kt) * 64 + 32 + (vq >> 3)) * 512 + h * 64 + (vq & 7) * 8); } } while (0)
#define SB_WRITE(buf) do { LAS unsigned char* kb_ = lds + 18432 + (buf) * 21504; if (kthr) { float a[8], b[8]; norm16(r0, r1, kpart, p.sb_k_norm, a, b); store_row16(kb_ + krow * 144, kpart, a, b); } \
    else { *(LAS u32x4*)(kb_ + 9216 + (vq >> 3) * 192 + (vq & 7) * 16) = r0; *(LAS u32x4*)(kb_ + 9216 + (32 + (vq >> 3)) * 192 + (vq & 7) * 16) = r1; } } while (0)
  const int ktmax = 2 * qb + 1;
  SB_LOAD(ktmax); SB_WRITE(0);
  __syncthreads();
  s16x8 qf[2];
#pragma unroll
  for (int ks = 0; ks < 2; ++ks) qf[ks] = *(const LAS s16x8*)(Qs + (16 * w + lt) * 144 + (32 * ks + 8 * g) * 2);
  float carry = 0.f; f32x4 o[4];
#pragma unroll
  for (int et = 0; et < 4; ++et) o[et] = (f32x4){0.f, 0.f, 0.f, 0.f};
  const int tq = t0 + 16 * w + lt;
  for (int kt = ktmax, it = 0; kt >= 0; --kt, ++it) {
    const int buf = it & 1; LAS unsigned char* Ks = lds + 18432 + buf * 21504; LAS unsigned char* Vs = Ks + 9216;
    if (kt > 0) SB_LOAD(kt - 1);
    f32x4 z[4];
#pragma unroll
    for (int a = 0; a < 4; ++a) { z[a] = (f32x4){0.f, 0.f, 0.f, 0.f};
#pragma unroll
      for (int ks = 0; ks < 2; ++ks) { const s16x8 af = *(const LAS s16x8*)(Ks + (16 * a + lt) * 144 + (32 * ks + 8 * g) * 2); z[a] = MFMA16(af, qf[ks], z[a]); } }
    float ls[4][4], zl[4][4], G[4], T[4], suf[4];
#pragma unroll
    for (int a = 0; a < 4; ++a) { G[a] = 0.f;
#pragma unroll
      for (int rr = 0; rr < 4; ++rr) { const bool valid = (kt * 64 + 16 * a + 4 * g + rr) < tq; const float zv = z[a][rr] * 0.125f;
        const float sp = fmaxf(zv, 0.f) + __logf(1.0f + __expf(-fabsf(zv)));
        ls[a][rr] = valid ? -sp : 0.f; zl[a][rr] = valid ? zv - sp : -1.0e30f; G[a] += ls[a][rr]; } }
#pragma unroll
    for (int a = 0; a < 4; ++a) { const float x1 = __shfl_xor(G[a], 16), x2 = __shfl_xor(G[a], 32), x3 = __shfl_xor(G[a], 48);
      T[a] = G[a] + x1 + x2 + x3; suf[a] = g == 0 ? (x1 + x2 + x3) : (g == 1 ? (x2 + x3) : (g == 2 ? x1 : 0.f)); }
    float wv[4][4];
    { float after = 0.f;
#pragma unroll
      for (int a = 3; a >= 0; --a) { float base = carry + after + suf[a];
#pragma unroll
        for (int rr = 3; rr >= 0; --rr) { wv[a][rr] = __expf(zl[a][rr] + base); base += ls[a][rr]; }
        after += T[a]; }
      carry += after; }
#pragma unroll
    for (int ap = 0; ap < 2; ++ap) {
      u32x4 bw; bw.x = pk_bf16(wv[2 * ap][0], wv[2 * ap][1]); bw.y = pk_bf16(wv[2 * ap][2], wv[2 * ap][3]); bw.z = pk_bf16(wv[2 * ap + 1][0], wv[2 * ap + 1][1]); bw.w = pk_bf16(wv[2 * ap + 1][2], wv[2 * ap + 1][3]);
      const s16x8 bf = __builtin_bit_cast(s16x8, bw);
#pragma unroll
      for (int et = 0; et < 4; ++et) { const s16x8 af = cat4(tr16(Vs, 192, 32 * ap + 4 * g, 16 * et, lane), tr16(Vs, 192, 32 * ap + 16 + 4 * g, 16 * et, lane)); o[et] = MFMA16(af, bf, o[et]); }
    }
    const bool done = __all(carry < -104.0f);
    if (lane == 0) flags[buf * 8 + w] = done ? 1u : 0u;
    if (kt > 0) SB_WRITE(buf ^ 1);
    __syncthreads();
    if (kt > 0) { unsigned all = 1u;
#pragma unroll
      for (int i = 0; i < 8; ++i) all &= flags[buf * 8 + i];
      if (all) break; }
  }
  { u16* op = SB + (size_t)tq * 512 + h * 64 + 4 * g;
#pragma unroll
    for (int et = 0; et < 4; ++et) { uint2 ov; ov.x = pk_bf16(o[et][0], o[et][1]); ov.y = pk_bf16(o[et][2], o[et][3]); *(uint2*)(op + 16 * et) = ov; } }
  __syncthreads();
#undef SB_LOAD
#undef SB_WRITE
}
__device__ __forceinline__ void phase_mixA(const Params& p, unsigned char* smem, char* dob) {
  LAS unsigned char* lds = (LAS unsigned char*)smem;
  for (int item = blockIdx.x; item < 2048; item += gridDim.x) { if (item < 1024) kv_item(p, lds, item, (float*)(dob + DO_KV)); else sb_item(p, lds, item - 1024, (u16*)(dob + DO_SB)); }
}
__device__ __forceinline__ void phase_retout(const Params& p, unsigned char* smem) {
  LAS unsigned char* lds = (LAS unsigned char*)smem;
  for (int item = blockIdx.x; item < 1024; item += gridDim.x) retout_item(p, lds, item);
}

#define LDS_BYTES 147456
template <int PH> __global__ __launch_bounds__(512, 2) void k_phase(Params p) {
  extern __shared__ __attribute__((aligned(16))) unsigned char smem[];
  if (PH == 0) phase_prologue(p, smem, (char*)p.out);
  if (PH == 1) phase_conv_tables(p);
  if (PH == 2) phase_mixA(p, smem, (char*)p.out);
  if (PH == 3) phase_scan(p, smem, (const float*)((char*)p.out + DO_KV));
  if (PH == 4) phase_retout(p, smem);
  if (PH == 7) phase_select(p, smem);
  if (PH == 8) phase_gather(p);
}
template <int PH> static void launch_phase(const Params& p, hipStream_t stream) {
  (void)hipFuncSetAttribute((const void*)k_phase<PH>, hipFuncAttributeMaxDynamicSharedMemorySize, LDS_BYTES);
  hipLaunchKernelGGL((k_phase<PH>), dim3(256), dim3(512), LDS_BYTES, stream, p);
}

template <bool F16, class Epi> __global__ __launch_bounds__(512, 2) void k_gemm_fast(pg8::Gemm g, Epi E) {
  extern __shared__ __attribute__((aligned(16))) unsigned char shm[];
  pg8::StaticOrder S; S.init(g.M, g.N, (int)gridDim.x, (int)blockIdx.x);
  pg8::gemm_phase<F16, Epi>((PG8_LAS unsigned char*)shm, g, S, E);
}
template <bool F16, class Epi> static void launch_gemm(const u16* A, const u16* Bt, int M, int N, int K, const Epi& E, hipStream_t stream) {
  (void)hipFuncSetAttribute((const void*)k_gemm_fast<F16, Epi>, hipFuncAttributeMaxDynamicSharedMemorySize, pg8::STAGE_BYTES);
  pg8::Gemm g{A, Bt, M, N, K, 0};
  hipLaunchKernelGGL((k_gemm_fast<F16, Epi>), dim3(256), dim3(512), pg8::STAGE_BYTES, stream, g, E);
}

extern "C" void kernel_launch(void* const* d_in, const int* in_sizes, int n_in, void* d_out, int out_size, void* d_ws, size_t ws_size, hipStream_t stream) {
  if (ws_size < WS_NEED) return;
  const float* x = (const float*)d_in[0]; const float* norm_attn = (const float*)d_in[1]; const float* w_in = (const float*)d_in[2];
  const float* ret_q_norm = (const float*)d_in[3]; const float* ret_k_norm = (const float*)d_in[4]; const float* ret_gn = (const float*)d_in[5];
  const float* sb_q_norm = (const float*)d_in[6]; const float* sb_k_norm = (const float*)d_in[7]; const float* w_bra = (const float*)d_in[8];
  const float* w_brb = (const float*)d_in[9]; const float* w_out = (const float*)d_in[10]; const float* norm_ffn = (const float*)d_in[11];
  const float* w_q = (const float*)d_in[12]; const float* sk1 = (const float*)d_in[13]; const float* sk2 = (const float*)d_in[14];
  const float* peer_u = (const float*)d_in[15]; const float* peer_v = (const float*)d_in[16];
  char* ws = (char*)d_ws; char* dob = (char*)d_out; float* out = (float*)d_out;
  u16* XN = (u16*)(dob + DO_XN); u16* WINT = (u16*)(dob + DO_WINT); u16* SB = (u16*)(dob + DO_SB); u16* WBRAT = (u16*)(dob + DO_WBRAT); u16* WBRBT = (u16*)(dob + DO_WBRBT);
  u16* WOUTT = (u16*)(ws + WS_WOUTT); u16* WQT = (u16*)(ws + WS_WQT); u16* K1 = (u16*)(ws + WS_K1); u16* K2 = (u16*)(ws + WS_K2);
  float* RC = (float*)(ws + WS_ROPE_C); float* RS = (float*)(ws + WS_ROPE_S); float* SSQ = (float*)(ws + WS_SSQ);
  u16* RQ = (u16*)(ws + WS_RQ); u16* RK = (u16*)(ws + WS_RK); u16* RV = (u16*)(ws + WS_RV); u16* SQ = (u16*)(ws + WS_SQ); u16* SK = (u16*)(ws + WS_SK);
  u16* SV = (u16*)(ws + WS_SV); u16* RG = (u16*)(ws + WS_RG); u16* GA = (u16*)(ws + WS_GA); u16* GB = (u16*)(ws + WS_GB);
  u16* IDX = (u16*)(ws + WS_IDX); float* GW = (float*)(ws + WS_G);
  u16* U16 = (u16*)(ws + WS_U16); u16* V16 = (u16*)(ws + WS_V16); u16* MIXED = (u16*)(ws + WS_MIXED); u16* X1H = (u16*)(ws + WS_X1H); u16* Q = (u16*)(ws + WS_Q);

  Params P{}; P.x = x; P.norm_attn = norm_attn; P.w_in = w_in; P.ret_q_norm = ret_q_norm; P.ret_k_norm = ret_k_norm; P.ret_gn = ret_gn; P.sb_q_norm = sb_q_norm; P.sb_k_norm = sb_k_norm;
  P.w_bra = w_bra; P.w_brb = w_brb; P.w_out = w_out; P.norm_ffn = norm_ffn; P.w_q = w_q; P.sk1 = sk1; P.sk2 = sk2; P.peer_u = peer_u; P.peer_v = peer_v; P.out = out; P.ws = ws;
  for (int h = 0; h < 8; ++h) P.l2g[h] = (float)log2(1.0 - exp2(-5.0 - (double)h));
  launch_phase<0>(P, stream);
  { FEpiInProj e{RQ, RK, RV, RG, SQ, SK, SV, GA, GB}; launch_gemm<false>(XN, WINT, S_, 6656, 1024, e, stream); }
  launch_phase<2>(P, stream);
  launch_phase<3>(P, stream);
  launch_phase<4>(P, stream);
  launch_phase<1>(P, stream);
  { FEpiMixB e{MIXED, GB}; launch_gemm<false>(SB, WBRBT, S_, 1024, 512, e, stream); }
  { FEpiMixA e{MIXED, GA}; launch_gemm<false>(RG, WBRAT, S_, 1024, 1024, e, stream); }
  { FEpiOut e{x, out, X1H, SSQ}; launch_gemm<false>(MIXED, WOUTT, S_, 1024, 1024, e, stream); }
  { FEpiQ e{SSQ, Q}; launch_gemm<true>(X1H, WQT, S_, 2048, 1024, e, stream); }
  launch_phase<7>(P, stream);
  launch_phase<8>(P, stream);
}
```

```cpp
#include <hip/hip_runtime.h>
#include <hip/hip_cooperative_groups.h>
#include <stdint.h>
#include <cstdio>
#include <cmath>
namespace cg = cooperative_groups;

typedef unsigned short u16;
#define S_ 16384
#define D_ 1024
#define MB_ ((size_t)1 << 20)

#define WS_WOUTT (1 * MB_)
#define WS_WQT (3 * MB_)
#define WS_K1 (7 * MB_)
#define WS_K2 (7 * MB_ + 65536)
#define WS_ROPE_C (8 * MB_)
#define WS_ROPE_S (10 * MB_)
#define WS_SSQ (12 * MB_)
#define WS_RQ (16 * MB_)
#define WS_RK (32 * MB_)
#define WS_RV (48 * MB_)
#define WS_SQ (80 * MB_)
#define WS_SK (96 * MB_)
#define WS_SV (112 * MB_)
#define WS_RG (128 * MB_)
#define WS_GA (160 * MB_)
#define WS_GB (192 * MB_)
#define WS_IDX (224 * MB_)
#define WS_G (232 * MB_)
#define WS_NEED (256 * MB_)
#define WS_U16 WS_RQ
#define WS_V16 WS_RV
#define WS_MIXED WS_SQ
#define WS_X1H WS_RG
#define WS_Q WS_GA
#define DO_XN (0 * MB_)
#define DO_WINT (32 * MB_)
#define DO_SB (32 * MB_)
#define DO_WBRAT (60 * MB_)
#define DO_WBRBT (62 * MB_)

__device__ __forceinline__ int ptid() { int t = (int)threadIdx.x; asm volatile("" : "+v"(t)); return t; }
__device__ __forceinline__ u16 f2bf(float f) { unsigned u = __float_as_uint(f); u += 0x7FFFu + ((u >> 16) & 1u); return (u16)(u >> 16); }
__device__ __forceinline__ float bf2f(u16 b) { return __uint_as_float(((unsigned)b) << 16); }
__device__ __forceinline__ u16 f2h(float f) { _Float16 h = (_Float16)f; return *(u16*)&h; }
__device__ __forceinline__ float h2f(u16 b) { _Float16 h = *(_Float16*)&b; return (float)h; }
template <bool F16> __device__ __forceinline__ float ld16(const u16* p) { return F16 ? h2f(*p) : bf2f(*p); }
__device__ __forceinline__ float sigmoidf_(float x) { return 1.0f / (1.0f + __expf(-x)); }

namespace pg8 {
#define PG8_LAS __attribute__((address_space(3)))
typedef short bf16x8 __attribute__((ext_vector_type(8)));
typedef _Float16 f16x8 __attribute__((ext_vector_type(8)));
typedef float f32x4 __attribute__((ext_vector_type(4)));
typedef unsigned u32x4 __attribute__((ext_vector_type(4)));
constexpr int BM = 256, BK = 64, HALF = 128, HTB = HALF * BK * 2, STAGE_BYTES = 8 * HTB, NXCD = 8, WGM = 8;
__host__ __device__ __forceinline__ int lds_byte(int r, int c) { const int st = (r >> 4) * 2 + (c >> 5), rr = r & 15, cc = c & 31, ob = rr * 64 + cc * 2; return st * 1024 + (ob ^ (((ob >> 9) & 1) << 5)); }
__host__ __device__ __forceinline__ void stage_rc(int b, int& R, int& C) { const int st = b / 1024, sb = b % 1024, swz = sb ^ (((sb >> 9) & 1) << 5); R = (st >> 1) * 16 + swz / 64; C = (st & 1) * 32 + (swz % 64) / 2; }
__host__ __device__ __forceinline__ int perm32(int rho) { const int n = rho >> 4, i = rho & 15; return 8 * (i >> 2) + 4 * n + (i & 3); }
struct Unit { int pm, pn; };
struct Gemm { const u16* A; const u16* Bt; int M, N, K, pad; };
struct StaticOrder {
  int nM, nN, nwg, G, c;
  __host__ __device__ void init(int M, int N, int G_, int c_) { nM = M / BM; nN = N / BM; nwg = nM * nN; G = G_; c = c_; }
  __host__ __device__ bool next(int i, Unit& u) const {
    const long L = (long)i * G + c; if (L >= nwg) return false;
    int wgid = (int)L; { const int q = nwg / NXCD, r = nwg % NXCD, xcd = wgid % NXCD, off = wgid / NXCD; wgid = (xcd < r ? xcd * (q + 1) : r * (q + 1) + (xcd - r) * q) + off; }
    const int nig = WGM * nN, gid = wgid / nig, fm = gid * WGM, gsz = (nM - fm) < WGM ? (nM - fm) : WGM;
    u.pm = fm + ((wgid % nig) % gsz); u.pn = (wgid % nig) / gsz; return true;
  }
};
__device__ __forceinline__ unsigned cvt_pk_bf16(float lo, float hi) { unsigned r; asm volatile("v_cvt_pk_bf16_f32 %0, %1, %2" : "=v"(r) : "v"(lo), "v"(hi)); return r; }
__device__ __forceinline__ unsigned cvt_pk_f16(float lo, float hi) { typedef _Float16 h2 __attribute__((ext_vector_type(2))); h2 v; v.x = (_Float16)lo; v.y = (_Float16)hi; return __builtin_bit_cast(unsigned, v); }

template <bool F16, class Epi>
__device__ __forceinline__ void gemm_phase(PG8_LAS unsigned char* lds, const Gemm g, const StaticOrder& S, const Epi& E) {
  const int tid = ptid(), wid = __builtin_amdgcn_readfirstlane(tid >> 6), lane = tid & 63, wr = wid >> 2, wc = wid & 3, fr = lane & 15, fq = lane >> 4;
  const int K = g.K, nt = K / BK;
  unsigned voffA[2], voffB[2];
#pragma unroll
  for (int i = 0; i < 2; ++i) { int R, C; stage_rc(tid * 16 + i * 8192, R, C); const int Rb = ((R & ~31) + perm32(R & 31));
    voffA[i] = (unsigned)(R * K + C) * 2u; voffB[i] = (unsigned)(Rb * K + C) * 2u; }
  const size_t kstep = (size_t)(BK * 2);
  const size_t hstep = (size_t)HALF * K * 2;
  const size_t tstep = 2 * hstep;
  const unsigned ldsw = (unsigned)wid * 1024u;
  const int aoff = lds_byte(wr * 64 + fr, fq * 8), boff = lds_byte(wc * 32 + fr, fq * 8);
#define PG8_SA(b, h) (((b) * 2 + (h)) * HTB)
#define PG8_SB(b, h) ((4 + (b) * 2 + (h)) * HTB)
#define PG8_STAGE(bufoff, gbase, voff) do { _Pragma("unroll") for (int _i = 0; _i < 2; ++_i) \
    __builtin_amdgcn_global_load_lds((const unsigned*)((const char*)(gbase) + (voff)[_i]), (PG8_LAS unsigned*)(lds + (bufoff) + ldsw + _i * 8192), 16, 0, 0); } while (0)
#define PG8_LDA(dst, b, h) do { _Pragma("unroll") for (int m = 0; m < 4; ++m) _Pragma("unroll") for (int k = 0; k < 2; ++k) dst[m][k] = *(const PG8_LAS bf16x8*)(lds + PG8_SA(b, h) + aoff + m * 2048 + k * 1024); } while (0)
#define PG8_LDB(dst, b, h) do { _Pragma("unroll") for (int n = 0; n < 2; ++n) _Pragma("unroll") for (int k = 0; k < 2; ++k) dst[n][k] = *(const PG8_LAS bf16x8*)(lds + PG8_SB(b, h) + boff + n * 2048 + k * 1024); } while (0)
#define PG8_MMA(ai, bj, At, Bt) do { __builtin_amdgcn_s_setprio(1); _Pragma("unroll") for (int m = 0; m < 4; ++m) _Pragma("unroll") for (int n = 0; n < 2; ++n) _Pragma("unroll") for (int k = 0; k < 2; ++k) { \
    if constexpr (F16) acc[ai][bj][m][n] = __builtin_amdgcn_mfma_f32_16x16x32_f16(__builtin_bit_cast(f16x8, Bt[n][k]), __builtin_bit_cast(f16x8, At[m][k]), acc[ai][bj][m][n], 0, 0, 0); \
    else acc[ai][bj][m][n] = __builtin_amdgcn_mfma_f32_16x16x32_bf16(Bt[n][k], At[m][k], acc[ai][bj][m][n], 0, 0, 0); } __builtin_amdgcn_s_setprio(0); } while (0)
#define PG8_WAIT_V(n) asm volatile("s_waitcnt vmcnt(" #n ")" ::: "memory")
#define PG8_WAIT_L(n) asm volatile("s_waitcnt lgkmcnt(" #n ")" ::: "memory")
#define PG8_BAR __builtin_amdgcn_s_barrier()
#define PG8_SCHED __builtin_amdgcn_sched_barrier(0)
  Unit cur, nxt; int ui = 0;
  if (!S.next(0, cur)) return;
  f32x4 acc[2][2][4][2];
#pragma unroll
  for (int a = 0; a < 2; ++a)
#pragma unroll
    for (int b = 0; b < 2; ++b)
#pragma unroll
      for (int m = 0; m < 4; ++m)
#pragma unroll
        for (int n = 0; n < 2; ++n) acc[a][b][m][n] = (f32x4){0.f, 0.f, 0.f, 0.f};
  bf16x8 At[4][2], B0[2][2], B1[2][2];
  const char* cA = (const char*)g.A + (size_t)cur.pm * tstep; const char* cB = (const char*)g.Bt + (size_t)cur.pn * tstep;
  PG8_STAGE(PG8_SB(0, 0), cB, voffB); PG8_STAGE(PG8_SA(0, 0), cA, voffA); PG8_STAGE(PG8_SB(0, 1), cB + hstep, voffB); PG8_STAGE(PG8_SA(0, 1), cA + hstep, voffA);
  if (wr == 1) PG8_BAR;
  PG8_WAIT_V(4); PG8_BAR;
  PG8_STAGE(PG8_SB(1, 0), cB + kstep, voffB); PG8_STAGE(PG8_SA(1, 0), cA + kstep, voffA); PG8_STAGE(PG8_SB(1, 1), cB + hstep + kstep, voffB);
  PG8_WAIT_V(6); PG8_BAR;
  for (;;) {
    const bool has_next = S.next(ui + 1, nxt);
    const char* nA = has_next ? (const char*)g.A + (size_t)nxt.pm * tstep : cA; const char* nB = has_next ? (const char*)g.Bt + (size_t)nxt.pn * tstep : cB;
    for (int t = 0; t < nt; t += 2) {
      const bool last = (t == nt - 2);
      const char* a1 = cA + (size_t)(t + 1) * kstep;
      const char* a2 = last ? nA : cA + (size_t)(t + 2) * kstep; const char* b2 = last ? nB : cB + (size_t)(t + 2) * kstep;
      const char* a3 = a2 + kstep; const char* b3 = b2 + kstep;
      PG8_LDB(B0, 0, 0); PG8_SCHED; PG8_LDA(At, 0, 0); PG8_STAGE(PG8_SA(1, 1), a1 + hstep, voffA);
      PG8_WAIT_L(8); PG8_BAR; PG8_WAIT_L(0); PG8_MMA(0, 0, At, B0); PG8_BAR; PG8_SCHED;
      PG8_LDB(B1, 0, 1); PG8_STAGE(PG8_SB(0, 0), b2, voffB);
      PG8_BAR; PG8_WAIT_L(0); PG8_MMA(0, 1, At, B1); PG8_BAR;
      PG8_LDA(At, 0, 1); PG8_STAGE(PG8_SA(0, 0), a2, voffA);
      PG8_BAR; PG8_WAIT_L(0); PG8_MMA(1, 0, At, B0); PG8_BAR; PG8_SCHED;
      PG8_STAGE(PG8_SB(0, 1), b2 + hstep, voffB);
      PG8_WAIT_V(6); PG8_BAR; PG8_MMA(1, 1, At, B1); PG8_BAR;
      PG8_LDB(B0, 1, 0); PG8_SCHED; PG8_LDA(At, 1, 0); PG8_STAGE(PG8_SA(0, 1), a2 + hstep, voffA);
      PG8_WAIT_L(8); PG8_BAR; PG8_WAIT_L(0); PG8_MMA(0, 0, At, B0); PG8_BAR; PG8_SCHED;
      PG8_LDB(B1, 1, 1); PG8_STAGE(PG8_SB(1, 0), b3, voffB);
      PG8_BAR; PG8_WAIT_L(0); PG8_MMA(0, 1, At, B1); PG8_BAR;
      PG8_LDA(At, 1, 1); PG8_STAGE(PG8_SA(1, 0), a3, voffA);
      PG8_BAR; PG8_WAIT_L(0); PG8_MMA(1, 0, At, B0); PG8_BAR; PG8_SCHED;
      PG8_STAGE(PG8_SB(1, 1), b3 + hstep, voffB);
      PG8_WAIT_V(6); PG8_BAR; PG8_MMA(1, 1, At, B1); PG8_BAR;
    }
    E(acc, cur, wr, wc, fr, fq);
    if (!has_next) break;
#pragma unroll
    for (int a = 0; a < 2; ++a)
#pragma unroll
      for (int b = 0; b < 2; ++b)
#pragma unroll
        for (int m = 0; m < 4; ++m)
#pragma unroll
          for (int n = 0; n < 2; ++n) acc[a][b][m][n] = (f32x4){0.f, 0.f, 0.f, 0.f};
    cur = nxt; cA = nA; cB = nB; ++ui;
  }
  PG8_WAIT_V(0);
  if (wr == 0) PG8_BAR;
  PG8_BAR;
#undef PG8_SA
#undef PG8_SB
#undef PG8_STAGE
#undef PG8_LDA
#undef PG8_LDB
#undef PG8_MMA
#undef PG8_WAIT_V
#undef PG8_WAIT_L
#undef PG8_BAR
#undef PG8_SCHED
}

template <class Epi0, class Epi1>
__device__ __forceinline__ void gemm_phase2(PG8_LAS unsigned char* lds, const Gemm g0, const Gemm g1, const StaticOrder& S, const Epi0& E0, const Epi1& E1) {
  const int tid = ptid(), wid = __builtin_amdgcn_readfirstlane(tid >> 6), lane = tid & 63, wr = wid >> 2, wc = wid & 3, fr = lane & 15, fq = lane >> 4;
  unsigned rA2[2], rB2[2], c2[2];
#pragma unroll
  for (int i = 0; i < 2; ++i) { int R, C; stage_rc(tid * 16 + i * 8192, R, C); rA2[i] = 2u * (unsigned)R; rB2[i] = 2u * (unsigned)((R & ~31) + perm32(R & 31)); c2[i] = 2u * (unsigned)C; }
  const size_t kstep = (size_t)(BK * 2);
  const unsigned ldsw = (unsigned)wid * 1024u;
  const int aoff = lds_byte(wr * 64 + fr, fq * 8), boff = lds_byte(wc * 32 + fr, fq * 8);
#define PG8_SA(b, h) (((b) * 2 + (h)) * HTB)
#define PG8_SB(b, h) ((4 + (b) * 2 + (h)) * HTB)
#define PG8_STAGE2(bufoff, gbase, r2, kk) do { \
    __builtin_amdgcn_global_load_lds((const unsigned*)((const char*)(gbase) + ((r2)[0] * (unsigned)(kk) + c2[0])), (PG8_LAS unsigned*)(lds + (bufoff) + ldsw), 16, 0, 0); \
    __builtin_amdgcn_global_load_lds((const unsigned*)((const char*)(gbase) + ((r2)[1] * (unsigned)(kk) + c2[1])), (PG8_LAS unsigned*)(lds + (bufoff) + ldsw + 8192), 16, 0, 0); } while (0)
#define PG8_LDA(dst, b, h) do { _Pragma("unroll") for (int m = 0; m < 4; ++m) _Pragma("unroll") for (int k = 0; k < 2; ++k) dst[m][k] = *(const PG8_LAS bf16x8*)(lds + PG8_SA(b, h) + aoff + m * 2048 + k * 1024); } while (0)
#define PG8_LDB(dst, b, h) do { _Pragma("unroll") for (int n = 0; n < 2; ++n) _Pragma("unroll") for (int k = 0; k < 2; ++k) dst[n][k] = *(const PG8_LAS bf16x8*)(lds + PG8_SB(b, h) + boff + n * 2048 + k * 1024); } while (0)
#define PG8_MMA(ai, bj, At, Bt) do { __builtin_amdgcn_s_setprio(1); _Pragma("unroll") for (int m = 0; m < 4; ++m) _Pragma("unroll") for (int n = 0; n < 2; ++n) _Pragma("unroll") for (int k = 0; k < 2; ++k) \
    acc[ai][bj][m][n] = __builtin_amdgcn_mfma_f32_16x16x32_bf16(Bt[n][k], At[m][k], acc[ai][bj][m][n], 0, 0, 0); __builtin_amdgcn_s_setprio(0); } while (0)
#define PG8_WAIT_V(n) asm volatile("s_waitcnt vmcnt(" #n ")" ::: "memory")
#define PG8_WAIT_L(n) asm volatile("s_waitcnt lgkmcnt(" #n ")" ::: "memory")
#define PG8_BAR __builtin_amdgcn_s_barrier()
#define PG8_SCHED __builtin_amdgcn_sched_barrier(0)
  Unit cur, nxtu; int ui = 0, which = 0;
  if (!S.next(0, cur)) return;
  f32x4 acc[2][2][4][2];
#pragma unroll
  for (int a = 0; a < 2; ++a)
#pragma unroll
    for (int b = 0; b < 2; ++b)
#pragma unroll
      for (int m = 0; m < 4; ++m)
#pragma unroll
        for (int n = 0; n < 2; ++n) acc[a][b][m][n] = (f32x4){0.f, 0.f, 0.f, 0.f};
  bf16x8 At[4][2], B0[2][2], B1[2][2];
  int K = g0.K; size_t hstep = (size_t)HALF * K * 2;
  const char* cA = (const char*)g0.A + (size_t)cur.pm * 2 * hstep; const char* cB = (const char*)g0.Bt + (size_t)cur.pn * 2 * hstep;
  PG8_STAGE2(PG8_SB(0, 0), cB, rB2, K); PG8_STAGE2(PG8_SA(0, 0), cA, rA2, K); PG8_STAGE2(PG8_SB(0, 1), cB + hstep, rB2, K); PG8_STAGE2(PG8_SA(0, 1), cA + hstep, rA2, K);
  if (wr == 1) PG8_BAR;
  PG8_WAIT_V(4); PG8_BAR;
  PG8_STAGE2(PG8_SB(1, 0), cB + kstep, rB2, K); PG8_STAGE2(PG8_SA(1, 0), cA + kstep, rA2, K); PG8_STAGE2(PG8_SB(1, 1), cB + hstep + kstep, rB2, K);
  PG8_WAIT_V(6); PG8_BAR;
  for (;;) {
    bool has_next; int nwhich; Unit nu = cur;
    if (which == 0) { has_next = true; nwhich = 1; } else { has_next = S.next(ui + 1, nxtu); nwhich = 0; if (has_next) nu = nxtu; }
    const u16* gnA = nwhich ? g1.A : g0.A; const u16* gnB = nwhich ? g1.Bt : g0.Bt; const int gnK = nwhich ? g1.K : g0.K;
    const int nK = has_next ? gnK : K; const size_t nhstep = (size_t)HALF * nK * 2;
    const char* nA = has_next ? (const char*)gnA + (size_t)nu.pm * 2 * nhstep : cA; const char* nB = has_next ? (const char*)gnB + (size_t)nu.pn * 2 * nhstep : cB;
    const int nt = K / BK;
    for (int t = 0; t < nt; t += 2) {
      const bool last = (t == nt - 2);
      const char* a1 = cA + (size_t)(t + 1) * kstep;
      const char* a2 = last ? nA : cA + (size_t)(t + 2) * kstep; const char* b2 = last ? nB : cB + (size_t)(t + 2) * kstep;
      const char* a3 = a2 + kstep; const char* b3 = b2 + kstep;
      const size_t h2 = last ? nhstep : hstep;
      const int K2 = last ? nK : K;
      PG8_LDB(B0, 0, 0); PG8_SCHED; PG8_LDA(At, 0, 0); PG8_STAGE2(PG8_SA(1, 1), a1 + hstep, rA2, K);
      PG8_WAIT_L(8); PG8_BAR; PG8_WAIT_L(0); PG8_MMA(0, 0, At, B0); PG8_BAR; PG8_SCHED;
      PG8_LDB(B1, 0, 1); PG8_STAGE2(PG8_SB(0, 0), b2, rB2, K2);
      PG8_BAR; PG8_WAIT_L(0); PG8_MMA(0, 1, At, B1); PG8_BAR;
      PG8_LDA(At, 0, 1); PG8_STAGE2(PG8_SA(0, 0), a2, rA2, K2);
      PG8_BAR; PG8_WAIT_L(0); PG8_MMA(1, 0, At, B0); PG8_BAR; PG8_SCHED;
      PG8_STAGE2(PG8_SB(0, 1), b2 + h2, rB2, K2);
      PG8_WAIT_V(6); PG8_BAR; PG8_MMA(1, 1, At, B1); PG8_BAR;
      PG8_LDB(B0, 1, 0); PG8_SCHED; PG8_LDA(At, 1, 0); PG8_STAGE2(PG8_SA(0, 1), a2 + h2, rA2, K2);
      PG8_WAIT_L(8); PG8_BAR; PG8_WAIT_L(0); PG8_MMA(0, 0, At, B0); PG8_BAR; PG8_SCHED;
      PG8_LDB(B1, 1, 1); PG8_STAGE2(PG8_SB(1, 0), b3, rB2, K2);
      PG8_BAR; PG8_WAIT_L(0); PG8_MMA(0, 1, At, B1); PG8_BAR;
      PG8_LDA(At, 1, 1); PG8_STAGE2(PG8_SA(1, 0), a3, rA2, K2);
      PG8_BAR; PG8_WAIT_L(0); PG8_MMA(1, 0, At, B0); PG8_BAR; PG8_SCHED;
      PG8_STAGE2(PG8_SB(1, 1), b3 + h2, rB2, K2);
      PG8_WAIT_V(6); PG8_BAR; PG8_MMA(1, 1, At, B1); PG8_BAR;
    }
    if (which == 0) E0(acc, cur, wr, wc, fr, fq); else E1(acc, cur, wr, wc, fr, fq);
    if (!has_next) break;
#pragma unroll
    for (int a = 0; a < 2; ++a)
#pragma unroll
      for (int b = 0; b < 2; ++b)
#pragma unroll
        for (int m = 0; m < 4; ++m)
#pragma unroll
          for (int n = 0; n < 2; ++n) acc[a][b][m][n] = (f32x4){0.f, 0.f, 0.f, 0.f};
    if (which == 1) { cur = nu; ++ui; }
    which = nwhich; K = nK; hstep = nhstep; cA = nA; cB = nB;
  }
  PG8_WAIT_V(0);
  if (wr == 0) PG8_BAR;
  PG8_BAR;
#undef PG8_SA
#undef PG8_SB
#undef PG8_STAGE2
#undef PG8_LDA
#undef PG8_LDB
#undef PG8_MMA
#undef PG8_WAIT_V
#undef PG8_WAIT_L
#undef PG8_BAR
#undef PG8_SCHED
}
}

typedef pg8::f32x4 f32x4; typedef pg8::u32x4 u32x4;
template <class F> __device__ __forceinline__ void epi_walk(const f32x4 (&acc)[2][2][4][2], const pg8::Unit& u, int wr, int wc, int fr, int fq, F&& f) {
  const int row0 = u.pm * 256 + wr * 64 + fr, col0 = u.pn * 256 + wc * 32 + 8 * fq;
#pragma unroll
  for (int ai = 0; ai < 2; ++ai)
#pragma unroll
    for (int m = 0; m < 4; ++m)
#pragma unroll
      for (int bj = 0; bj < 2; ++bj) f(row0 + ai * 128 + m * 16, col0 + bj * 128, acc[ai][bj][m][0], acc[ai][bj][m][1]);
}
__device__ __forceinline__ u32x4 pack8_bf16(f32x4 v0, f32x4 v1) { u32x4 w; w.x = pg8::cvt_pk_bf16(v0[0], v0[1]); w.y = pg8::cvt_pk_bf16(v0[2], v0[3]); w.z = pg8::cvt_pk_bf16(v1[0], v1[1]); w.w = pg8::cvt_pk_bf16(v1[2], v1[3]); return w; }
__device__ __forceinline__ u32x4 pack8_f16(f32x4 v0, f32x4 v1) { u32x4 w; w.x = pg8::cvt_pk_f16(v0[0], v0[1]); w.y = pg8::cvt_pk_f16(v0[2], v0[3]); w.z = pg8::cvt_pk_f16(v1[0], v1[1]); w.w = pg8::cvt_pk_f16(v1[2], v1[3]); return w; }
__device__ __forceinline__ void unpack8_bf16(u32x4 w, float (&f)[8]) {
  f[0] = __uint_as_float(w.x << 16); f[1] = __uint_as_float(w.x & 0xffff0000u); f[2] = __uint_as_float(w.y << 16); f[3] = __uint_as_float(w.y & 0xffff0000u);
  f[4] = __uint_as_float(w.z << 16); f[5] = __uint_as_float(w.z & 0xffff0000u); f[6] = __uint_as_float(w.w << 16); f[7] = __uint_as_float(w.w & 0xffff0000u); }

typedef unsigned u32x2v __attribute__((ext_vector_type(2)));
__device__ __forceinline__ u32x2v pack8_fp8(f32x4 v0, f32x4 v1) { int a = 0, b = 0;
  a = __builtin_amdgcn_cvt_pk_fp8_f32(v0[0], v0[1], a, false); a = __builtin_amdgcn_cvt_pk_fp8_f32(v0[2], v0[3], a, true);
  b = __builtin_amdgcn_cvt_pk_fp8_f32(v1[0], v1[1], b, false); b = __builtin_amdgcn_cvt_pk_fp8_f32(v1[2], v1[3], b, true);
  u32x2v r; r.x = (unsigned)a; r.y = (unsigned)b; return r; }
__device__ __forceinline__ void unpack8_fp8(u32x2v w, float (&f)[8]) { const int a = (int)w.x, b = (int)w.y;
  const auto p0 = __builtin_amdgcn_cvt_pk_f32_fp8(a, false), p1 = __builtin_amdgcn_cvt_pk_f32_fp8(a, true), p2 = __builtin_amdgcn_cvt_pk_f32_fp8(b, false), p3 = __builtin_amdgcn_cvt_pk_f32_fp8(b, true);
  f[0] = p0[0]; f[1] = p0[1]; f[2] = p1[0]; f[3] = p1[1]; f[4] = p2[0]; f[5] = p2[1]; f[6] = p3[0]; f[7] = p3[1]; }
struct FEpiInProj {
  u16 *rq, *rk, *rv, *rg, *sq, *sk, *sv, *ga, *gb;
  __device__ __forceinline__ void operator()(const f32x4 (&acc)[2][2][4][2], const pg8::Unit& u, int wr, int wc, int fr, int fq) const {
    const int c = u.pn * 256; u16* b; int ld, c0;
    if (c < 512) { b = rq; ld = 512; c0 = 0; } else if (c < 1024) { b = rk; ld = 512; c0 = 512; } else if (c < 2048) { b = rv; ld = 1024; c0 = 1024; }
    else if (c < 3072) { b = rg; ld = 1024; c0 = 2048; } else if (c < 3584) { b = sq; ld = 512; c0 = 3072; } else if (c < 4096) { b = sk; ld = 512; c0 = 3584; }
    else if (c < 4608) { b = sv; ld = 512; c0 = 4096; } else if (c < 5632) { b = ga; ld = 1024; c0 = 4608; } else { b = gb; ld = 1024; c0 = 5632; }
    if (c >= 4608) {
      unsigned char* g8 = (unsigned char*)b;
      epi_walk(acc, u, wr, wc, fr, fq, [&](int row, int col, f32x4 v0, f32x4 v1) { *(u32x2v*)(g8 + (size_t)row * 1024 + (col - c0)) = pack8_fp8(v0, v1); });
    } else
    epi_walk(acc, u, wr, wc, fr, fq, [&](int row, int col, f32x4 v0, f32x4 v1) { *(u32x4*)(b + (size_t)row * ld + (col - c0)) = pack8_bf16(v0, v1); });
  }
};
struct FEpiMixB { u16* mixed; const u16* gb;
  __device__ __forceinline__ void operator()(const f32x4 (&acc)[2][2][4][2], const pg8::Unit& u, int wr, int wc, int fr, int fq) const {
    const int row0 = u.pm * 256 + wr * 64 + fr, col0 = u.pn * 256 + wc * 32 + 8 * fq;
#pragma unroll
    for (int ai = 0; ai < 2; ++ai) {
      u32x2v gw[4][2];
#pragma unroll
      for (int m = 0; m < 4; ++m)
#pragma unroll
        for (int bj = 0; bj < 2; ++bj) gw[m][bj] = *(const u32x2v*)((const unsigned char*)gb + (size_t)(row0 + ai * 128 + m * 16) * D_ + col0 + bj * 128);
#pragma unroll
      for (int m = 0; m < 4; ++m)
#pragma unroll
        for (int bj = 0; bj < 2; ++bj) { const size_t i = (size_t)(row0 + ai * 128 + m * 16) * D_ + col0 + bj * 128; float g[8]; unpack8_fp8(gw[m][bj], g);
          const f32x4 v0 = acc[ai][bj][m][0], v1 = acc[ai][bj][m][1]; f32x4 a, b2;
          a[0] = sigmoidf_(g[0]) * v0[0]; a[1] = sigmoidf_(g[1]) * v0[1]; a[2] = sigmoidf_(g[2]) * v0[2]; a[3] = sigmoidf_(g[3]) * v0[3];
          b2[0] = sigmoidf_(g[4]) * v1[0]; b2[1] = sigmoidf_(g[5]) * v1[1]; b2[2] = sigmoidf_(g[6]) * v1[2]; b2[3] = sigmoidf_(g[7]) * v1[3];
          *(u32x4*)(mixed + i) = pack8_bf16(a, b2); }
    }
  }
};
struct FEpiMixA { u16* mixed; const u16* ga;
  __device__ __forceinline__ void operator()(const f32x4 (&acc)[2][2][4][2], const pg8::Unit& u, int wr, int wc, int fr, int fq) const {
    const int row0 = u.pm * 256 + wr * 64 + fr, col0 = u.pn * 256 + wc * 32 + 8 * fq;
#pragma unroll
    for (int ai = 0; ai < 2; ++ai)
#pragma unroll
      for (int mh = 0; mh < 2; ++mh) {
        u32x2v gw[2][2]; u32x4 ow[2][2];
#pragma unroll
        for (int mm = 0; mm < 2; ++mm)
#pragma unroll
          for (int bj = 0; bj < 2; ++bj) { const size_t i = (size_t)(row0 + ai * 128 + (2 * mh + mm) * 16) * D_ + col0 + bj * 128; gw[mm][bj] = *(const u32x2v*)((const unsigned char*)ga + i); ow[mm][bj] = *(const u32x4*)(mixed + i); }
#pragma unroll
        for (int mm = 0; mm < 2; ++mm)
#pragma unroll
          for (int bj = 0; bj < 2; ++bj) { const int m = 2 * mh + mm; const size_t i = (size_t)(row0 + ai * 128 + m * 16) * D_ + col0 + bj * 128; float g[8], o[8]; unpack8_fp8(gw[mm][bj], g); unpack8_bf16(ow[mm][bj], o);
            const f32x4 v0 = acc[ai][bj][m][0], v1 = acc[ai][bj][m][1]; f32x4 a, b2;
            a[0] = o[0] + sigmoidf_(g[0]) * v0[0]; a[1] = o[1] + sigmoidf_(g[1]) * v0[1]; a[2] = o[2] + sigmoidf_(g[2]) * v0[2]; a[3] = o[3] + sigmoidf_(g[3]) * v0[3];
            b2[0] = o[4] + sigmoidf_(g[4]) * v1[0]; b2[1] = o[5] + sigmoidf_(g[5]) * v1[1]; b2[2] = o[6] + sigmoidf_(g[6]) * v1[2]; b2[3] = o[7] + sigmoidf_(g[7]) * v1[3];
            *(u32x4*)(mixed + i) = pack8_bf16(a, b2); }
      }
  }
};
struct FEpiOut { const float* x; float* x1; u16* x1h; float* ssq;
  __device__ __forceinline__ void operator()(const f32x4 (&acc)[2][2][4][2], const pg8::Unit& u, int wr, int wc, int fr, int fq) const {
    const int row0 = u.pm * 256 + wr * 64 + fr, col0 = u.pn * 256 + wc * 32 + 8 * fq;
#pragma unroll
    for (int ai = 0; ai < 2; ++ai) {
      f32x4 xa[4][2], xb[4][2];
#pragma unroll
      for (int m = 0; m < 4; ++m)
#pragma unroll
        for (int bj = 0; bj < 2; ++bj) { const size_t i = (size_t)(row0 + ai * 128 + m * 16) * D_ + col0 + bj * 128; xa[m][bj] = *(const f32x4*)(x + i); xb[m][bj] = *(const f32x4*)(x + i + 4); }
#pragma unroll
      for (int m = 0; m < 4; ++m) {
        const int row = row0 + ai * 128 + m * 16; float ss = 0.f;
#pragma unroll
        for (int bj = 0; bj < 2; ++bj) {
          const size_t i = (size_t)row * D_ + col0 + bj * 128;
          const f32x4 a = xa[m][bj] + acc[ai][bj][m][0], b2 = xb[m][bj] + acc[ai][bj][m][1];
          *(u32x4*)(x1h + i) = pack8_f16(a, b2);
          ss += a[0] * a[0] + a[1] * a[1] + a[2] * a[2] + a[3] * a[3] + b2[0] * b2[0] + b2[1] * b2[1] + b2[2] * b2[2] + b2[3] * b2[3];
        }
        ss += __shfl_xor(ss, 16); ss += __shfl_xor(ss, 32);
        if (fq == 0 && ssq) atomicAdd(ssq + row, ss);
      }
    }
  }
};
struct FEpiQ { const float* ssq; u16* q;
  __device__ __forceinline__ void operator()(const f32x4 (&acc)[2][2][4][2], const pg8::Unit& u, int wr, int wc, int fr, int fq) const {
    const int row0 = u.pm * 256 + wr * 64 + fr, col0 = u.pn * 256 + wc * 32 + 8 * fq;
    float rs[2][4];
#pragma unroll
    for (int ai = 0; ai < 2; ++ai)
#pragma unroll
      for (int m = 0; m < 4; ++m) rs[ai][m] = ssq[row0 + ai * 128 + m * 16];
#pragma unroll
    for (int ai = 0; ai < 2; ++ai)
#pragma unroll
      for (int m = 0; m < 4; ++m) { const float rstd = rsqrtf(rs[ai][m] * (1.0f / D_) + 1e-6f);
#pragma unroll
        for (int bj = 0; bj < 2; ++bj) *(u32x4*)(q + (size_t)(row0 + ai * 128 + m * 16) * 2048 + col0 + bj * 128) = pack8_bf16(acc[ai][bj][m][0] * rstd, acc[ai][bj][m][1] * rstd); }
  }
};

#define LAS __attribute__((address_space(3)))
typedef short s16x8 __attribute__((ext_vector_type(8)));
typedef short s16x4 __attribute__((ext_vector_type(4)));
typedef float f32x16 __attribute__((ext_vector_type(16)));
typedef float f32x2 __attribute__((ext_vector_type(2)));
typedef __bf16 bf16x2_t __attribute__((ext_vector_type(2)));
typedef _Float16 h16x2 __attribute__((ext_vector_type(2)));
__device__ __forceinline__ unsigned pk_bf16(float lo, float hi) { f32x2 v = {lo, hi}; return __builtin_bit_cast(unsigned, __builtin_convertvector(v, bf16x2_t)); }
__device__ __forceinline__ unsigned pk_f16(float lo, float hi) { f32x2 v = {lo, hi}; return __builtin_bit_cast(unsigned, __builtin_convertvector(v, h16x2)); }
#define MFMA32(a, b, c) __builtin_amdgcn_mfma_f32_32x32x16_bf16((a), (b), (c), 0, 0, 0)
#define MFMA16(a, b, c) __builtin_amdgcn_mfma_f32_16x16x32_bf16((a), (b), (c), 0, 0, 0)

struct Params {
  const float *x, *norm_attn, *w_in, *ret_q_norm, *ret_k_norm, *ret_gn, *sb_q_norm, *sb_k_norm, *w_bra, *w_brb, *w_out, *norm_ffn, *w_q, *sk1, *sk2, *peer_u, *peer_v;
  float* out; char* ws;
  float l2g[8];
  int use_cg, pad;
};

template <bool F16> __device__ __forceinline__ void transpose_tile(const float* __restrict__ W, u16* __restrict__ Wt, int K, int N, int k0, int n0, const float* __restrict__ scale, float* tile  ) {
  const int tid = ptid();
  { const int r = tid >> 4, c4 = tid & 15;
#pragma unroll
    for (int hh = 0; hh < 2; ++hh) { const int k = k0 + r + 32 * hh; float4 v = *(const float4*)(W + (size_t)k * N + n0 + 4 * c4); const float s = scale ? scale[k] : 1.0f;
      float* tp = tile + (r + 32 * hh) * 65 + 4 * c4; tp[0] = v.x * s; tp[1] = v.y * s; tp[2] = v.z * s; tp[3] = v.w * s; } }
  __syncthreads();
  { const int n = tid >> 3, kc = tid & 7; float f[8];
#pragma unroll
    for (int i = 0; i < 8; ++i) f[i] = tile[(8 * kc + i) * 65 + n];
    u32x4 w;
    if (F16) { w.x = pk_f16(f[0], f[1]); w.y = pk_f16(f[2], f[3]); w.z = pk_f16(f[4], f[5]); w.w = pk_f16(f[6], f[7]); }
    else { w.x = pk_bf16(f[0], f[1]); w.y = pk_bf16(f[2], f[3]); w.z = pk_bf16(f[4], f[5]); w.w = pk_bf16(f[6], f[7]); }
    *(u32x4*)(Wt + (size_t)(n0 + n) * K + k0 + 8 * kc) = w; }
  __syncthreads();
}
__device__ __forceinline__ void phase_prologue(const Params& p, unsigned char* smem, char* dob) {
  const int tid = ptid(), lane = tid & 63, w = tid >> 6, G = gridDim.x, b = blockIdx.x;
  u16* XN = (u16*)(dob + DO_XN);
  for (int t0 = b * 8 + w; t0 < S_; t0 += 2 * G * 8) {
    float4 v[2][4]; float4 gq[4];
#pragma unroll
    for (int i = 0; i < 4; ++i) gq[i] = *(const float4*)(p.norm_attn + lane * 16 + 4 * i);
#pragma unroll
    for (int rr = 0; rr < 2; ++rr) { const int t = t0 + rr * G * 8 < S_ ? t0 + rr * G * 8 : t0; const float* xp = p.x + (size_t)t * D_ + lane * 16;
#pragma unroll
      for (int i = 0; i < 4; ++i) v[rr][i] = *(const float4*)(xp + 4 * i); }
#pragma unroll
    for (int rr = 0; rr < 2; ++rr) { const int t = t0 + rr * G * 8; if (t < S_) {
      float ss = 0.f;
#pragma unroll
      for (int i = 0; i < 4; ++i) ss += v[rr][i].x * v[rr][i].x + v[rr][i].y * v[rr][i].y + v[rr][i].z * v[rr][i].z + v[rr][i].w * v[rr][i].w;
#pragma unroll
      for (int o = 32; o > 0; o >>= 1) ss += __shfl_xor(ss, o);
      const float r = rsqrtf(ss * (1.0f / D_) + 1e-6f);
      u32x4 o0, o1;
      o0.x = pk_bf16(v[rr][0].x * r * gq[0].x, v[rr][0].y * r * gq[0].y); o0.y = pk_bf16(v[rr][0].z * r * gq[0].z, v[rr][0].w * r * gq[0].w); o0.z = pk_bf16(v[rr][1].x * r * gq[1].x, v[rr][1].y * r * gq[1].y); o0.w = pk_bf16(v[rr][1].z * r * gq[1].z, v[rr][1].w * r * gq[1].w);
      o1.x = pk_bf16(v[rr][2].x * r * gq[2].x, v[rr][2].y * r * gq[2].y); o1.y = pk_bf16(v[rr][2].z * r * gq[2].z, v[rr][2].w * r * gq[2].w); o1.z = pk_bf16(v[rr][3].x * r * gq[3].x, v[rr][3].y * r * gq[3].y); o1.w = pk_bf16(v[rr][3].z * r * gq[3].z, v[rr][3].w * r * gq[3].w);
      u16* op = XN + (size_t)t * D_ + lane * 16; *(u32x4*)op = o0; *(u32x4*)(op + 8) = o1; } }
  }
  float* tile = (float*)smem;
  for (int j = b; j < 2816; j += G) {
    if (j < 1664) { transpose_tile<false>(p.w_in, (u16*)(dob + DO_WINT), 1024, 6656, (j / 104) * 64, (j % 104) * 64, nullptr, tile); }
    else if (j < 1920) { const int q = j - 1664; transpose_tile<false>(p.w_bra, (u16*)(dob + DO_WBRAT), 1024, 1024, (q / 16) * 64, (q % 16) * 64, nullptr, tile); }
    else if (j < 2048) { const int q = j - 1920; transpose_tile<false>(p.w_brb, (u16*)(dob + DO_WBRBT), 512, 1024, (q / 16) * 64, (q % 16) * 64, nullptr, tile); }
    else if (j < 2304) { const int q = j - 2048; transpose_tile<false>(p.w_out, (u16*)(p.ws + WS_WOUTT), 1024, 1024, (q / 16) * 64, (q % 16) * 64, nullptr, tile); }
    else { const int q = j - 2304; transpose_tile<true>(p.w_q, (u16*)(p.ws + WS_WQT), 1024, 2048, (q / 32) * 64, (q % 32) * 64, p.norm_ffn, tile); }
  }
  const int gt = b * 512 + tid, GT = G * 512;
  for (int i = gt; i < 16384; i += GT) { ((u16*)(p.ws + WS_K1))[i] = f2bf(p.sk1[i]); ((u16*)(p.ws + WS_K2))[i] = f2bf(p.sk2[i]); ((float*)(p.ws + WS_SSQ))[i] = 0.f; }
  for (int i = gt; i < S_ * 32; i += GT) { const int t = i >> 5, f = i & 31; const float freq = powf(10000.0f, -(float)f / 32.0f); float sn, cs; sincosf((float)t * freq, &sn, &cs);
    ((float*)(p.ws + WS_ROPE_C))[i] = cs; ((float*)(p.ws + WS_ROPE_S))[i] = sn; }
}

#define WS_U8 (240 * MB_)
#define WS_V8 WS_RK
#define WS_HP WS_GA
#define WS_A WS_RV
#define U8_SCALE 256.0f
#define V8_SCALE 32.0f
#define SLICE_BYTES (16384 * 128)
__device__ __forceinline__ void conv_table(const Params& p, int which, int part, int nparts) {
  const size_t gt = (size_t)part * 512 + ptid(), GT = (size_t)nparts * 512, NC = (size_t)S_ * D_ / 8;
  unsigned char* T8 = (unsigned char*)(p.ws + (which == 0 ? WS_U8 : WS_V8)); const float* src = which == 0 ? p.peer_u : p.peer_v; const float sc = which == 0 ? U8_SCALE : V8_SCALE;
  for (size_t c0 = gt; c0 < NC; c0 += 4 * GT) {
    float4 a0[4], a1[4], g0[4], g1[4];
#pragma unroll
    for (int k = 0; k < 4; ++k) { const size_t c = c0 + k * GT < NC ? c0 + k * GT : c0, i = c * 8; const int col = (int)(i & (D_ - 1));
      a0[k] = *(const float4*)(src + i); a1[k] = *(const float4*)(src + i + 4);
      if (which == 0) { g0[k] = *(const float4*)(p.norm_ffn + col); g1[k] = *(const float4*)(p.norm_ffn + col + 4); } else { g0[k] = make_float4(1.f, 1.f, 1.f, 1.f); g1[k] = g0[k]; } }
#pragma unroll
    for (int k = 0; k < 4; ++k) { const size_t c = c0 + k * GT; if (c < NC) { const size_t i = c * 8; const int col = (int)(i & (D_ - 1)), e = (int)(i >> 10);
      const size_t dst = (size_t)(col >> 7) * SLICE_BYTES + (size_t)e * 128 + (col & 127);
      int w0 = 0, w1 = 0;
      w0 = __builtin_amdgcn_cvt_pk_fp8_f32(a0[k].x * g0[k].x * sc, a0[k].y * g0[k].y * sc, w0, false); w0 = __builtin_amdgcn_cvt_pk_fp8_f32(a0[k].z * g0[k].z * sc, a0[k].w * g0[k].w * sc, w0, true);
      w1 = __builtin_amdgcn_cvt_pk_fp8_f32(a1[k].x * g1[k].x * sc, a1[k].y * g1[k].y * sc, w1, false); w1 = __builtin_amdgcn_cvt_pk_fp8_f32(a1[k].z * g1[k].z * sc, a1[k].w * g1[k].w * sc, w1, true);
      *(uint2*)(T8 + dst) = make_uint2((unsigned)w0, (unsigned)w1); } }
  }
}

#define SEL_KSTR 272
#define INSERT16(V, x) do { const float _x = (x); _Pragma("unroll") for (int _j = 15; _j >= 1; --_j) V[_j] = __builtin_amdgcn_fmed3f(V[_j - 1], V[_j], _x); V[0] = fmaxf(V[0], _x); } while (0)
#define MERGE16(V) do { float _c[16]; _Pragma("unroll") for (int _i = 0; _i < 16; ++_i) _c[_i] = __shfl_xor(V[_i], 32); \
  _Pragma("unroll") for (int _i = 0; _i < 16; ++_i) V[_i] = fmaxf(V[_i], _c[15 - _i]); \
  _Pragma("unroll") for (int _k = 8; _k >= 1; _k >>= 1) { _Pragma("unroll") for (int _i = 0; _i < 16; ++_i) if ((_i & _k) == 0) { const float _hi = fmaxf(V[_i], V[_i + _k]), _lo = fminf(V[_i], V[_i + _k]); V[_i] = _hi; V[_i + _k] = _lo; } } } while (0)
__device__ __forceinline__ void select_side(const u16* __restrict__ qrow  , LAS unsigned char* ks, int lane, float (&V)[16]) {
  const int hh = lane >> 5, r = lane & 31;
  s16x8 bq[8];
#pragma unroll
  for (int k = 0; k < 8; ++k) bq[k] = *(const s16x8*)(qrow + 16 * k + 8 * hh);
#pragma unroll
  for (int j = 0; j < 16; ++j) V[j] = -3.0e38f;
#pragma unroll
  for (int a = 0; a < 4; ++a) {
    f32x16 acc;
#pragma unroll
    for (int i = 0; i < 16; ++i) acc[i] = 0.f;
#pragma unroll
    for (int k = 0; k < 8; ++k) { const s16x8 af = *(const LAS s16x8*)(ks + (32 * a + r) * SEL_KSTR + (16 * k + 8 * hh) * 2); acc = MFMA32(af, bq[k], acc); }
#pragma unroll
    for (int i = 0; i < 16; ++i) { const int n = 32 * a + (i & 3) + 8 * (i >> 2) + 4 * hh; const float key = __uint_as_float((__float_as_uint(acc[i]) & 0xFFFFFF80u) | (unsigned)n); INSERT16(V, key); }
  }
  MERGE16(V);
}
__device__ __forceinline__ void phase_select(const Params& p, unsigned char* smem, const pg8::StaticOrder& S) {
  const int tid = ptid(), lane = tid & 63, w = tid >> 6, hh = lane >> 5;
  LAS unsigned char* lds = (LAS unsigned char*)smem;
  LAS unsigned char* k1s = lds; LAS unsigned char* k2s = lds + 128 * SEL_KSTR; LAS unsigned* scr = (LAS unsigned*)(lds + 2 * 128 * SEL_KSTR + w * 4096);
  const u16* K1 = (const u16*)(p.ws + WS_K1); const u16* K2 = (const u16*)(p.ws + WS_K2); const u16* Q = (const u16*)(p.ws + WS_Q);
  u16* IDX = (u16*)(p.ws + WS_IDX); float* GW = (float*)(p.ws + WS_G);
  for (int c = tid; c < 2048; c += 512) { const int n = c >> 4, ch = c & 15;
    *(LAS u32x4*)(k1s + n * SEL_KSTR + ch * 16) = *(const u32x4*)(K1 + n * 128 + ch * 8); *(LAS u32x4*)(k2s + n * SEL_KSTR + ch * 16) = *(const u32x4*)(K2 + n * 128 + ch * 8); }
  __syncthreads();
  pg8::Unit un;
  for (int ui = 0; S.next(ui, un); ++ui) {
    const int tb = un.pm * 8 + w, h = un.pn, t = tb * 32 + (lane & 31);
    const u16* qrow = Q + (size_t)t * 2048 + h * 256;
    float v1[16], v2[16];
    select_side(qrow, k1s, lane, v1);
    select_side(qrow + 128, k2s, lane, v2);
    if (hh == 0) {
#pragma unroll
      for (int i = 0; i < 16; ++i) { scr[(lane & 31) * 32 + i] = __float_as_uint(v1[i]); scr[(lane & 31) * 32 + 16 + i] = __float_as_uint(v2[i]); } }
    float c[16];
#pragma unroll
    for (int j = 0; j < 16; ++j) c[j] = -3.0e38f;
    { int ci = 0; float pend = 0.f; unsigned pcode = 0;
#pragma unroll
      for (int a = 0; a < 16; ++a)
#pragma unroll
        for (int bb = 0; bb < 16; ++bb) if ((a + 1) * (bb + 1) <= 16) {
          const float s = v1[a] + v2[bb]; const unsigned code = (unsigned)(a * 16 + bb);
          if ((ci & 1) == 0) { pend = s; pcode = code; }
          else { const float x = hh ? s : pend; const unsigned cd = hh ? code : pcode; INSERT16(c, __uint_as_float((__float_as_uint(x) & 0xFFFFFF00u) | cd)); }
          ++ci; }
    }
    MERGE16(c);
    float sum = 0.f, e[16];
#pragma unroll
    for (int j = 0; j < 16; ++j) { e[j] = __expf(c[j] - c[0]); sum += e[j]; }
    const float inv = 1.0f / sum;
    unsigned ids[8]; float gs[8];
#pragma unroll
    for (int j = 0; j < 8; ++j) { float cl = c[j], ch = c[8 + j], el = e[j], eh = e[8 + j]; asm volatile("" : "+v"(cl), "+v"(ch), "+v"(el), "+v"(eh));
      const float cj = hh ? ch : cl; const unsigned code = __float_as_uint(cj) & 0xFFu; gs[j] = (hh ? eh : el) * inv;
      const unsigned k1 = scr[(lane & 31) * 32 + (code >> 4)], k2 = scr[(lane & 31) * 32 + 16 + (code & 15)]; ids[j] = (k1 & 127u) * 128u + (k2 & 127u); }
    u32x4 iw; iw.x = ids[0] | (ids[1] << 16); iw.y = ids[2] | (ids[3] << 16); iw.z = ids[4] | (ids[5] << 16); iw.w = ids[6] | (ids[7] << 16);
    *(u32x4*)(IDX + (size_t)t * 128 + h * 16 + 8 * hh) = iw;
    float* gp = GW + (size_t)t * 128 + h * 16 + 8 * hh; *(f32x4*)gp = (f32x4){gs[0], gs[1], gs[2], gs[3]}; *(f32x4*)(gp + 4) = (f32x4){gs[4], gs[5], gs[6], gs[7]};
  }
}

__device__ __forceinline__ unsigned xb_xcc_id();
#define LDS_BAR_OFF 147440
__device__ __forceinline__ float gelu_tanh_f(float x) { const float u = 0.7978845608028654f * (x + 0.044715f * x * x * x); const float e = __expf(2.0f * u); return x * (1.0f - 1.0f / (e + 1.0f)); }
#define GQ_WORD(ph, x) (4096 + 64 * ((ph) * 8 + (x)))
#define GCHUNK 32
__device__ __forceinline__ int gq_next(unsigned* ctr, volatile LAS int* slot) {
  if (ptid() == 0) *slot = (int)__hip_atomic_fetch_add(ctr, 1u, __ATOMIC_RELAXED, __HIP_MEMORY_SCOPE_AGENT);
  __syncthreads(); const int v = *slot; __syncthreads(); return v;
}
#define NTOK 16
template <int SIDE, bool DRY> __device__ __forceinline__ void gather_wave_chunk(const Params& p, int tb, int x, int lane) {
  const int ps = lane >> 3, k8 = lane & 7;
  const u16* AUX = (SIDE == 0) ? (const u16*)(p.ws + WS_X1H) + 128 * x + 16 * k8 : (const u16*)(p.ws + WS_A) + 16 * ps;
  const int auxld = (SIDE == 0) ? D_ : 128;
  const u16* IDX = (const u16*)(p.ws + WS_IDX) + 16 * ps;
  const unsigned char* T8 = (const unsigned char*)(p.ws + (SIDE == 0 ? WS_U8 : WS_V8)) + (size_t)x * SLICE_BYTES;
  const unsigned loff = 16u * (unsigned)k8;
  u16* HP = (u16*)(p.ws + WS_HP) + (size_t)x * S_ * 128 + 2 * lane;
  float* OUT = p.out + 128 * x + 16 * k8 + 2 * ps; const u16* X1R = (const u16*)(p.ws + WS_X1H) + 128 * x + 16 * k8 + 2 * ps;
  u32x4 mi[2][2], ax[2][2], gw[2][16]; unsigned xres[2];
#define G_META(kk) do { mi[(kk) & 1][0] = *(const u32x4*)(IDX + (size_t)(tb + (kk)) * 128); mi[(kk) & 1][1] = *(const u32x4*)(IDX + (size_t)(tb + (kk)) * 128 + 8); } while (0)
#define G_ISSUE(kk) do { const int s_ = (kk) & 1; const int t_ = tb + (kk); const unsigned iw_[8] = {mi[s_][0].x, mi[s_][0].y, mi[s_][0].z, mi[s_][0].w, mi[s_][1].x, mi[s_][1].y, mi[s_][1].z, mi[s_][1].w}; \
    _Pragma("unroll") for (int i_ = 0; i_ < 16; ++i_) { const unsigned e_ = (i_ & 1) ? (iw_[i_ >> 1] >> 16) : (iw_[i_ >> 1] & 0xFFFFu); gw[s_][i_] = *(const u32x4*)(T8 + (e_ * 128u + loff)); } \
    ax[s_][0] = *(const u32x4*)(AUX + (size_t)t_ * auxld); ax[s_][1] = *(const u32x4*)(AUX + (size_t)t_ * auxld + 8); \
    if (SIDE == 1) xres[s_] = *(const unsigned*)(X1R + (size_t)t_ * D_); } while (0)
  G_META(0); G_META(1); G_ISSUE(0);
#pragma unroll
  for (int k = 0; k < NTOK; ++k) {
    const int gs = k & 1, t = tb + k;
    if (k + 1 < NTOK) G_ISSUE(k + 1);
    if (k + 2 < NTOK) G_META(k + 2);
    const unsigned xw[8] = {ax[gs][0].x, ax[gs][0].y, ax[gs][0].z, ax[gs][0].w, ax[gs][1].x, ax[gs][1].y, ax[gs][1].z, ax[gs][1].w};
    if (SIDE == 0) {
      float sv[16];
#pragma unroll
      for (int i = 0; i < 16; ++i) {
        const unsigned w4[4] = {gw[gs][i].x, gw[gs][i].y, gw[gs][i].z, gw[gs][i].w};
        float s = 0.f;
#pragma unroll
        for (int d = 0; d < 4; ++d) { const unsigned wd = w4[d], x0 = xw[2 * d], x1 = xw[2 * d + 1];
          s = __builtin_amdgcn_fdot2(__builtin_amdgcn_cvt_scalef32_pk_f16_fp8(wd, 1.0f, false), __builtin_bit_cast(h16x2, x0), s, false);
          s = __builtin_amdgcn_fdot2(__builtin_amdgcn_cvt_scalef32_pk_f16_fp8(wd, 1.0f, true), __builtin_bit_cast(h16x2, x1), s, false); }
        sv[i] = s;
      }
      const bool c2 = (lane & 4) != 0, c1 = (lane & 2) != 0, c0 = (lane & 1) != 0;
      float q8[8], q4[4], q2[2];
#define DPP_F(v, ctrl) __uint_as_float(__builtin_amdgcn_update_dpp(0, (int)__float_as_uint(v), (ctrl), 0xf, 0xf, false))
#pragma unroll
      for (int c = 0; c < 8; ++c) { const float keep = c2 ? sv[c + 8] : sv[c], send = c2 ? sv[c] : sv[c + 8]; const float m = DPP_F(send, 0x141); q8[c] = keep + DPP_F(m, 0x1B); }
#pragma unroll
      for (int c = 0; c < 4; ++c) { const float keep = c1 ? q8[c + 4] : q8[c], send = c1 ? q8[c] : q8[c + 4]; q4[c] = keep + DPP_F(send, 0x4E); }
#pragma unroll
      for (int c = 0; c < 2; ++c) { const float keep = c0 ? q4[c + 2] : q4[c], send = c0 ? q4[c] : q4[c + 2]; q2[c] = keep + DPP_F(send, 0xB1); }
      const float h0 = q2[0], h1 = q2[1];
      *(unsigned*)(HP + (size_t)t * 128) = pk_f16(h0, h1);
    } else {
      h16x2 acc2[8];
#pragma unroll
      for (int j = 0; j < 8; ++j) acc2[j] = (h16x2){(_Float16)0.f, (_Float16)0.f};
#pragma unroll
      for (int i = 0; i < 16; ++i) {
        const unsigned w4[4] = {gw[gs][i].x, gw[gs][i].y, gw[gs][i].z, gw[gs][i].w}; const unsigned aw = xw[i >> 1]; const h16x2 a2 = __builtin_bit_cast(h16x2, aw);
        const h16x2 aa = (i & 1) ? (h16x2){a2.y, a2.y} : (h16x2){a2.x, a2.x};
#pragma unroll
        for (int d = 0; d < 4; ++d) { const unsigned wd = w4[d]; const h16x2 lo = __builtin_amdgcn_cvt_scalef32_pk_f16_fp8(wd, 1.0f, false), hi = __builtin_amdgcn_cvt_scalef32_pk_f16_fp8(wd, 1.0f, true);
          acc2[2 * d] = lo * aa + acc2[2 * d]; acc2[2 * d + 1] = hi * aa + acc2[2 * d + 1]; }
      }
      float acc[16];
#pragma unroll
      for (int j = 0; j < 8; ++j) { acc[2 * j] = (float)acc2[j].x; acc[2 * j + 1] = (float)acc2[j].y; }
      const bool b3 = (lane & 8) != 0;
      float r8[8], r4[4], r2[2];
#pragma unroll
      for (int c = 0; c < 8; ++c) { const auto sw = __builtin_amdgcn_permlane32_swap(__float_as_uint(acc[c]), __float_as_uint(acc[c + 8]), false, false); r8[c] = __uint_as_float(sw[0]) + __uint_as_float(sw[1]); }
#pragma unroll
      for (int c = 0; c < 4; ++c) { const auto sw = __builtin_amdgcn_permlane16_swap(__float_as_uint(r8[c]), __float_as_uint(r8[c + 4]), false, false); r4[c] = __uint_as_float(sw[0]) + __uint_as_float(sw[1]); }
#pragma unroll
      for (int c = 0; c < 2; ++c) { const float keep = b3 ? r4[c + 2] : r4[c], send = b3 ? r4[c] : r4[c + 2];
        r2[c] = keep + __uint_as_float(__builtin_amdgcn_update_dpp(0, (int)__float_as_uint(send), 0x128, 0xf, 0xf, false)); }
      float* op = OUT + (size_t)t * D_;
      const unsigned xr = xres[gs]; const h16x2 xh = __builtin_bit_cast(h16x2, xr);
      f32x2 o; o[0] = (float)xh.x + r2[0] * (1.0f / V8_SCALE); o[1] = (float)xh.y + r2[1] * (1.0f / V8_SCALE); if (!DRY || o[0] == 123456.789f) *(f32x2*)op = o;
    }
  }
#undef G_META
#undef G_ISSUE
}
template <int SIDE, bool DRY> __device__ __forceinline__ void phase_gather_sliced(const Params& p, unsigned char* smem) {
  const int tid = ptid(), lane = tid & 63, w = __builtin_amdgcn_readfirstlane(tid >> 6);
  volatile LAS int* ql = (volatile LAS int*)((LAS unsigned char*)smem + 131072);
  unsigned* ctrl = (unsigned*)p.ws;
  const int NCH = S_ / (8 * NTOK), QB = SIDE + (DRY ? 2 : 0);
  int x = (int)(xb_xcc_id() & 7u), cur = 0;
  if (tid == 0) ql[0] = (int)__hip_atomic_fetch_add(&ctrl[GQ_WORD(QB, x)], 1u, __ATOMIC_RELAXED, __HIP_MEMORY_SCOPE_AGENT);
  __syncthreads();
  for (;;) {
    const int ch = __builtin_amdgcn_readfirstlane(ql[cur]);
    if (ch < NCH) {
      unsigned nxt = 0u;
      if (tid == 0) nxt = __hip_atomic_fetch_add(&ctrl[GQ_WORD(QB, x)], 1u, __ATOMIC_RELAXED, __HIP_MEMORY_SCOPE_AGENT);
      gather_wave_chunk<SIDE, DRY>(p, ch * 8 * NTOK + w * NTOK, x, lane);
      if (tid == 0) ql[cur ^ 1] = (int)nxt;
      __syncthreads();
      cur ^= 1;
    } else {
      if (tid < 8) ql[8 + tid] = (int)__hip_atomic_load(&ctrl[GQ_WORD(QB, tid)], __ATOMIC_RELAXED, __HIP_MEMORY_SCOPE_AGENT);
      __syncthreads();
      int nx = -1;
#pragma unroll
      for (int s = 7; s >= 1; --s) { const int y = (x + s) & 7; if (__builtin_amdgcn_readfirstlane(ql[8 + y]) < NCH) nx = y; }
      __syncthreads();
      if (nx < 0) break;
      x = nx;
      if (tid == 0) ql[cur] = (int)__hip_atomic_fetch_add(&ctrl[GQ_WORD(QB, x)], 1u, __ATOMIC_RELAXED, __HIP_MEMORY_SCOPE_AGENT);
      __syncthreads();
    }
  }
}
__device__ __forceinline__ f32x4 ld4h(const u16* p) { const uint2 w = *(const uint2*)p; const unsigned a = w.x, b = w.y; const h16x2 lo = __builtin_bit_cast(h16x2, a), hi = __builtin_bit_cast(h16x2, b); return (f32x4){(float)lo.x, (float)lo.y, (float)hi.x, (float)hi.y}; }
__device__ __forceinline__ void phase_areduce(const Params& p) {
  const u16* HP = (const u16*)(p.ws + WS_HP); const float* GW = (const float*)(p.ws + WS_G); const float* SSQ = (const float*)(p.ws + WS_SSQ); u16* A = (u16*)(p.ws + WS_A);
  const int gt = blockIdx.x * 512 + ptid(), GT = gridDim.x * 512, NQ = S_ * 128 / 4;
  for (int b0 = gt; b0 < NQ; b0 += 4 * GT) {
    f32x4 s[4], g[4]; float rq[4];
#pragma unroll
    for (int k = 0; k < 4; ++k) { const int qd = b0 + k * GT < NQ ? b0 + k * GT : b0, i = qd * 4; s[k] = ld4h(HP + i); g[k] = *(const f32x4*)(GW + i); rq[k] = SSQ[i >> 7]; }
#pragma unroll
    for (int x = 1; x < 8; ++x)
#pragma unroll
      for (int k = 0; k < 4; ++k) { const int qd = b0 + k * GT < NQ ? b0 + k * GT : b0; s[k] += ld4h(HP + (size_t)x * S_ * 128 + qd * 4); }
#pragma unroll
    for (int k = 0; k < 4; ++k) { const int qd = b0 + k * GT; if (qd < NQ) { const int i = qd * 4; const float rs = rsqrtf(rq[k] * (1.0f / D_) + 1e-6f) * (1.0f / U8_SCALE);
      uint2 o; o.x = pk_f16(gelu_tanh_f(s[k][0] * rs) * g[k][0], gelu_tanh_f(s[k][1] * rs) * g[k][1]); o.y = pk_f16(gelu_tanh_f(s[k][2] * rs) * g[k][2], gelu_tanh_f(s[k][3] * rs) * g[k][3]);
      *(uint2*)(A + i) = o; } }
  }
}

#define WS_ST16 WS_SQ
#define DO_KV (0 * MB_)
__device__ __forceinline__ s16x8 cat4(s16x4 x, s16x4 y) { return __builtin_shufflevector(x, y, 0, 1, 2, 3, 4, 5, 6, 7); }
__device__ __forceinline__ s16x4 tr32(LAS unsigned char* base, int st, int kb, int nb, int lane) {
  const int q = (lane & 15) >> 2, pp = lane & 3, blk = (lane >> 4) & 1;
  return __builtin_amdgcn_ds_read_tr16_b64_v4i16((LAS s16x4*)(base + (kb + q) * st + (nb + 16 * blk + 4 * pp) * 2));
}
__device__ __forceinline__ s16x4 tr16(LAS unsigned char* base, int st, int kb, int nb, int lane) {
  const int q = (lane & 15) >> 2, pp = lane & 3;
  return __builtin_amdgcn_ds_read_tr16_b64_v4i16((LAS s16x4*)(base + (kb + q) * st + (nb + 4 * pp) * 2));
}
__device__ __forceinline__ void norm16(u32x4 lo, u32x4 hi, int part, const float* __restrict__ gain, float (&a)[8], float (&b)[8]) {
  unpack8_bf16(lo, a); unpack8_bf16(hi, b);
  float ss = 0.f;
#pragma unroll
  for (int i = 0; i < 8; ++i) ss += a[i] * a[i] + b[i] * b[i];
  ss += __shfl_xor(ss, 1); ss += __shfl_xor(ss, 2);
  const float r = rsqrtf(ss * (1.0f / 64.0f) + 1e-6f);
  const f32x4 g0 = *(const f32x4*)(gain + 8 * part), g1 = *(const f32x4*)(gain + 8 * part + 4), g2 = *(const f32x4*)(gain + 32 + 8 * part), g3 = *(const f32x4*)(gain + 36 + 8 * part);
#pragma unroll
  for (int i = 0; i < 4; ++i) { a[i] *= r * g0[i]; a[4 + i] *= r * g1[i]; b[i] *= r * g2[i]; b[4 + i] *= r * g3[i]; }
}
__device__ __forceinline__ void rope16(float (&a)[8], float (&b)[8], const float* __restrict__ rc, const float* __restrict__ rs, int t, int part, float scale) {
  const f32x4 c0 = *(const f32x4*)(rc + t * 32 + 8 * part), c1 = *(const f32x4*)(rc + t * 32 + 8 * part + 4), s0 = *(const f32x4*)(rs + t * 32 + 8 * part), s1 = *(const f32x4*)(rs + t * 32 + 8 * part + 4);
#pragma unroll
  for (int i = 0; i < 8; ++i) { const float c = i < 4 ? c0[i & 3] : c1[i & 3], s = i < 4 ? s0[i & 3] : s1[i & 3]; const float x1 = a[i], x2 = b[i]; a[i] = (x1 * c - x2 * s) * scale; b[i] = (x1 * s + x2 * c) * scale; }
}
__device__ __forceinline__ void store_row16(LAS unsigned char* rowp, int part, const float (&a)[8], const float (&b)[8]) {
  u32x4 wa, wb; wa.x = pk_bf16(a[0], a[1]); wa.y = pk_bf16(a[2], a[3]); wa.z = pk_bf16(a[4], a[5]); wa.w = pk_bf16(a[6], a[7]);
  wb.x = pk_bf16(b[0], b[1]); wb.y = pk_bf16(b[2], b[3]); wb.z = pk_bf16(b[4], b[5]); wb.w = pk_bf16(b[6], b[7]);
  *(LAS u32x4*)(rowp + 16 * part) = wa; *(LAS u32x4*)(rowp + 64 + 16 * part) = wb;
}

struct KvRegs { u32x4 k0, k1, v[4]; };
__device__ __forceinline__ void kv_load(const Params& p, int item, KvRegs& R) {
  const int tid = ptid(), c = item >> 3, h = item & 7, t0 = c * 128;
  const u16* RK = (const u16*)(p.ws + WS_RK); const u16* RV = (const u16*)(p.ws + WS_RV);
  { const int j = tid >> 2, part = tid & 3; const u16* pp = RK + (size_t)(t0 + j) * 512 + h * 64 + part * 8; R.k0 = *(const u32x4*)pp; R.k1 = *(const u32x4*)(pp + 32); }
#pragma unroll
  for (int it = 0; it < 4; ++it) { const int q = tid + 512 * it, row = q >> 4, ch = q & 15; R.v[it] = *(const u32x4*)(RV + (size_t)(t0 + row) * 1024 + h * 128 + ch * 8); }
}
__device__ __forceinline__ void kv_item(const Params& p, LAS unsigned char* lds, int item, u16* __restrict__ KV, const KvRegs& R) {
  const int tid = ptid(), lane = tid & 63, w = __builtin_amdgcn_readfirstlane(tid >> 6), hh = lane >> 5, r = lane & 31;
  const int c = item >> 3, h = item & 7, t0 = c * 128;
  LAS unsigned char* Ks = lds; LAS unsigned char* Vs = lds + 128 * 192;
  const float* RC = (const float*)(p.ws + WS_ROPE_C); const float* RS = (const float*)(p.ws + WS_ROPE_S);
  { const int j = tid >> 2, part = tid & 3, t = t0 + j;
    float a[8], b[8]; norm16(R.k0, R.k1, part, p.ret_k_norm, a, b);
    rope16(a, b, RC, RS, t, part, 0.125f * exp2f((float)(127 - j) * p.l2g[h])); store_row16(Ks + j * 192, part, a, b); }
#pragma unroll
  for (int it = 0; it < 4; ++it) { const int q = tid + 512 * it, row = q >> 4, ch = q & 15; *(LAS u32x4*)(Vs + row * 320 + ch * 16) = R.v[it]; }
  __syncthreads();
  const int mb = w & 1, nb = w >> 1;
  f32x16 acc;
#pragma unroll
  for (int i = 0; i < 16; ++i) acc[i] = 0.f;
#pragma unroll
  for (int ks = 0; ks < 8; ++ks) { const int kb = 16 * ks + 8 * hh;
    const s16x8 af = cat4(tr32(Ks, 192, kb, 32 * mb, lane), tr32(Ks, 192, kb + 4, 32 * mb, lane));
    const s16x8 bf = cat4(tr32(Vs, 320, kb, 32 * nb, lane), tr32(Vs, 320, kb + 4, 32 * nb, lane));
    acc = MFMA32(af, bf, acc); }
  u16* op = KV + ((size_t)(c * 8 + h) * 128 + 32 * nb + r) * 64 + 32 * mb + 4 * hh;
#pragma unroll
  for (int g4 = 0; g4 < 4; ++g4) { uint2 o; o.x = pk_bf16(acc[4 * g4], acc[4 * g4 + 1]); o.y = pk_bf16(acc[4 * g4 + 2], acc[4 * g4 + 3]); *(uint2*)(op + 8 * g4) = o; }
  __syncthreads();
}

__device__ __forceinline__ void phase_scan(const Params& p, unsigned char* smem, const u16* __restrict__ KV) {
  const int tid = ptid(), q = tid & 63, g = tid >> 6;
  f32x4* tot = (f32x4*)smem;
  u16* ST = (u16*)(p.ws + WS_ST16);
  for (int batch = blockIdx.x; batch < 256; batch += gridDim.x) {
    const int q4 = batch * 64 + q, h = q4 >> 11;
    const float cd = exp2f(128.0f * p.l2g[h]);
    f32x4 v[16];
#pragma unroll
    for (int i = 0; i < 16; ++i) { const uint2 w = *(const uint2*)(KV + ((size_t)(16 * g + i) * 16384 + q4) * 4);
      v[i] = (f32x4){__uint_as_float(w.x << 16), __uint_as_float(w.x & 0xffff0000u), __uint_as_float(w.y << 16), __uint_as_float(w.y & 0xffff0000u)}; }
    f32x4 run = (f32x4){0.f, 0.f, 0.f, 0.f};
#pragma unroll
    for (int i = 0; i < 16; ++i) { const f32x4 tmp = v[i]; v[i] = run; run = run * cd + tmp; }
    tot[g * 64 + q] = run;
    __syncthreads();
    float cd16 = cd; cd16 *= cd16; cd16 *= cd16; cd16 *= cd16; cd16 *= cd16;
    f32x4 C = (f32x4){0.f, 0.f, 0.f, 0.f};
    for (int gg = 0; gg < g; ++gg) C = C * cd16 + tot[gg * 64 + q];
    float pw = 1.0f;
#pragma unroll
    for (int i = 0; i < 16; ++i) { const f32x4 s = v[i] + C * pw; pw *= cd;
      uint2 o; o.x = pk_bf16(s[0], s[1]); o.y = pk_bf16(s[2], s[3]); *(uint2*)(ST + ((size_t)(16 * g + i) * 16384 + q4) * 4) = o; }
    __syncthreads();
  }
}

struct RetRegs { u32x4 q0, q1, k0, k1, st[2], v[4], gate[4]; };
__device__ __forceinline__ void retout_load(const Params& p, int item, RetRegs& R) {
  const int tid = ptid(), c = item >> 3, h = item & 7, t0 = c * 128;
  const u16* RQ = (const u16*)(p.ws + WS_RQ); const u16* RK = (const u16*)(p.ws + WS_RK); const u16* RV = (const u16*)(p.ws + WS_RV); const u16* ST = (const u16*)(p.ws + WS_ST16);
  { const int j = tid >> 2, part = tid & 3; const u16* pq = RQ + (size_t)(t0 + j) * 512 + h * 64 + part * 8; R.q0 = *(const u32x4*)pq; R.q1 = *(const u32x4*)(pq + 32);
    const u16* pk = RK + (size_t)(t0 + j) * 512 + h * 64 + part * 8; R.k0 = *(const u32x4*)pk; R.k1 = *(const u32x4*)(pk + 32); }
#pragma unroll
  for (int it = 0; it < 2; ++it) { const int q = tid + 512 * it, row = q >> 3, ch = q & 7; R.st[it] = *(const u32x4*)(ST + ((size_t)(c * 8 + h) * 128 + row) * 64 + ch * 8); }
  { const int lane = tid & 63, w = tid >> 6, ib = w >> 1, eh = w & 1; const u16* RG = (const u16*)(p.ws + WS_RG);
#pragma unroll
    for (int k = 0; k < 4; ++k) R.gate[k] = *(const u32x4*)(RG + (size_t)(t0 + 32 * ib + (lane >> 3) + 8 * k) * 1024 + h * 128 + 64 * eh + 8 * (lane & 7)); }
#pragma unroll
  for (int it = 0; it < 4; ++it) { const int q = tid + 512 * it, row = q >> 4, ch = q & 15; R.v[it] = *(const u32x4*)(RV + (size_t)(t0 + row) * 1024 + h * 128 + ch * 8); }
}
template <bool DRY> __device__ __forceinline__ void retout_item(const Params& p, LAS unsigned char* lds, int item, const RetRegs& R) {
  const int tid = ptid(), lane = tid & 63, w = __builtin_amdgcn_readfirstlane(tid >> 6), hh = lane >> 5, r = lane & 31;
  const int c = item >> 3, h = item & 7, t0 = c * 128;
  LAS unsigned char* Qs = lds; LAS unsigned char* Ks = lds + 18432; LAS unsigned char* STs = lds + 36864; LAS unsigned char* Vs = lds + 55296; LAS f32x2* red = (LAS f32x2*)(lds + 96256);
  u16* RG = (u16*)(p.ws + WS_RG);
  const float* RC = (const float*)(p.ws + WS_ROPE_C); const float* RS = (const float*)(p.ws + WS_ROPE_S);
  const float l2g = p.l2g[h];
  { const int j = tid >> 2, part = tid & 3, t = t0 + j; float a[8], b[8];
    norm16(R.q0, R.q1, part, p.ret_q_norm, a, b); rope16(a, b, RC, RS, t, part, 1.0f); store_row16(Qs + j * 144, part, a, b);
    norm16(R.k0, R.k1, part, p.ret_k_norm, a, b); rope16(a, b, RC, RS, t, part, 0.125f); store_row16(Ks + j * 144, part, a, b); }
#pragma unroll
  for (int it = 0; it < 2; ++it) { const int q = tid + 512 * it, row = q >> 3, ch = q & 7; *(LAS u32x4*)(STs + row * 144 + ch * 16) = R.st[it]; }
#pragma unroll
  for (int it = 0; it < 4; ++it) { const int q = tid + 512 * it, row = q >> 4, ch = q & 15; *(LAS u32x4*)(Vs + row * 320 + ch * 16) = R.v[it]; }
  __syncthreads();
  const int ib = w >> 1, eh = w & 1;
  f32x16 acc[2];
#pragma unroll
  for (int et = 0; et < 2; ++et)
#pragma unroll
    for (int i = 0; i < 16; ++i) acc[et][i] = 0.f;
  s16x8 bq[4];
#pragma unroll
  for (int ks = 0; ks < 4; ++ks) bq[ks] = *(const LAS s16x8*)(Qs + (32 * ib + r) * 144 + (16 * ks + 8 * hh) * 2);
#pragma unroll
  for (int et = 0; et < 2; ++et)
#pragma unroll
    for (int ks = 0; ks < 4; ++ks) { const s16x8 af = *(const LAS s16x8*)(STs + (32 * (2 * eh + et) + r) * 144 + (16 * ks + 8 * hh) * 2); acc[et] = MFMA32(af, bq[ks], acc[et]); }
  { const float qd = exp2f((float)(32 * ib + r + 1) * l2g);
#pragma unroll
    for (int et = 0; et < 2; ++et)
#pragma unroll
      for (int i = 0; i < 16; ++i) acc[et][i] *= qd; }
  float rowdec[16];
#pragma unroll
  for (int i = 0; i < 16; ++i) rowdec[i] = __builtin_amdgcn_exp2f(-(float)((i & 3) + 8 * (i >> 2) + 4 * hh) * l2g);
  for (int jb = 0; jb <= ib; ++jb) {
    f32x16 sc;
#pragma unroll
    for (int i = 0; i < 16; ++i) sc[i] = 0.f;
#pragma unroll
    for (int ks = 0; ks < 4; ++ks) { const s16x8 af = *(const LAS s16x8*)(Ks + (32 * jb + r) * 144 + (16 * ks + 8 * hh) * 2); sc = MFMA32(af, bq[ks], sc); }
    float pv[16];
    const float fcol = __builtin_amdgcn_exp2f((float)(32 * (ib - jb) + r) * l2g);
#pragma unroll
    for (int i = 0; i < 16; ++i) { const int jl = 32 * jb + (i & 3) + 8 * (i >> 2) + 4 * hh, diff = 32 * ib + r - jl; pv[i] = diff >= 0 ? sc[i] * (fcol * rowdec[i]) : 0.f; }
#pragma unroll
    for (int s = 0; s < 2; ++s) {
      u32x4 bw; bw.x = pk_bf16(pv[8 * s], pv[8 * s + 1]); bw.y = pk_bf16(pv[8 * s + 2], pv[8 * s + 3]); bw.z = pk_bf16(pv[8 * s + 4], pv[8 * s + 5]); bw.w = pk_bf16(pv[8 * s + 6], pv[8 * s + 7]);
      const s16x8 bf = __builtin_bit_cast(s16x8, bw);
#pragma unroll
      for (int et = 0; et < 2; ++et) { const int kb = 32 * jb + 16 * s + 4 * hh, nb = 32 * (2 * eh + et);
        const s16x8 af = cat4(tr32(Vs, 320, kb, nb, lane), tr32(Vs, 320, kb + 8, nb, lane)); acc[et] = MFMA32(af, bf, acc[et]); }
    }
  }
  float s1 = 0.f, s2 = 0.f;
#pragma unroll
  for (int et = 0; et < 2; ++et)
#pragma unroll
    for (int i = 0; i < 16; ++i) { const float v = acc[et][i]; s1 += v; s2 += v * v; }
  s1 += __shfl_xor(s1, 32); s2 += __shfl_xor(s2, 32);
  if (hh == 0) red[(32 * ib + r) * 2 + eh] = (f32x2){s1, s2};
  __syncthreads();
  const f32x2 ra = red[(32 * ib + r) * 2], rb = red[(32 * ib + r) * 2 + 1];
  const float mu = (ra.x + rb.x) * (1.0f / 128.0f), var = fmaxf((ra.y + rb.y) * (1.0f / 128.0f) - mu * mu, 0.f), rstd = rsqrtf(var + 1e-6f);
  LAS unsigned char* wt = lds + 98304 + w * 4608;
#pragma unroll
  for (int et = 0; et < 2; ++et)
#pragma unroll
    for (int g4 = 0; g4 < 4; ++g4) { typedef unsigned u32x2_t __attribute__((ext_vector_type(2))); u32x2_t o;
      o.x = pk_bf16((acc[et][4 * g4] - mu) * rstd, (acc[et][4 * g4 + 1] - mu) * rstd); o.y = pk_bf16((acc[et][4 * g4 + 2] - mu) * rstd, (acc[et][4 * g4 + 3] - mu) * rstd);
      *(LAS u32x2_t*)(wt + r * 144 + (32 * et + 8 * g4 + 4 * hh) * 2) = o; }
  { u32x4 yv[4]; f32x4 ga[4], gb[4];
#pragma unroll
    for (int k = 0; k < 4; ++k) { const int row = (lane >> 3) + 8 * k, ch = lane & 7, col = h * 128 + 64 * eh + 8 * ch;
      yv[k] = *(const LAS u32x4*)(wt + row * 144 + ch * 16); ga[k] = *(const f32x4*)(p.ret_gn + col); gb[k] = *(const f32x4*)(p.ret_gn + col + 4); }
#pragma unroll
    for (int k = 0; k < 4; ++k) { const int row = (lane >> 3) + 8 * k, ch = lane & 7, col = h * 128 + 64 * eh + 8 * ch;
      float y[8], g[8]; unpack8_bf16(yv[k], y); unpack8_bf16(R.gate[k], g); f32x4 o0, o1;
#pragma unroll
      for (int i = 0; i < 4; ++i) { o0[i] = y[i] * ga[k][i] * g[i] * sigmoidf_(g[i]); o1[i] = y[4 + i] * gb[k][i] * g[4 + i] * sigmoidf_(g[4 + i]); }
      const u32x4 ov = pack8_bf16(o0, o1); if (!DRY || ov.x == 0x12345678u) *(u32x4*)(RG + (size_t)(t0 + 32 * ib + row) * 1024 + col) = ov; } }
  __syncthreads();
}

__device__ __forceinline__ void sb_item(const Params& p, LAS unsigned char* lds, int item, u16* __restrict__ SB) {
  const int tid = ptid(), lane = tid & 63, w = __builtin_amdgcn_readfirstlane(tid >> 6), g = lane >> 4, lt = lane & 15;
  const int qb = item >> 3, h = item & 7, t0 = qb * 128;
  LAS unsigned char* Qs = lds; LAS unsigned* flags = (LAS unsigned*)(lds + 61440);
  const u16* SQ = (const u16*)(p.ws + WS_SQ); const u16* SK = (const u16*)(p.ws + WS_SK); const u16* SV = (const u16*)(p.ws + WS_SV);
  { const int j = tid >> 2, part = tid & 3, t = t0 + j; float a[8], b[8];
    const u16* pq = SQ + (size_t)t * 512 + h * 64 + part * 8; norm16(*(const u32x4*)pq, *(const u32x4*)(pq + 32), part, p.sb_q_norm, a, b);
#pragma unroll
    for (int i = 0; i < 8; ++i) { a[i] *= 0.18033688011112042f; b[i] *= 0.18033688011112042f; }
    store_row16(Qs + j * 144, part, a, b); }
  u32x4 r0, r1;
  const bool kthr = tid < 256; const int krow = tid >> 2, kpart = tid & 3, vq = tid - 256;
#define SB_LOAD(kt) do { if (kthr) { const u16* pk = SK + (size_t)((kt) * 64 + krow) * 512 + h * 64 + kpart * 8; r0 = *(const u32x4*)pk; r1 = *(const u32x4*)(pk + 32); } \
    else { r0 = *(const u32x4*)(SV + (size_t)((kt) * 64 + (vq >> 3)) * 512 + h * 64 + (vq & 7) * 8); r1 = *(const u32x4*)(SV + (size_t)((kt) * 64 + 32 + (vq >> 3)) * 512 + h * 64 + (vq & 7) * 8); } } while (0)
#define SB_WRITE(buf) do { LAS unsigned char* kb_ = lds + 18432 + (buf) * 21504; if (kthr) { float a[8], b[8]; norm16(r0, r1, kpart, p.sb_k_norm, a, b); store_row16(kb_ + krow * 144, kpart, a, b); } \
    else { *(LAS u32x4*)(kb_ + 9216 + (vq >> 3) * 192 + (vq & 7) * 16) = r0; *(LAS u32x4*)(kb_ + 9216 + (32 + (vq >> 3)) * 192 + (vq & 7) * 16) = r1; } } while (0)
  const int ktmax = 2 * qb + 1;
  SB_LOAD(ktmax); SB_WRITE(0);
  __syncthreads();
  s16x8 qf[2];
#pragma unroll
  for (int ks = 0; ks < 2; ++ks) qf[ks] = *(const LAS s16x8*)(Qs + (16 * w + lt) * 144 + (32 * ks + 8 * g) * 2);
  float carry = 0.f; f32x4 o[4];
#pragma unroll
  for (int et = 0; et < 4; ++et) o[et] = (f32x4){0.f, 0.f, 0.f, 0.f};
  const int tq = t0 + 16 * w + lt;
  for (int kt = ktmax, it = 0; kt >= 0; --kt, ++it) {
    const int buf = it & 1; LAS unsigned char* Ks = lds + 18432 + buf * 21504; LAS unsigned char* Vs = Ks + 9216;
    if (kt > 0) SB_LOAD(kt - 1);
    const bool wskip = (kt * 64 >= t0 + 16 * w + 16) || __all(carry < -150.1f);
    if (!wskip) {
    f32x4 z[4];
#pragma unroll
    for (int a = 0; a < 4; ++a) { z[a] = (f32x4){0.f, 0.f, 0.f, 0.f};
#pragma unroll
      for (int ks = 0; ks < 2; ++ks) { const s16x8 af = *(const LAS s16x8*)(Ks + (16 * a + lt) * 144 + (32 * ks + 8 * g) * 2); z[a] = MFMA16(af, qf[ks], z[a]); } }
    float ls[4][4], zl[4][4], G[4], T[4], suf[4];
    const bool masked = kt * 64 + 64 > t0 + 16 * w;
#pragma unroll
    for (int a = 0; a < 4; ++a) { G[a] = 0.f;
#pragma unroll
      for (int rr = 0; rr < 4; ++rr) { const float zv = z[a][rr];
        const float sp = fmaxf(zv, 0.f) + __builtin_amdgcn_logf(1.0f + __builtin_amdgcn_exp2f(-fabsf(zv)));
        ls[a][rr] = -sp; zl[a][rr] = zv - sp; } }
    if (masked) {
#pragma unroll
      for (int a = 0; a < 4; ++a)
#pragma unroll
        for (int rr = 0; rr < 4; ++rr) { const bool valid = (kt * 64 + 16 * a + 4 * g + rr) < tq; ls[a][rr] = valid ? ls[a][rr] : 0.f; zl[a][rr] = valid ? zl[a][rr] : -1.0e30f; }
    }
#pragma unroll
    for (int a = 0; a < 4; ++a) G[a] = (ls[a][0] + ls[a][1]) + (ls[a][2] + ls[a][3]);
#pragma unroll
    for (int a = 0; a < 4; ++a) { const float x1 = __shfl_xor(G[a], 16), x2 = __shfl_xor(G[a], 32), x3 = __shfl_xor(G[a], 48);
      T[a] = G[a] + x1 + x2 + x3; suf[a] = g == 0 ? (x1 + x2 + x3) : (g == 1 ? (x2 + x3) : (g == 2 ? x1 : 0.f)); }
    float wv[4][4];
    { float after = 0.f;
#pragma unroll
      for (int a = 3; a >= 0; --a) { float base = carry + after + suf[a];
#pragma unroll
        for (int rr = 3; rr >= 0; --rr) { wv[a][rr] = __builtin_amdgcn_exp2f(zl[a][rr] + base); base += ls[a][rr]; }
        after += T[a]; }
      carry += after; }
#pragma unroll
    for (int ap = 0; ap < 2; ++ap) {
      u32x4 bw; bw.x = pk_bf16(wv[2 * ap][0], wv[2 * ap][1]); bw.y = pk_bf16(wv[2 * ap][2], wv[2 * ap][3]); bw.z = pk_bf16(wv[2 * ap + 1][0], wv[2 * ap + 1][1]); bw.w = pk_bf16(wv[2 * ap + 1][2], wv[2 * ap + 1][3]);
      const s16x8 bf = __builtin_bit_cast(s16x8, bw);
#pragma unroll
      for (int et = 0; et < 4; ++et) { const s16x8 af = cat4(tr16(Vs, 192, 32 * ap + 4 * g, 16 * et, lane), tr16(Vs, 192, 32 * ap + 16 + 4 * g, 16 * et, lane)); o[et] = MFMA16(af, bf, o[et]); }
    }
    }
    const bool done = __all(carry < -150.1f);
    if (lane == 0) flags[buf * 8 + w] = done ? 1u : 0u;
    if (kt > 0) SB_WRITE(buf ^ 1);
    __syncthreads();
    if (kt > 0) { unsigned all = 1u;
#pragma unroll
      for (int i = 0; i < 8; ++i) all &= flags[buf * 8 + i];
      if (all) break; }
  }
  { u16* op = SB + (size_t)tq * 512 + h * 64 + 4 * g;
#pragma unroll
    for (int et = 0; et < 4; ++et) { uint2 ov; ov.x = pk_bf16(o[et][0], o[et][1]); ov.y = pk_bf16(o[et][2], o[et][3]); *(uint2*)(op + 16 * et) = ov; } }
  __syncthreads();
#undef SB_LOAD
#undef SB_WRITE
}
__device__ __forceinline__ void phase_mixA(const Params& p, unsigned char* smem, char* dob) {
  LAS unsigned char* lds = (LAS unsigned char*)smem;
  { KvRegs cur, nxt; int item = blockIdx.x; if (item < 1024) kv_load(p, item, cur);
    for (; item < 1024; item += gridDim.x) { const int ni = item + gridDim.x; if (ni < 1024) kv_load(p, ni, nxt); kv_item(p, lds, item, (u16*)(dob + DO_KV), cur); cur = nxt; }
    for (; item < 2048; item += gridDim.x) sb_item(p, lds, item - 1024, (u16*)(dob + DO_SB)); }
}
template <bool DRY> __device__ __forceinline__ void phase_retout(const Params& p, unsigned char* smem) {
  LAS unsigned char* lds = (LAS unsigned char*)smem;
  RetRegs cur, nxt; int item = blockIdx.x; if (item < 1024) retout_load(p, item, cur);
  for (; item < 1024; item += gridDim.x) { const int ni = item + gridDim.x; if (ni < 1024) retout_load(p, ni, nxt); retout_item<DRY>(p, lds, item, cur); cur = nxt; }
}


#define XB_TMO      128
#define XB_XCNT(j)  (256  + 64 * (j))
#define XB_XSUB(j)  (1280 + 64 * (j))
#define XB_XGEN(j)  (2304 + 64 * (j))
#define XB_TOP      3328
#define XB_TOPGEN   3392
#define XCD_BAR_WORDS 3456
#define XB_SPIN_CAP (1u << 22)
__device__ __forceinline__ unsigned xb_ld(unsigned* p)              { return __hip_atomic_load(p, __ATOMIC_RELAXED, __HIP_MEMORY_SCOPE_AGENT); }
__device__ __forceinline__ unsigned xb_add(unsigned* p, unsigned v) { return __hip_atomic_fetch_add(p, v, __ATOMIC_RELAXED, __HIP_MEMORY_SCOPE_AGENT); }
__device__ __forceinline__ unsigned xb_xcc_id() { return (unsigned)__builtin_amdgcn_s_getreg((3 << 11) | 20) & 0xFu; }
#define XB_SPIN(cond, bar) do { unsigned _sp = 0; while (cond) { __builtin_amdgcn_s_sleep(1); \
    if ((++_sp & 255u) == 0u) { if (xb_ld(&(bar)[XB_TMO])) break; if (_sp > XB_SPIN_CAP) { atomicAdd(&(bar)[XB_TMO], 1u); break; } } } } while (0)
struct XcdBarrier { unsigned* bar; unsigned x; volatile LAS unsigned* st; };
__device__ __forceinline__ XcdBarrier xcd_barrier_post(unsigned* bar, volatile LAS unsigned* st) {
  XcdBarrier b; b.bar = bar; b.x = xb_xcc_id(); b.st = st;
  if (ptid() == 0) (void)xb_add(&bar[XB_XCNT(b.x)], 1u);
  return b;
}
__device__ __forceinline__ void xcd_barrier_complete(unsigned* bar, unsigned x, unsigned& nloc, unsigned& nx) {
  const unsigned G = gridDim.x * gridDim.y * gridDim.z;
  unsigned sum, cnt, mine, sp = 0u;
  for (;;) {
    sum = 0u; cnt = 0u; mine = 0u;
#pragma unroll
    for (unsigned j = 0; j < 16; ++j) { const unsigned c = xb_ld(&bar[XB_XCNT(j)]); sum += c; cnt += (c > 0u) ? 1u : 0u; mine = (j == x) ? c : mine; }
    if (sum == G) break;
    __builtin_amdgcn_s_sleep(1);
    if ((++sp & 255u) == 0u) { if (xb_ld(&bar[XB_TMO])) break; if (sp > XB_SPIN_CAP) { atomicAdd(&bar[XB_TMO], 1u); break; } }
  }
  nloc = mine > 0u ? mine : 1u; nx = cnt > 0u ? cnt : 1u;
}
__device__ __forceinline__ void xcd_barrier(const XcdBarrier& b) {
  asm volatile("s_waitcnt vmcnt(0)" ::: "memory");
  __syncthreads();
  if (ptid() == 0) {
    unsigned* bar = b.bar;
    __builtin_amdgcn_s_waitcnt(0);
    unsigned nloc = b.st[0], nx = b.st[1];
    if (nloc == 0u) { xcd_barrier_complete(bar, b.x, nloc, nx); b.st[0] = nloc; b.st[1] = nx; }
    const unsigned old = xb_add(&bar[XB_XSUB(b.x)], 1u);
    const unsigned gen = old / nloc;
    if (old + 1u == (gen + 1u) * nloc) {
      __builtin_amdgcn_fence(__ATOMIC_RELEASE, "agent");
      asm volatile("s_waitcnt vmcnt(0)" ::: "memory");
      const unsigned og = xb_add(&bar[XB_TOP], 1u);
      const unsigned tg = og / nx;
      if (og + 1u == (tg + 1u) * nx) xb_add(&bar[XB_TOPGEN], 1u);
      else XB_SPIN(xb_ld(&bar[XB_TOPGEN]) == tg, bar);
      __builtin_amdgcn_fence(__ATOMIC_ACQUIRE, "agent");
      xb_add(&bar[XB_XGEN(b.x)], 1u);
      asm volatile("s_waitcnt vmcnt(0)" ::: "memory");
    } else {
      XB_SPIN(xb_ld(&bar[XB_XGEN(b.x)]) == gen, bar);
      __builtin_amdgcn_fence(__ATOMIC_ACQUIRE, "agent");
      asm volatile("s_waitcnt vmcnt(0)" ::: "memory");
    }
  }
  __syncthreads();
}

#define LDS_BYTES 147456
#ifndef PROBE_DUP
#define PROBE_DUP -1
#endif
#define LDS_BAR_OFF 147440
__global__ __launch_bounds__(512, 2) void k_mega(Params p) {
  extern __shared__ __attribute__((aligned(16))) unsigned char smem[];
  cg::grid_group grid = cg::this_grid();
  char* dob = (char*)p.out; char* ws = p.ws;
  PG8_LAS unsigned char* lds = (PG8_LAS unsigned char*)smem;
  u16* XN = (u16*)(dob + DO_XN); u16* WINT = (u16*)(dob + DO_WINT); u16* SB = (u16*)(dob + DO_SB); u16* WBRAT = (u16*)(dob + DO_WBRAT); u16* WBRBT = (u16*)(dob + DO_WBRBT);
  u16* WOUTT = (u16*)(ws + WS_WOUTT); u16* WQT = (u16*)(ws + WS_WQT); float* SSQ = (float*)(ws + WS_SSQ);
  u16* RQ = (u16*)(ws + WS_RQ); u16* RK = (u16*)(ws + WS_RK); u16* RV = (u16*)(ws + WS_RV); u16* SQ = (u16*)(ws + WS_SQ); u16* SK = (u16*)(ws + WS_SK);
  u16* SV = (u16*)(ws + WS_SV); u16* RG = (u16*)(ws + WS_RG); u16* GA = (u16*)(ws + WS_GA); u16* GB = (u16*)(ws + WS_GB);
  u16* MIXED = (u16*)(ws + WS_MIXED); u16* X1H = (u16*)(ws + WS_X1H); u16* Q = (u16*)(ws + WS_Q);
  const int G = (int)gridDim.x, c = (int)blockIdx.x;
  volatile LAS unsigned* xst = (volatile LAS unsigned*)((LAS unsigned char*)smem + LDS_BAR_OFF);
  if (ptid() < 4) xst[ptid()] = 0u;
  __syncthreads();
  const XcdBarrier xb = xcd_barrier_post((unsigned*)ws, xst);
  if (p.use_cg) grid.sync();
#define GRID_SYNC() xcd_barrier(xb)
#if PROBE_DUP == 100
  for (int i = 0; i < 10; ++i) GRID_SYNC();
#endif
#if PROBE_DUP == 0
  phase_prologue(p, smem, dob); __syncthreads();
#endif
  phase_prologue(p, smem, dob);
  GRID_SYNC();
#if PROBE_DUP == 1
  { FEpiInProj e{RQ, RK, RV, RG, SQ, SK, SV, GA, GB}; pg8::StaticOrder S; S.init(S_, 6656, G, c); pg8::gemm_phase<false>(lds, pg8::Gemm{XN, WINT, S_, 6656, 1024, 0}, S, e); }
#endif
  { FEpiInProj e{RQ, RK, RV, RG, SQ, SK, SV, GA, GB}; pg8::StaticOrder S; S.init(S_, 6656, G, c); pg8::gemm_phase<false>(lds, pg8::Gemm{XN, WINT, S_, 6656, 1024, 0}, S, e);
    const int rem = S.nwg % G;
    if (rem && c >= rem) conv_table(p, 0, c - rem, G - rem); }
  GRID_SYNC();
#if PROBE_DUP == 2
  phase_mixA(p, smem, dob);
#endif
  phase_mixA(p, smem, dob);
  GRID_SYNC();
#if PROBE_DUP == 3
  phase_scan(p, smem, (const u16*)(dob + DO_KV));
#endif
  phase_scan(p, smem, (const u16*)(dob + DO_KV));
  GRID_SYNC();
#if PROBE_DUP == 4
  phase_retout<true>(p, smem);
#endif
  phase_retout<false>(p, smem);
  GRID_SYNC();
  { const int rem = ((S_ / 256) * (6656 / 256)) % G; if (!rem) conv_table(p, 0, c, G); }
  conv_table(p, 1, c, G);
  __syncthreads();
#if PROBE_DUP == 51
  { FEpiMixB e{MIXED, GB}; pg8::StaticOrder S; S.init(S_, 1024, G, c); pg8::gemm_phase<false>(lds, pg8::Gemm{SB, WBRBT, S_, 1024, 512, 0}, S, e); }
  { FEpiMixA e{MIXED, GA}; pg8::StaticOrder S; S.init(S_, 1024, G, c); pg8::gemm_phase<false>(lds, pg8::Gemm{RG, WBRAT, S_, 1024, 1024, 0}, S, e); }
#endif
  { FEpiMixB e0{MIXED, GB}; FEpiMixA e1{MIXED, GA}; pg8::StaticOrder S; S.init(S_, 1024, G, c);
    pg8::gemm_phase2(lds, pg8::Gemm{SB, WBRBT, S_, 1024, 512, 0}, pg8::Gemm{RG, WBRAT, S_, 1024, 1024, 0}, S, e0, e1); }
  GRID_SYNC();
#if PROBE_DUP == 6
  { FEpiOut e{p.x, p.out, X1H, nullptr}; pg8::StaticOrder S; S.init(S_, 1024, G, c); pg8::gemm_phase<false>(lds, pg8::Gemm{MIXED, WOUTT, S_, 1024, 1024, 0}, S, e); }
#endif
  { FEpiOut e{p.x, p.out, X1H, SSQ}; pg8::StaticOrder S; S.init(S_, 1024, G, c); pg8::gemm_phase<false>(lds, pg8::Gemm{MIXED, WOUTT, S_, 1024, 1024, 0}, S, e); }
  GRID_SYNC();
  { FEpiQ e{SSQ, Q}; pg8::StaticOrder S; S.init(S_, 2048, G, c); pg8::gemm_phase<true>(lds, pg8::Gemm{X1H, WQT, S_, 2048, 1024, 0}, S, e);
    __syncthreads();
#if PROBE_DUP == 8
    phase_select(p, smem, S); __syncthreads();
#endif
    phase_select(p, smem, S); }
  GRID_SYNC();
#if PROBE_DUP == 9
  phase_gather_sliced<0, true>(p, smem);
#endif
  phase_gather_sliced<0, false>(p, smem);
  GRID_SYNC();
#if PROBE_DUP == 10
  phase_areduce(p);
#endif
  phase_areduce(p);
  GRID_SYNC();
#if PROBE_DUP == 11
  phase_gather_sliced<1, true>(p, smem);
#endif
  phase_gather_sliced<1, false>(p, smem);
}

extern "C" void kernel_launch(void* const* d_in, const int* in_sizes, int n_in, void* d_out, int out_size, void* d_ws, size_t ws_size, hipStream_t stream) {
  if (ws_size < WS_NEED || n_in != 17) return;
  static int grid_blocks = 0;
  if (!grid_blocks) {
    int dev = 0, cus = 0, per_cu = 0;
    (void)hipGetDevice(&dev);
    (void)hipDeviceGetAttribute(&cus, hipDeviceAttributeMultiprocessorCount, dev);
    (void)hipFuncSetAttribute((const void*)k_mega, hipFuncAttributeMaxDynamicSharedMemorySize, LDS_BYTES);
    (void)hipOccupancyMaxActiveBlocksPerMultiprocessor(&per_cu, (const void*)k_mega, 512, LDS_BYTES);
    if (per_cu < 1) { fprintf(stderr, "k_mega: occupancy query says %d blocks per CU\n", per_cu); grid_blocks = -1; }
    else grid_blocks = cus * per_cu;
  }
  if (grid_blocks < 0) return;
  Params P{};
  P.x = (const float*)d_in[0]; P.norm_attn = (const float*)d_in[1]; P.w_in = (const float*)d_in[2]; P.ret_q_norm = (const float*)d_in[3]; P.ret_k_norm = (const float*)d_in[4];
  P.ret_gn = (const float*)d_in[5]; P.sb_q_norm = (const float*)d_in[6]; P.sb_k_norm = (const float*)d_in[7]; P.w_bra = (const float*)d_in[8]; P.w_brb = (const float*)d_in[9];
  P.w_out = (const float*)d_in[10]; P.norm_ffn = (const float*)d_in[11]; P.w_q = (const float*)d_in[12]; P.sk1 = (const float*)d_in[13]; P.sk2 = (const float*)d_in[14];
  P.peer_u = (const float*)d_in[15]; P.peer_v = (const float*)d_in[16]; P.out = (float*)d_out; P.ws = (char*)d_ws;
  for (int h = 0; h < 8; ++h) P.l2g[h] = (float)log2(1.0 - exp2(-5.0 - (double)h));
  P.use_cg = 0; P.pad = 0;
  (void)hipMemsetAsync(d_ws, 0, 32768, stream);
  void* args[] = {&P};
  hipError_t e = hipLaunchCooperativeKernel((const void*)k_mega, dim3(grid_blocks), dim3(512), args, LDS_BYTES, stream);
  if (e != hipSuccess) fprintf(stderr, "cooperative launch failed: %s (grid %d)\n", hipGetErrorString(e), grid_blocks);
}
```

```cpp
#include <hip/hip_runtime.h>
#include <hip/hip_cooperative_groups.h>
#include <stdint.h>
#include <cstdio>
#include <cmath>
namespace cg = cooperative_groups;

typedef unsigned short u16;
#define S_ 16384
#define D_ 1024
#define MB_ ((size_t)1 << 20)

#define WS_WOUTT (1 * MB_)
#define WS_WQT (3 * MB_)
#define WS_K1 (7 * MB_)
#define WS_K2 (7 * MB_ + 65536)
#define WS_ROPE_C (8 * MB_)
#define WS_ROPE_S (10 * MB_)
#define WS_SSQ (12 * MB_)
#define WS_RQ (16 * MB_)
#define WS_RK (32 * MB_)
#define WS_RV (48 * MB_)
#define WS_SQ (80 * MB_)
#define WS_SK (96 * MB_)
#define WS_SV (112 * MB_)
#define WS_RG (128 * MB_)
#define WS_GA (160 * MB_)
#define WS_GB (192 * MB_)
#define WS_IDX (224 * MB_)
#define WS_G (232 * MB_)
#define WS_NEED (256 * MB_)
#define WS_U16 WS_RQ
#define WS_V16 WS_RV
#define WS_MIXED WS_SQ
#define WS_X1H WS_RG
#define WS_Q WS_GA
#define DO_XN (0 * MB_)
#define DO_WINT (32 * MB_)
#define DO_SB (32 * MB_)
#define DO_WBRAT (60 * MB_)
#define DO_WBRBT (62 * MB_)

__device__ __forceinline__ int ptid() { int t = (int)threadIdx.x; asm volatile("" : "+v"(t)); return t; }
__device__ __forceinline__ u16 f2bf(float f) { unsigned u = __float_as_uint(f); u += 0x7FFFu + ((u >> 16) & 1u); return (u16)(u >> 16); }
__device__ __forceinline__ float bf2f(u16 b) { return __uint_as_float(((unsigned)b) << 16); }
__device__ __forceinline__ u16 f2h(float f) { _Float16 h = (_Float16)f; return *(u16*)&h; }
__device__ __forceinline__ float h2f(u16 b) { _Float16 h = *(_Float16*)&b; return (float)h; }
template <bool F16> __device__ __forceinline__ float ld16(const u16* p) { return F16 ? h2f(*p) : bf2f(*p); }
__device__ __forceinline__ float sigmoidf_(float x) { return 1.0f / (1.0f + __expf(-x)); }

namespace pg8 {
#define PG8_LAS __attribute__((address_space(3)))
typedef short bf16x8 __attribute__((ext_vector_type(8)));
typedef _Float16 f16x8 __attribute__((ext_vector_type(8)));
typedef float f32x4 __attribute__((ext_vector_type(4)));
typedef unsigned u32x4 __attribute__((ext_vector_type(4)));
constexpr int BM = 256, BK = 64, HALF = 128, HTB = HALF * BK * 2, STAGE_BYTES = 8 * HTB, NXCD = 8, WGM = 8;
__host__ __device__ __forceinline__ int lds_byte(int r, int c) { const int st = (r >> 4) * 2 + (c >> 5), rr = r & 15, cc = c & 31, ob = rr * 64 + cc * 2; return st * 1024 + (ob ^ (((ob >> 9) & 1) << 5)); }
__host__ __device__ __forceinline__ void stage_rc(int b, int& R, int& C) { const int st = b / 1024, sb = b % 1024, swz = sb ^ (((sb >> 9) & 1) << 5); R = (st >> 1) * 16 + swz / 64; C = (st & 1) * 32 + (swz % 64) / 2; }
__host__ __device__ __forceinline__ int perm32(int rho) { const int n = rho >> 4, i = rho & 15; return 8 * (i >> 2) + 4 * n + (i & 3); }
struct Unit { int pm, pn; };
struct Gemm { const u16* A; const u16* Bt; int M, N, K, pad; };
struct StaticOrder {
  int nM, nN, nwg, G, c;
  __host__ __device__ void init(int M, int N, int G_, int c_) { nM = M / BM; nN = N / BM; nwg = nM * nN; G = G_; c = c_; }
  __host__ __device__ bool next(int i, Unit& u) const {
    const long L = (long)i * G + c; if (L >= nwg) return false;
    int wgid = (int)L; { const int q = nwg / NXCD, r = nwg % NXCD, xcd = wgid % NXCD, off = wgid / NXCD; wgid = (xcd < r ? xcd * (q + 1) : r * (q + 1) + (xcd - r) * q) + off; }
    const int nig = WGM * nN, gid = wgid / nig, fm = gid * WGM, gsz = (nM - fm) < WGM ? (nM - fm) : WGM;
    u.pm = fm + ((wgid % nig) % gsz); u.pn = (wgid % nig) / gsz; return true;
  }
};
__device__ __forceinline__ unsigned cvt_pk_bf16(float lo, float hi) { unsigned r; asm volatile("v_cvt_pk_bf16_f32 %0, %1, %2" : "=v"(r) : "v"(lo), "v"(hi)); return r; }
__device__ __forceinline__ unsigned cvt_pk_f16(float lo, float hi) { typedef _Float16 h2 __attribute__((ext_vector_type(2))); h2 v; v.x = (_Float16)lo; v.y = (_Float16)hi; return __builtin_bit_cast(unsigned, v); }

template <bool F16, class Epi>
__device__ __forceinline__ void gemm_phase(PG8_LAS unsigned char* lds, const Gemm g, const StaticOrder& S, const Epi& E) {
  const int tid = ptid(), wid = __builtin_amdgcn_readfirstlane(tid >> 6), lane = tid & 63, wr = wid >> 2, wc = wid & 3, fr = lane & 15, fq = lane >> 4;
  const int K = g.K, nt = K / BK;
  unsigned voffA[2], voffB[2];
#pragma unroll
  for (int i = 0; i < 2; ++i) { int R, C; stage_rc(tid * 16 + i * 8192, R, C); const int Rb = ((R & ~31) + perm32(R & 31));
    voffA[i] = (unsigned)(R * K + C) * 2u; voffB[i] = (unsigned)(Rb * K + C) * 2u; }
  const size_t kstep = (size_t)(BK * 2);
  const size_t hstep = (size_t)HALF * K * 2;
  const size_t tstep = 2 * hstep;
  const unsigned ldsw = (unsigned)wid * 1024u;
  const int aoff = lds_byte(wr * 64 + fr, fq * 8), boff = lds_byte(wc * 32 + fr, fq * 8);
#define PG8_SA(b, h) (((b) * 2 + (h)) * HTB)
#define PG8_SB(b, h) ((4 + (b) * 2 + (h)) * HTB)
#define PG8_STAGE(bufoff, gbase, voff) do { _Pragma("unroll") for (int _i = 0; _i < 2; ++_i) \
    __builtin_amdgcn_global_load_lds((const unsigned*)((const char*)(gbase) + (voff)[_i]), (PG8_LAS unsigned*)(lds + (bufoff) + ldsw + _i * 8192), 16, 0, 0); } while (0)
#define PG8_LDA(dst, b, h) do { _Pragma("unroll") for (int m = 0; m < 4; ++m) _Pragma("unroll") for (int k = 0; k < 2; ++k) dst[m][k] = *(const PG8_LAS bf16x8*)(lds + PG8_SA(b, h) + aoff + m * 2048 + k * 1024); } while (0)
#define PG8_LDB(dst, b, h) do { _Pragma("unroll") for (int n = 0; n < 2; ++n) _Pragma("unroll") for (int k = 0; k < 2; ++k) dst[n][k] = *(const PG8_LAS bf16x8*)(lds + PG8_SB(b, h) + boff + n * 2048 + k * 1024); } while (0)
#define PG8_MMA(ai, bj, At, Bt) do { __builtin_amdgcn_s_setprio(1); _Pragma("unroll") for (int m = 0; m < 4; ++m) _Pragma("unroll") for (int n = 0; n < 2; ++n) _Pragma("unroll") for (int k = 0; k < 2; ++k) { \
    if constexpr (F16) acc[ai][bj][m][n] = __builtin_amdgcn_mfma_f32_16x16x32_f16(__builtin_bit_cast(f16x8, Bt[n][k]), __builtin_bit_cast(f16x8, At[m][k]), acc[ai][bj][m][n], 0, 0, 0); \
    else acc[ai][bj][m][n] = __builtin_amdgcn_mfma_f32_16x16x32_bf16(Bt[n][k], At[m][k], acc[ai][bj][m][n], 0, 0, 0); } __builtin_amdgcn_s_setprio(0); } while (0)
#define PG8_WAIT_V(n) asm volatile("s_waitcnt vmcnt(" #n ")" ::: "memory")
#define PG8_WAIT_L(n) asm volatile("s_waitcnt lgkmcnt(" #n ")" ::: "memory")
#define PG8_BAR __builtin_amdgcn_s_barrier()
#define PG8_SCHED __builtin_amdgcn_sched_barrier(0)
  Unit cur, nxt; int ui = 0;
  if (!S.next(0, cur)) return;
  f32x4 acc[2][2][4][2];
#pragma unroll
  for (int a = 0; a < 2; ++a)
#pragma unroll
    for (int b = 0; b < 2; ++b)
#pragma unroll
      for (int m = 0; m < 4; ++m)
#pragma unroll
        for (int n = 0; n < 2; ++n) acc[a][b][m][n] = (f32x4){0.f, 0.f, 0.f, 0.f};
  bf16x8 At[4][2], B0[2][2], B1[2][2];
  const char* cA = (const char*)g.A + (size_t)cur.pm * tstep; const char* cB = (const char*)g.Bt + (size_t)cur.pn * tstep;
  PG8_STAGE(PG8_SB(0, 0), cB, voffB); PG8_STAGE(PG8_SA(0, 0), cA, voffA); PG8_STAGE(PG8_SB(0, 1), cB + hstep, voffB); PG8_STAGE(PG8_SA(0, 1), cA + hstep, voffA);
  if (wr == 1) PG8_BAR;
  PG8_WAIT_V(4); PG8_BAR;
  PG8_STAGE(PG8_SB(1, 0), cB + kstep, voffB); PG8_STAGE(PG8_SA(1, 0), cA + kstep, voffA); PG8_STAGE(PG8_SB(1, 1), cB + hstep + kstep, voffB);
  PG8_WAIT_V(6); PG8_BAR;
  for (;;) {
    const bool has_next = S.next(ui + 1, nxt);
    const char* nA = has_next ? (const char*)g.A + (size_t)nxt.pm * tstep : cA; const char* nB = has_next ? (const char*)g.Bt + (size_t)nxt.pn * tstep : cB;
    for (int t = 0; t < nt; t += 2) {
      const bool last = (t == nt - 2);
      const char* a1 = cA + (size_t)(t + 1) * kstep;
      const char* a2 = last ? nA : cA + (size_t)(t + 2) * kstep; const char* b2 = last ? nB : cB + (size_t)(t + 2) * kstep;
      const char* a3 = a2 + kstep; const char* b3 = b2 + kstep;
      PG8_LDB(B0, 0, 0); PG8_SCHED; PG8_LDA(At, 0, 0); PG8_STAGE(PG8_SA(1, 1), a1 + hstep, voffA);
      PG8_WAIT_L(8); PG8_BAR; PG8_WAIT_L(0); PG8_MMA(0, 0, At, B0); PG8_BAR; PG8_SCHED;
      PG8_LDB(B1, 0, 1); PG8_STAGE(PG8_SB(0, 0), b2, voffB);
      PG8_BAR; PG8_WAIT_L(0); PG8_MMA(0, 1, At, B1); PG8_BAR;
      PG8_LDA(At, 0, 1); PG8_STAGE(PG8_SA(0, 0), a2, voffA);
      PG8_BAR; PG8_WAIT_L(0); PG8_MMA(1, 0, At, B0); PG8_BAR; PG8_SCHED;
      PG8_STAGE(PG8_SB(0, 1), b2 + hstep, voffB);
      PG8_WAIT_V(6); PG8_BAR; PG8_MMA(1, 1, At, B1); PG8_BAR;
      PG8_LDB(B0, 1, 0); PG8_SCHED; PG8_LDA(At, 1, 0); PG8_STAGE(PG8_SA(0, 1), a2 + hstep, voffA);
      PG8_WAIT_L(8); PG8_BAR; PG8_WAIT_L(0); PG8_MMA(0, 0, At, B0); PG8_BAR; PG8_SCHED;
      PG8_LDB(B1, 1, 1); PG8_STAGE(PG8_SB(1, 0), b3, voffB);
      PG8_BAR; PG8_WAIT_L(0); PG8_MMA(0, 1, At, B1); PG8_BAR;
      PG8_LDA(At, 1, 1); PG8_STAGE(PG8_SA(1, 0), a3, voffA);
      PG8_BAR; PG8_WAIT_L(0); PG8_MMA(1, 0, At, B0); PG8_BAR; PG8_SCHED;
      PG8_STAGE(PG8_SB(1, 1), b3 + hstep, voffB);
      PG8_WAIT_V(6); PG8_BAR; PG8_MMA(1, 1, At, B1); PG8_BAR;
    }
    E(acc, cur, wr, wc, fr, fq);
    if (!has_next) break;
#pragma unroll
    for (int a = 0; a < 2; ++a)
#pragma unroll
      for (int b = 0; b < 2; ++b)
#pragma unroll
        for (int m = 0; m < 4; ++m)
#pragma unroll
          for (int n = 0; n < 2; ++n) acc[a][b][m][n] = (f32x4){0.f, 0.f, 0.f, 0.f};
    cur = nxt; cA = nA; cB = nB; ++ui;
  }
  PG8_WAIT_V(0);
  if (wr == 0) PG8_BAR;
  PG8_BAR;
#undef PG8_SA
#undef PG8_SB
#undef PG8_STAGE
#undef PG8_LDA
#undef PG8_LDB
#undef PG8_MMA
#undef PG8_WAIT_V
#undef PG8_WAIT_L
#undef PG8_BAR
#undef PG8_SCHED
}

template <class Epi0, class Epi1>
__device__ __forceinline__ void gemm_phase2(PG8_LAS unsigned char* lds, const Gemm g0, const Gemm g1, const StaticOrder& S, const Epi0& E0, const Epi1& E1) {
  const int tid = ptid(), wid = __builtin_amdgcn_readfirstlane(tid >> 6), lane = tid & 63, wr = wid >> 2, wc = wid & 3, fr = lane & 15, fq = lane >> 4;
  unsigned rA2[2], rB2[2], c2[2];
#pragma unroll
  for (int i = 0; i < 2; ++i) { int R, C; stage_rc(tid * 16 + i * 8192, R, C); rA2[i] = 2u * (unsigned)R; rB2[i] = 2u * (unsigned)((R & ~31) + perm32(R & 31)); c2[i] = 2u * (unsigned)C; }
  const size_t kstep = (size_t)(BK * 2);
  const unsigned ldsw = (unsigned)wid * 1024u;
  const int aoff = lds_byte(wr * 64 + fr, fq * 8), boff = lds_byte(wc * 32 + fr, fq * 8);
#define PG8_SA(b, h) (((b) * 2 + (h)) * HTB)
#define PG8_SB(b, h) ((4 + (b) * 2 + (h)) * HTB)
#define PG8_STAGE2(bufoff, gbase, r2, kk) do { \
    __builtin_amdgcn_global_load_lds((const unsigned*)((const char*)(gbase) + ((r2)[0] * (unsigned)(kk) + c2[0])), (PG8_LAS unsigned*)(lds + (bufoff) + ldsw), 16, 0, 0); \
    __builtin_amdgcn_global_load_lds((const unsigned*)((const char*)(gbase) + ((r2)[1] * (unsigned)(kk) + c2[1])), (PG8_LAS unsigned*)(lds + (bufoff) + ldsw + 8192), 16, 0, 0); } while (0)
#define PG8_LDA(dst, b, h) do { _Pragma("unroll") for (int m = 0; m < 4; ++m) _Pragma("unroll") for (int k = 0; k < 2; ++k) dst[m][k] = *(const PG8_LAS bf16x8*)(lds + PG8_SA(b, h) + aoff + m * 2048 + k * 1024); } while (0)
#define PG8_LDB(dst, b, h) do { _Pragma("unroll") for (int n = 0; n < 2; ++n) _Pragma("unroll") for (int k = 0; k < 2; ++k) dst[n][k] = *(const PG8_LAS bf16x8*)(lds + PG8_SB(b, h) + boff + n * 2048 + k * 1024); } while (0)
#define PG8_MMA(ai, bj, At, Bt) do { __builtin_amdgcn_s_setprio(1); _Pragma("unroll") for (int m = 0; m < 4; ++m) _Pragma("unroll") for (int n = 0; n < 2; ++n) _Pragma("unroll") for (int k = 0; k < 2; ++k) \
    acc[ai][bj][m][n] = __builtin_amdgcn_mfma_f32_16x16x32_bf16(Bt[n][k], At[m][k], acc[ai][bj][m][n], 0, 0, 0); __builtin_amdgcn_s_setprio(0); } while (0)
#define PG8_WAIT_V(n) asm volatile("s_waitcnt vmcnt(" #n ")" ::: "memory")
#define PG8_WAIT_L(n) asm volatile("s_waitcnt lgkmcnt(" #n ")" ::: "memory")
#define PG8_BAR __builtin_amdgcn_s_barrier()
#define PG8_SCHED __builtin_amdgcn_sched_barrier(0)
  Unit cur, nxtu; int ui = 0, which = 0;
  if (!S.next(0, cur)) return;
  f32x4 acc[2][2][4][2];
#pragma unroll
  for (int a = 0; a < 2; ++a)
#pragma unroll
    for (int b = 0; b < 2; ++b)
#pragma unroll
      for (int m = 0; m < 4; ++m)
#pragma unroll
        for (int n = 0; n < 2; ++n) acc[a][b][m][n] = (f32x4){0.f, 0.f, 0.f, 0.f};
  bf16x8 At[4][2], B0[2][2], B1[2][2];
  int K = g0.K; size_t hstep = (size_t)HALF * K * 2;
  const char* cA = (const char*)g0.A + (size_t)cur.pm * 2 * hstep; const char* cB = (const char*)g0.Bt + (size_t)cur.pn * 2 * hstep;
  PG8_STAGE2(PG8_SB(0, 0), cB, rB2, K); PG8_STAGE2(PG8_SA(0, 0), cA, rA2, K); PG8_STAGE2(PG8_SB(0, 1), cB + hstep, rB2, K); PG8_STAGE2(PG8_SA(0, 1), cA + hstep, rA2, K);
  if (wr == 1) PG8_BAR;
  PG8_WAIT_V(4); PG8_BAR;
  PG8_STAGE2(PG8_SB(1, 0), cB + kstep, rB2, K); PG8_STAGE2(PG8_SA(1, 0), cA + kstep, rA2, K); PG8_STAGE2(PG8_SB(1, 1), cB + hstep + kstep, rB2, K);
  PG8_WAIT_V(6); PG8_BAR;
  for (;;) {
    bool has_next; int nwhich; Unit nu = cur;
    if (which == 0) { has_next = true; nwhich = 1; } else { has_next = S.next(ui + 1, nxtu); nwhich = 0; if (has_next) nu = nxtu; }
    const u16* gnA = nwhich ? g1.A : g0.A; const u16* gnB = nwhich ? g1.Bt : g0.Bt; const int gnK = nwhich ? g1.K : g0.K;
    const int nK = has_next ? gnK : K; const size_t nhstep = (size_t)HALF * nK * 2;
    const char* nA = has_next ? (const char*)gnA + (size_t)nu.pm * 2 * nhstep : cA; const char* nB = has_next ? (const char*)gnB + (size_t)nu.pn * 2 * nhstep : cB;
    const int nt = K / BK;
    for (int t = 0; t < nt; t += 2) {
      const bool last = (t == nt - 2);
      const char* a1 = cA + (size_t)(t + 1) * kstep;
      const char* a2 = last ? nA : cA + (size_t)(t + 2) * kstep; const char* b2 = last ? nB : cB + (size_t)(t + 2) * kstep;
      const char* a3 = a2 + kstep; const char* b3 = b2 + kstep;
      const size_t h2 = last ? nhstep : hstep;
      const int K2 = last ? nK : K;
      PG8_LDB(B0, 0, 0); PG8_SCHED; PG8_LDA(At, 0, 0); PG8_STAGE2(PG8_SA(1, 1), a1 + hstep, rA2, K);
      PG8_WAIT_L(8); PG8_BAR; PG8_WAIT_L(0); PG8_MMA(0, 0, At, B0); PG8_BAR; PG8_SCHED;
      PG8_LDB(B1, 0, 1); PG8_STAGE2(PG8_SB(0, 0), b2, rB2, K2);
      PG8_BAR; PG8_WAIT_L(0); PG8_MMA(0, 1, At, B1); PG8_BAR;
      PG8_LDA(At, 0, 1); PG8_STAGE2(PG8_SA(0, 0), a2, rA2, K2);
      PG8_BAR; PG8_WAIT_L(0); PG8_MMA(1, 0, At, B0); PG8_BAR; PG8_SCHED;
      PG8_STAGE2(PG8_SB(0, 1), b2 + h2, rB2, K2);
      PG8_WAIT_V(6); PG8_BAR; PG8_MMA(1, 1, At, B1); PG8_BAR;
      PG8_LDB(B0, 1, 0); PG8_SCHED; PG8_LDA(At, 1, 0); PG8_STAGE2(PG8_SA(0, 1), a2 + h2, rA2, K2);
      PG8_WAIT_L(8); PG8_BAR; PG8_WAIT_L(0); PG8_MMA(0, 0, At, B0); PG8_BAR; PG8_SCHED;
      PG8_LDB(B1, 1, 1); PG8_STAGE2(PG8_SB(1, 0), b3, rB2, K2);
      PG8_BAR; PG8_WAIT_L(0); PG8_MMA(0, 1, At, B1); PG8_BAR;
      PG8_LDA(At, 1, 1); PG8_STAGE2(PG8_SA(1, 0), a3, rA2, K2);
      PG8_BAR; PG8_WAIT_L(0); PG8_MMA(1, 0, At, B0); PG8_BAR; PG8_SCHED;
      PG8_STAGE2(PG8_SB(1, 1), b3 + h2, rB2, K2);
      PG8_WAIT_V(6); PG8_BAR; PG8_MMA(1, 1, At, B1); PG8_BAR;
    }
    if (which == 0) E0(acc, cur, wr, wc, fr, fq); else E1(acc, cur, wr, wc, fr, fq);
    if (!has_next) break;
#pragma unroll
    for (int a = 0; a < 2; ++a)
#pragma unroll
      for (int b = 0; b < 2; ++b)
#pragma unroll
        for (int m = 0; m < 4; ++m)
#pragma unroll
          for (int n = 0; n < 2; ++n) acc[a][b][m][n] = (f32x4){0.f, 0.f, 0.f, 0.f};
    if (which == 1) { cur = nu; ++ui; }
    which = nwhich; K = nK; hstep = nhstep; cA = nA; cB = nB;
  }
  PG8_WAIT_V(0);
  if (wr == 0) PG8_BAR;
  PG8_BAR;
#undef PG8_SA
#undef PG8_SB
#undef PG8_STAGE2
#undef PG8_LDA
#undef PG8_LDB
#undef PG8_MMA
#undef PG8_WAIT_V
#undef PG8_WAIT_L
#undef PG8_BAR
#undef PG8_SCHED
}
}

typedef pg8::f32x4 f32x4; typedef pg8::u32x4 u32x4;
template <class F> __device__ __forceinline__ void epi_walk(const f32x4 (&acc)[2][2][4][2], const pg8::Unit& u, int wr, int wc, int fr, int fq, F&& f) {
  const int row0 = u.pm * 256 + wr * 64 + fr, col0 = u.pn * 256 + wc * 32 + 8 * fq;
#pragma unroll
  for (int ai = 0; ai < 2; ++ai)
#pragma unroll
    for (int m = 0; m < 4; ++m)
#pragma unroll
      for (int bj = 0; bj < 2; ++bj) f(row0 + ai * 128 + m * 16, col0 + bj * 128, acc[ai][bj][m][0], acc[ai][bj][m][1]);
}
__device__ __forceinline__ u32x4 pack8_bf16(f32x4 v0, f32x4 v1) { u32x4 w; w.x = pg8::cvt_pk_bf16(v0[0], v0[1]); w.y = pg8::cvt_pk_bf16(v0[2], v0[3]); w.z = pg8::cvt_pk_bf16(v1[0], v1[1]); w.w = pg8::cvt_pk_bf16(v1[2], v1[3]); return w; }
__device__ __forceinline__ u32x4 pack8_f16(f32x4 v0, f32x4 v1) { u32x4 w; w.x = pg8::cvt_pk_f16(v0[0], v0[1]); w.y = pg8::cvt_pk_f16(v0[2], v0[3]); w.z = pg8::cvt_pk_f16(v1[0], v1[1]); w.w = pg8::cvt_pk_f16(v1[2], v1[3]); return w; }
__device__ __forceinline__ void unpack8_bf16(u32x4 w, float (&f)[8]) {
  f[0] = __uint_as_float(w.x << 16); f[1] = __uint_as_float(w.x & 0xffff0000u); f[2] = __uint_as_float(w.y << 16); f[3] = __uint_as_float(w.y & 0xffff0000u);
  f[4] = __uint_as_float(w.z << 16); f[5] = __uint_as_float(w.z & 0xffff0000u); f[6] = __uint_as_float(w.w << 16); f[7] = __uint_as_float(w.w & 0xffff0000u); }

typedef unsigned u32x2v __attribute__((ext_vector_type(2)));
__device__ __forceinline__ u32x2v pack8_fp8(f32x4 v0, f32x4 v1) { int a = 0, b = 0;
  a = __builtin_amdgcn_cvt_pk_fp8_f32(v0[0], v0[1], a, false); a = __builtin_amdgcn_cvt_pk_fp8_f32(v0[2], v0[3], a, true);
  b = __builtin_amdgcn_cvt_pk_fp8_f32(v1[0], v1[1], b, false); b = __builtin_amdgcn_cvt_pk_fp8_f32(v1[2], v1[3], b, true);
  u32x2v r; r.x = (unsigned)a; r.y = (unsigned)b; return r; }
__device__ __forceinline__ void unpack8_fp8(u32x2v w, float (&f)[8]) { const int a = (int)w.x, b = (int)w.y;
  const auto p0 = __builtin_amdgcn_cvt_pk_f32_fp8(a, false), p1 = __builtin_amdgcn_cvt_pk_f32_fp8(a, true), p2 = __builtin_amdgcn_cvt_pk_f32_fp8(b, false), p3 = __builtin_amdgcn_cvt_pk_f32_fp8(b, true);
  f[0] = p0[0]; f[1] = p0[1]; f[2] = p1[0]; f[3] = p1[1]; f[4] = p2[0]; f[5] = p2[1]; f[6] = p3[0]; f[7] = p3[1]; }
struct FEpiInProj {
  u16 *rq, *rk, *rv, *rg, *sq, *sk, *sv, *ga, *gb;
  __device__ __forceinline__ void operator()(const f32x4 (&acc)[2][2][4][2], const pg8::Unit& u, int wr, int wc, int fr, int fq) const {
    const int c = u.pn * 256; u16* b; int ld, c0;
    if (c < 512) { b = rq; ld = 512; c0 = 0; } else if (c < 1024) { b = rk; ld = 512; c0 = 512; } else if (c < 2048) { b = rv; ld = 1024; c0 = 1024; }
    else if (c < 3072) { b = rg; ld = 1024; c0 = 2048; } else if (c < 3584) { b = sq; ld = 512; c0 = 3072; } else if (c < 4096) { b = sk; ld = 512; c0 = 3584; }
    else if (c < 4608) { b = sv; ld = 512; c0 = 4096; } else if (c < 5632) { b = ga; ld = 1024; c0 = 4608; } else { b = gb; ld = 1024; c0 = 5632; }
    if (c >= 4608) {
      unsigned char* g8 = (unsigned char*)b;
      epi_walk(acc, u, wr, wc, fr, fq, [&](int row, int col, f32x4 v0, f32x4 v1) { *(u32x2v*)(g8 + (size_t)row * 1024 + (col - c0)) = pack8_fp8(v0, v1); });
    } else
    epi_walk(acc, u, wr, wc, fr, fq, [&](int row, int col, f32x4 v0, f32x4 v1) { *(u32x4*)(b + (size_t)row * ld + (col - c0)) = pack8_bf16(v0, v1); });
  }
};
struct FEpiMixB { u16* mixed; const u16* gb;
  __device__ __forceinline__ void operator()(const f32x4 (&acc)[2][2][4][2], const pg8::Unit& u, int wr, int wc, int fr, int fq) const {
    const int row0 = u.pm * 256 + wr * 64 + fr, col0 = u.pn * 256 + wc * 32 + 8 * fq;
#pragma unroll
    for (int ai = 0; ai < 2; ++ai) {
      u32x2v gw[4][2];
#pragma unroll
      for (int m = 0; m < 4; ++m)
#pragma unroll
        for (int bj = 0; bj < 2; ++bj) gw[m][bj] = *(const u32x2v*)((const unsigned char*)gb + (size_t)(row0 + ai * 128 + m * 16) * D_ + col0 + bj * 128);
#pragma unroll
      for (int m = 0; m < 4; ++m)
#pragma unroll
        for (int bj = 0; bj < 2; ++bj) { const size_t i = (size_t)(row0 + ai * 128 + m * 16) * D_ + col0 + bj * 128; float g[8]; unpack8_fp8(gw[m][bj], g);
          const f32x4 v0 = acc[ai][bj][m][0], v1 = acc[ai][bj][m][1]; f32x4 a, b2;
          a[0] = sigmoidf_(g[0]) * v0[0]; a[1] = sigmoidf_(g[1]) * v0[1]; a[2] = sigmoidf_(g[2]) * v0[2]; a[3] = sigmoidf_(g[3]) * v0[3];
          b2[0] = sigmoidf_(g[4]) * v1[0]; b2[1] = sigmoidf_(g[5]) * v1[1]; b2[2] = sigmoidf_(g[6]) * v1[2]; b2[3] = sigmoidf_(g[7]) * v1[3];
          *(u32x4*)(mixed + i) = pack8_bf16(a, b2); }
    }
  }
};
struct FEpiMixA { u16* mixed; const u16* ga;
  __device__ __forceinline__ void operator()(const f32x4 (&acc)[2][2][4][2], const pg8::Unit& u, int wr, int wc, int fr, int fq) const {
    const int row0 = u.pm * 256 + wr * 64 + fr, col0 = u.pn * 256 + wc * 32 + 8 * fq;
#pragma unroll
    for (int ai = 0; ai < 2; ++ai)
#pragma unroll
      for (int mh = 0; mh < 2; ++mh) {
        u32x2v gw[2][2]; u32x4 ow[2][2];
#pragma unroll
        for (int mm = 0; mm < 2; ++mm)
#pragma unroll
          for (int bj = 0; bj < 2; ++bj) { const size_t i = (size_t)(row0 + ai * 128 + (2 * mh + mm) * 16) * D_ + col0 + bj * 128; gw[mm][bj] = *(const u32x2v*)((const unsigned char*)ga + i); ow[mm][bj] = *(const u32x4*)(mixed + i); }
#pragma unroll
        for (int mm = 0; mm < 2; ++mm)
#pragma unroll
          for (int bj = 0; bj < 2; ++bj) { const int m = 2 * mh + mm; const size_t i = (size_t)(row0 + ai * 128 + m * 16) * D_ + col0 + bj * 128; float g[8], o[8]; unpack8_fp8(gw[mm][bj], g); unpack8_bf16(ow[mm][bj], o);
            const f32x4 v0 = acc[ai][bj][m][0], v1 = acc[ai][bj][m][1]; f32x4 a, b2;
            a[0] = o[0] + sigmoidf_(g[0]) * v0[0]; a[1] = o[1] + sigmoidf_(g[1]) * v0[1]; a[2] = o[2] + sigmoidf_(g[2]) * v0[2]; a[3] = o[3] + sigmoidf_(g[3]) * v0[3];
            b2[0] = o[4] + sigmoidf_(g[4]) * v1[0]; b2[1] = o[5] + sigmoidf_(g[5]) * v1[1]; b2[2] = o[6] + sigmoidf_(g[6]) * v1[2]; b2[3] = o[7] + sigmoidf_(g[7]) * v1[3];
            *(u32x4*)(mixed + i) = pack8_bf16(a, b2); }
      }
  }
};
struct FEpiOut { const float* x; float* x1; u16* x1h; float* ssq;
  __device__ __forceinline__ void operator()(const f32x4 (&acc)[2][2][4][2], const pg8::Unit& u, int wr, int wc, int fr, int fq) const {
    const int row0 = u.pm * 256 + wr * 64 + fr, col0 = u.pn * 256 + wc * 32 + 8 * fq;
#pragma unroll
    for (int ai = 0; ai < 2; ++ai) {
      f32x4 xa[4][2], xb[4][2];
#pragma unroll
      for (int m = 0; m < 4; ++m)
#pragma unroll
        for (int bj = 0; bj < 2; ++bj) { const size_t i = (size_t)(row0 + ai * 128 + m * 16) * D_ + col0 + bj * 128; xa[m][bj] = *(const f32x4*)(x + i); xb[m][bj] = *(const f32x4*)(x + i + 4); }
#pragma unroll
      for (int m = 0; m < 4; ++m) {
        const int row = row0 + ai * 128 + m * 16; float ss = 0.f;
#pragma unroll
        for (int bj = 0; bj < 2; ++bj) {
          const size_t i = (size_t)row * D_ + col0 + bj * 128;
          const f32x4 a = xa[m][bj] + acc[ai][bj][m][0], b2 = xb[m][bj] + acc[ai][bj][m][1];
          *(u32x4*)(x1h + i) = pack8_f16(a, b2);
          ss += a[0] * a[0] + a[1] * a[1] + a[2] * a[2] + a[3] * a[3] + b2[0] * b2[0] + b2[1] * b2[1] + b2[2] * b2[2] + b2[3] * b2[3];
        }
        ss += __shfl_xor(ss, 16); ss += __shfl_xor(ss, 32);
        if (fq == 0 && ssq) atomicAdd(ssq + row, ss);
      }
    }
  }
};
struct FEpiQ { const float* ssq; u16* q;
  __device__ __forceinline__ void operator()(const f32x4 (&acc)[2][2][4][2], const pg8::Unit& u, int wr, int wc, int fr, int fq) const {
    const int row0 = u.pm * 256 + wr * 64 + fr, col0 = u.pn * 256 + wc * 32 + 8 * fq;
    float rs[2][4];
#pragma unroll
    for (int ai = 0; ai < 2; ++ai)
#pragma unroll
      for (int m = 0; m < 4; ++m) rs[ai][m] = ssq[row0 + ai * 128 + m * 16];
#pragma unroll
    for (int ai = 0; ai < 2; ++ai)
#pragma unroll
      for (int m = 0; m < 4; ++m) { const float rstd = rsqrtf(rs[ai][m] * (1.0f / D_) + 1e-6f);
#pragma unroll
        for (int bj = 0; bj < 2; ++bj) *(u32x4*)(q + (size_t)(row0 + ai * 128 + m * 16) * 2048 + col0 + bj * 128) = pack8_bf16(acc[ai][bj][m][0] * rstd, acc[ai][bj][m][1] * rstd); }
  }
};

#define LAS __attribute__((address_space(3)))
typedef short s16x8 __attribute__((ext_vector_type(8)));
typedef short s16x4 __attribute__((ext_vector_type(4)));
typedef float f32x16 __attribute__((ext_vector_type(16)));
typedef float f32x2 __attribute__((ext_vector_type(2)));
typedef __bf16 bf16x2_t __attribute__((ext_vector_type(2)));
typedef _Float16 h16x2 __attribute__((ext_vector_type(2)));
__device__ __forceinline__ unsigned pk_bf16(float lo, float hi) { f32x2 v = {lo, hi}; return __builtin_bit_cast(unsigned, __builtin_convertvector(v, bf16x2_t)); }
__device__ __forceinline__ unsigned pk_f16(float lo, float hi) { f32x2 v = {lo, hi}; return __builtin_bit_cast(unsigned, __builtin_convertvector(v, h16x2)); }
#define MFMA32(a, b, c) __builtin_amdgcn_mfma_f32_32x32x16_bf16((a), (b), (c), 0, 0, 0)
#define MFMA16(a, b, c) __builtin_amdgcn_mfma_f32_16x16x32_bf16((a), (b), (c), 0, 0, 0)

struct Params {
  const float *x, *norm_attn, *w_in, *ret_q_norm, *ret_k_norm, *ret_gn, *sb_q_norm, *sb_k_norm, *w_bra, *w_brb, *w_out, *norm_ffn, *w_q, *sk1, *sk2, *peer_u, *peer_v;
  float* out; char* ws;
  float l2g[8];
  int use_cg, pad;
};

template <bool F16> __device__ __forceinline__ void transpose_tile(const float* __restrict__ W, u16* __restrict__ Wt, int K, int N, int k0, int n0, const float* __restrict__ scale, float* tile  ) {
  const int tid = ptid();
  { const int r = tid >> 4, c4 = tid & 15;
#pragma unroll
    for (int hh = 0; hh < 2; ++hh) { const int k = k0 + r + 32 * hh; float4 v = *(const float4*)(W + (size_t)k * N + n0 + 4 * c4); const float s = scale ? scale[k] : 1.0f;
      float* tp = tile + (r + 32 * hh) * 65 + 4 * c4; tp[0] = v.x * s; tp[1] = v.y * s; tp[2] = v.z * s; tp[3] = v.w * s; } }
  __syncthreads();
  { const int n = tid >> 3, kc = tid & 7; float f[8];
#pragma unroll
    for (int i = 0; i < 8; ++i) f[i] = tile[(8 * kc + i) * 65 + n];
    u32x4 w;
    if (F16) { w.x = pk_f16(f[0], f[1]); w.y = pk_f16(f[2], f[3]); w.z = pk_f16(f[4], f[5]); w.w = pk_f16(f[6], f[7]); }
    else { w.x = pk_bf16(f[0], f[1]); w.y = pk_bf16(f[2], f[3]); w.z = pk_bf16(f[4], f[5]); w.w = pk_bf16(f[6], f[7]); }
    *(u32x4*)(Wt + (size_t)(n0 + n) * K + k0 + 8 * kc) = w; }
  __syncthreads();
}
__device__ __forceinline__ void phase_prologue(const Params& p, unsigned char* smem, char* dob) {
  const int tid = ptid(), lane = tid & 63, w = tid >> 6, G = gridDim.x, b = blockIdx.x;
  u16* XN = (u16*)(dob + DO_XN);
  for (int t0 = b * 8 + w; t0 < S_; t0 += 2 * G * 8) {
    float4 v[2][4]; float4 gq[4];
#pragma unroll
    for (int i = 0; i < 4; ++i) gq[i] = *(const float4*)(p.norm_attn + lane * 16 + 4 * i);
#pragma unroll
    for (int rr = 0; rr < 2; ++rr) { const int t = t0 + rr * G * 8 < S_ ? t0 + rr * G * 8 : t0; const float* xp = p.x + (size_t)t * D_ + lane * 16;
#pragma unroll
      for (int i = 0; i < 4; ++i) v[rr][i] = *(const float4*)(xp + 4 * i); }
#pragma unroll
    for (int rr = 0; rr < 2; ++rr) { const int t = t0 + rr * G * 8; if (t < S_) {
      float ss = 0.f;
#pragma unroll
      for (int i = 0; i < 4; ++i) ss += v[rr][i].x * v[rr][i].x + v[rr][i].y * v[rr][i].y + v[rr][i].z * v[rr][i].z + v[rr][i].w * v[rr][i].w;
#pragma unroll
      for (int o = 32; o > 0; o >>= 1) ss += __shfl_xor(ss, o);
      const float r = rsqrtf(ss * (1.0f / D_) + 1e-6f);
      u32x4 o0, o1;
      o0.x = pk_bf16(v[rr][0].x * r * gq[0].x, v[rr][0].y * r * gq[0].y); o0.y = pk_bf16(v[rr][0].z * r * gq[0].z, v[rr][0].w * r * gq[0].w); o0.z = pk_bf16(v[rr][1].x * r * gq[1].x, v[rr][1].y * r * gq[1].y); o0.w = pk_bf16(v[rr][1].z * r * gq[1].z, v[rr][1].w * r * gq[1].w);
      o1.x = pk_bf16(v[rr][2].x * r * gq[2].x, v[rr][2].y * r * gq[2].y); o1.y = pk_bf16(v[rr][2].z * r * gq[2].z, v[rr][2].w * r * gq[2].w); o1.z = pk_bf16(v[rr][3].x * r * gq[3].x, v[rr][3].y * r * gq[3].y); o1.w = pk_bf16(v[rr][3].z * r * gq[3].z, v[rr][3].w * r * gq[3].w);
      u16* op = XN + (size_t)t * D_ + lane * 16; *(u32x4*)op = o0; *(u32x4*)(op + 8) = o1; } }
  }
  float* tile = (float*)smem;
  for (int j = b; j < 2816; j += G) {
    if (j < 1664) { transpose_tile<false>(p.w_in, (u16*)(dob + DO_WINT), 1024, 6656, (j / 104) * 64, (j % 104) * 64, nullptr, tile); }
    else if (j < 1920) { const int q = j - 1664; transpose_tile<false>(p.w_bra, (u16*)(dob + DO_WBRAT), 1024, 1024, (q / 16) * 64, (q % 16) * 64, nullptr, tile); }
    else if (j < 2048) { const int q = j - 1920; transpose_tile<false>(p.w_brb, (u16*)(dob + DO_WBRBT), 512, 1024, (q / 16) * 64, (q % 16) * 64, nullptr, tile); }
    else if (j < 2304) { const int q = j - 2048; transpose_tile<false>(p.w_out, (u16*)(p.ws + WS_WOUTT), 1024, 1024, (q / 16) * 64, (q % 16) * 64, nullptr, tile); }
    else { const int q = j - 2304; transpose_tile<true>(p.w_q, (u16*)(p.ws + WS_WQT), 1024, 2048, (q / 32) * 64, (q % 32) * 64, p.norm_ffn, tile); }
  }
  const int gt = b * 512 + tid, GT = G * 512;
  for (int i = gt; i < 16384; i += GT) { ((u16*)(p.ws + WS_K1))[i] = f2bf(p.sk1[i]); ((u16*)(p.ws + WS_K2))[i] = f2bf(p.sk2[i]); ((float*)(p.ws + WS_SSQ))[i] = 0.f; }
  for (int i = gt; i < S_ * 32; i += GT) { const int t = i >> 5, f = i & 31; const float freq = powf(10000.0f, -(float)f / 32.0f); float sn, cs; sincosf((float)t * freq, &sn, &cs);
    ((float*)(p.ws + WS_ROPE_C))[i] = cs; ((float*)(p.ws + WS_ROPE_S))[i] = sn; }
}

#define WS_U8 (240 * MB_)
#define WS_V8 WS_RK
#define WS_HP WS_GA
#define WS_A WS_RV
#define U8_SCALE 256.0f
#define V8_SCALE 32.0f
#define SLICE_BYTES (16384 * 128)
__device__ __forceinline__ void conv_table(const Params& p, int which, int part, int nparts) {
  const size_t gt = (size_t)part * 512 + ptid(), GT = (size_t)nparts * 512, NC = (size_t)S_ * D_ / 8;
  unsigned char* T8 = (unsigned char*)(p.ws + (which == 0 ? WS_U8 : WS_V8)); const float* src = which == 0 ? p.peer_u : p.peer_v; const float sc = which == 0 ? U8_SCALE : V8_SCALE;
  for (size_t c0 = gt; c0 < NC; c0 += 4 * GT) {
    float4 a0[4], a1[4], g0[4], g1[4];
#pragma unroll
    for (int k = 0; k < 4; ++k) { const size_t c = c0 + k * GT < NC ? c0 + k * GT : c0, i = c * 8; const int col = (int)(i & (D_ - 1));
      a0[k] = *(const float4*)(src + i); a1[k] = *(const float4*)(src + i + 4);
      if (which == 0) { g0[k] = *(const float4*)(p.norm_ffn + col); g1[k] = *(const float4*)(p.norm_ffn + col + 4); } else { g0[k] = make_float4(1.f, 1.f, 1.f, 1.f); g1[k] = g0[k]; } }
#pragma unroll
    for (int k = 0; k < 4; ++k) { const size_t c = c0 + k * GT; if (c < NC) { const size_t i = c * 8; const int col = (int)(i & (D_ - 1)), e = (int)(i >> 10);
      const size_t dst = (size_t)(col >> 7) * SLICE_BYTES + (size_t)e * 128 + (col & 127);
      int w0 = 0, w1 = 0;
      w0 = __builtin_amdgcn_cvt_pk_fp8_f32(a0[k].x * g0[k].x * sc, a0[k].y * g0[k].y * sc, w0, false); w0 = __builtin_amdgcn_cvt_pk_fp8_f32(a0[k].z * g0[k].z * sc, a0[k].w * g0[k].w * sc, w0, true);
      w1 = __builtin_amdgcn_cvt_pk_fp8_f32(a1[k].x * g1[k].x * sc, a1[k].y * g1[k].y * sc, w1, false); w1 = __builtin_amdgcn_cvt_pk_fp8_f32(a1[k].z * g1[k].z * sc, a1[k].w * g1[k].w * sc, w1, true);
      *(uint2*)(T8 + dst) = make_uint2((unsigned)w0, (unsigned)w1); } }
  }
}

#define SEL_KSTR 272
#define INSERT16(V, x) do { const float _x = (x); _Pragma("unroll") for (int _j = 15; _j >= 1; --_j) V[_j] = __builtin_amdgcn_fmed3f(V[_j - 1], V[_j], _x); V[0] = fmaxf(V[0], _x); } while (0)
#define MERGE16(V) do { float _c[16]; _Pragma("unroll") for (int _i = 0; _i < 16; ++_i) _c[_i] = __shfl_xor(V[_i], 32); \
  _Pragma("unroll") for (int _i = 0; _i < 16; ++_i) V[_i] = fmaxf(V[_i], _c[15 - _i]); \
  _Pragma("unroll") for (int _k = 8; _k >= 1; _k >>= 1) { _Pragma("unroll") for (int _i = 0; _i < 16; ++_i) if ((_i & _k) == 0) { const float _hi = fmaxf(V[_i], V[_i + _k]), _lo = fminf(V[_i], V[_i + _k]); V[_i] = _hi; V[_i + _k] = _lo; } } } while (0)
__device__ __forceinline__ void select_side(const u16* __restrict__ qrow  , LAS unsigned char* ks, int lane, float (&V)[16]) {
  const int hh = lane >> 5, r = lane & 31;
  s16x8 bq[8];
#pragma unroll
  for (int k = 0; k < 8; ++k) bq[k] = *(const s16x8*)(qrow + 16 * k + 8 * hh);
#pragma unroll
  for (int j = 0; j < 16; ++j) V[j] = -3.0e38f;
#pragma unroll
  for (int a = 0; a < 4; ++a) {
    f32x16 acc;
#pragma unroll
    for (int i = 0; i < 16; ++i) acc[i] = 0.f;
#pragma unroll
    for (int k = 0; k < 8; ++k) { const s16x8 af = *(const LAS s16x8*)(ks + (32 * a + r) * SEL_KSTR + (16 * k + 8 * hh) * 2); acc = MFMA32(af, bq[k], acc); }
#pragma unroll
    for (int i = 0; i < 16; ++i) { const int n = 32 * a + (i & 3) + 8 * (i >> 2) + 4 * hh; const float key = __uint_as_float((__float_as_uint(acc[i]) & 0xFFFFFF80u) | (unsigned)n); INSERT16(V, key); }
  }
  MERGE16(V);
}
struct ConvRegs { float4 a0[4], a1[4]; };
__device__ __forceinline__ void convv_load(const Params& p, int j, ConvRegs& R) {
  const size_t gt = (size_t)blockIdx.x * 512 + ptid(), GT = (size_t)gridDim.x * 512, NC = (size_t)S_ * D_ / 8, c0 = gt + (size_t)j * 4 * GT;
#pragma unroll
  for (int k = 0; k < 4; ++k) { const size_t c = c0 + k * GT < NC ? c0 + k * GT : gt, i = c * 8; R.a0[k] = *(const float4*)(p.peer_v + i); R.a1[k] = *(const float4*)(p.peer_v + i + 4); }
}
__device__ __forceinline__ void convv_store(const Params& p, int j, const ConvRegs& R) {
  const size_t gt = (size_t)blockIdx.x * 512 + ptid(), GT = (size_t)gridDim.x * 512, NC = (size_t)S_ * D_ / 8, c0 = gt + (size_t)j * 4 * GT;
  unsigned char* T8 = (unsigned char*)(p.ws + WS_V8);
#pragma unroll
  for (int k = 0; k < 4; ++k) { const size_t c = c0 + k * GT; if (c < NC) { const size_t i = c * 8; const int col = (int)(i & (D_ - 1)), e = (int)(i >> 10);
    const size_t dst = (size_t)(col >> 7) * SLICE_BYTES + (size_t)e * 128 + (col & 127);
    int w0 = 0, w1 = 0;
    w0 = __builtin_amdgcn_cvt_pk_fp8_f32(R.a0[k].x * V8_SCALE, R.a0[k].y * V8_SCALE, w0, false); w0 = __builtin_amdgcn_cvt_pk_fp8_f32(R.a0[k].z * V8_SCALE, R.a0[k].w * V8_SCALE, w0, true);
    w1 = __builtin_amdgcn_cvt_pk_fp8_f32(R.a1[k].x * V8_SCALE, R.a1[k].y * V8_SCALE, w1, false); w1 = __builtin_amdgcn_cvt_pk_fp8_f32(R.a1[k].z * V8_SCALE, R.a1[k].w * V8_SCALE, w1, true);
    *(uint2*)(T8 + dst) = make_uint2((unsigned)w0, (unsigned)w1); } }
}
__device__ __forceinline__ void phase_select(const Params& p, unsigned char* smem, const pg8::StaticOrder& S) {
  const int tid = ptid(), lane = tid & 63, w = tid >> 6, hh = lane >> 5;
  LAS unsigned char* lds = (LAS unsigned char*)smem;
  LAS unsigned char* k1s = lds; LAS unsigned char* k2s = lds + 128 * SEL_KSTR; LAS unsigned* scr = (LAS unsigned*)(lds + 2 * 128 * SEL_KSTR + w * 4096);
  const u16* K1 = (const u16*)(p.ws + WS_K1); const u16* K2 = (const u16*)(p.ws + WS_K2); const u16* Q = (const u16*)(p.ws + WS_Q);
  u16* IDX = (u16*)(p.ws + WS_IDX); float* GW = (float*)(p.ws + WS_G);
  for (int c = tid; c < 2048; c += 512) { const int n = c >> 4, ch = c & 15;
    *(LAS u32x4*)(k1s + n * SEL_KSTR + ch * 16) = *(const u32x4*)(K1 + n * 128 + ch * 8); *(LAS u32x4*)(k2s + n * SEL_KSTR + ch * 16) = *(const u32x4*)(K2 + n * 128 + ch * 8); }
  __syncthreads();
  pg8::Unit un;
  const int npieces = (int)(((size_t)S_ * D_ / 8 + (size_t)4 * gridDim.x * 512 - 1) / ((size_t)4 * gridDim.x * 512)); int cj = 0;
  for (int ui = 0; S.next(ui, un); ++ui) {
    const int tb = un.pm * 8 + w, h = un.pn, t = tb * 32 + (lane & 31);
    const u16* qrow = Q + (size_t)t * 2048 + h * 256;
    float v1[16], v2[16];
    { ConvRegs cr; const bool cv = cj < npieces; if (cv) convv_load(p, cj, cr);
      select_side(qrow, k1s, lane, v1);
      if (cv) { convv_store(p, cj, cr); ++cj; } }
    { ConvRegs cr; const bool cv = cj < npieces; if (cv) convv_load(p, cj, cr);
      select_side(qrow + 128, k2s, lane, v2);
      if (cv) { convv_store(p, cj, cr); ++cj; } }
    if (hh == 0) {
#pragma unroll
      for (int i = 0; i < 16; ++i) { scr[(lane & 31) * 32 + i] = __float_as_uint(v1[i]); scr[(lane & 31) * 32 + 16 + i] = __float_as_uint(v2[i]); } }
    float c[16];
#pragma unroll
    for (int j = 0; j < 16; ++j) c[j] = -3.0e38f;
    { int ci = 0; float pend = 0.f; unsigned pcode = 0;
#pragma unroll
      for (int a = 0; a < 16; ++a)
#pragma unroll
        for (int bb = 0; bb < 16; ++bb) if ((a + 1) * (bb + 1) <= 16) {
          const float s = v1[a] + v2[bb]; const unsigned code = (unsigned)(a * 16 + bb);
          if ((ci & 1) == 0) { pend = s; pcode = code; }
          else { const float x = hh ? s : pend; const unsigned cd = hh ? code : pcode; INSERT16(c, __uint_as_float((__float_as_uint(x) & 0xFFFFFF00u) | cd)); }
          ++ci; }
    }
    MERGE16(c);
    float sum = 0.f, e[16];
#pragma unroll
    for (int j = 0; j < 16; ++j) { e[j] = __expf(c[j] - c[0]); sum += e[j]; }
    const float inv = 1.0f / sum;
    unsigned ids[8]; float gs[8];
#pragma unroll
    for (int j = 0; j < 8; ++j) { float cl = c[j], ch = c[8 + j], el = e[j], eh = e[8 + j]; asm volatile("" : "+v"(cl), "+v"(ch), "+v"(el), "+v"(eh));
      const float cj = hh ? ch : cl; const unsigned code = __float_as_uint(cj) & 0xFFu; gs[j] = (hh ? eh : el) * inv;
      const unsigned k1 = scr[(lane & 31) * 32 + (code >> 4)], k2 = scr[(lane & 31) * 32 + 16 + (code & 15)]; ids[j] = (k1 & 127u) * 128u + (k2 & 127u); }
    u32x4 iw; iw.x = ids[0] | (ids[1] << 16); iw.y = ids[2] | (ids[3] << 16); iw.z = ids[4] | (ids[5] << 16); iw.w = ids[6] | (ids[7] << 16);
    *(u32x4*)(IDX + (size_t)t * 128 + h * 16 + 8 * hh) = iw;
    float* gp = GW + (size_t)t * 128 + h * 16 + 8 * hh; *(f32x4*)gp = (f32x4){gs[0], gs[1], gs[2], gs[3]}; *(f32x4*)(gp + 4) = (f32x4){gs[4], gs[5], gs[6], gs[7]};
  }
  for (; cj < npieces; ++cj) { ConvRegs cr; convv_load(p, cj, cr); convv_store(p, cj, cr); }
}

__device__ __forceinline__ unsigned xb_xcc_id();
#define LDS_BAR_OFF 147440
__device__ __forceinline__ float gelu_tanh_f(float x) { const float u = 0.7978845608028654f * (x + 0.044715f * x * x * x); const float e = __expf(2.0f * u); return x * (1.0f - 1.0f / (e + 1.0f)); }
#define GQ_WORD(ph, x) (4096 + 64 * ((ph) * 8 + (x)))
#define GCHUNK 32
__device__ __forceinline__ int gq_next(unsigned* ctr, volatile LAS int* slot) {
  if (ptid() == 0) *slot = (int)__hip_atomic_fetch_add(ctr, 1u, __ATOMIC_RELAXED, __HIP_MEMORY_SCOPE_AGENT);
  __syncthreads(); const int v = *slot; __syncthreads(); return v;
}
#define NTOK 16
template <int SIDE, bool DRY> __device__ __forceinline__ void gather_wave_chunk(const Params& p, int tb, int x, int lane) {
  const int ps = lane >> 3, k8 = lane & 7;
  const u16* AUX = (SIDE == 0) ? (const u16*)(p.ws + WS_X1H) + 128 * x + 16 * k8 : (const u16*)(p.ws + WS_A) + 16 * ps;
  const int auxld = (SIDE == 0) ? D_ : 128;
  const u16* IDX = (const u16*)(p.ws + WS_IDX) + 16 * ps;
  const unsigned char* T8 = (const unsigned char*)(p.ws + (SIDE == 0 ? WS_U8 : WS_V8)) + (size_t)x * SLICE_BYTES;
  const unsigned loff = 16u * (unsigned)k8;
  u16* HP = (u16*)(p.ws + WS_HP) + (size_t)x * S_ * 128 + 2 * lane;
  float* OUT = p.out + 128 * x + 16 * k8 + 2 * ps; const u16* X1R = (const u16*)(p.ws + WS_X1H) + 128 * x + 16 * k8 + 2 * ps;
  u32x4 mi[2][2], ax[2][2], gw[2][16]; unsigned xres[2];
#define G_META(kk) do { mi[(kk) & 1][0] = *(const u32x4*)(IDX + (size_t)(tb + (kk)) * 128); mi[(kk) & 1][1] = *(const u32x4*)(IDX + (size_t)(tb + (kk)) * 128 + 8); } while (0)
#define G_ISSUE(kk) do { const int s_ = (kk) & 1; const int t_ = tb + (kk); const unsigned iw_[8] = {mi[s_][0].x, mi[s_][0].y, mi[s_][0].z, mi[s_][0].w, mi[s_][1].x, mi[s_][1].y, mi[s_][1].z, mi[s_][1].w}; \
    _Pragma("unroll") for (int i_ = 0; i_ < 16; ++i_) { const unsigned e_ = (i_ & 1) ? (iw_[i_ >> 1] >> 16) : (iw_[i_ >> 1] & 0xFFFFu); gw[s_][i_] = *(const u32x4*)(T8 + (e_ * 128u + loff)); } \
    ax[s_][0] = *(const u32x4*)(AUX + (size_t)t_ * auxld); ax[s_][1] = *(const u32x4*)(AUX + (size_t)t_ * auxld + 8); \
    if (SIDE == 1) xres[s_] = *(const unsigned*)(X1R + (size_t)t_ * D_); } while (0)
  G_META(0); G_META(1); G_ISSUE(0);
#pragma unroll
  for (int k = 0; k < NTOK; ++k) {
    const int gs = k & 1, t = tb + k;
    if (k + 1 < NTOK) G_ISSUE(k + 1);
    if (k + 2 < NTOK) G_META(k + 2);
    const unsigned xw[8] = {ax[gs][0].x, ax[gs][0].y, ax[gs][0].z, ax[gs][0].w, ax[gs][1].x, ax[gs][1].y, ax[gs][1].z, ax[gs][1].w};
    if (SIDE == 0) {
      float sv[16];
#pragma unroll
      for (int i = 0; i < 16; ++i) {
        const unsigned w4[4] = {gw[gs][i].x, gw[gs][i].y, gw[gs][i].z, gw[gs][i].w};
        float s = 0.f;
#pragma unroll
        for (int d = 0; d < 4; ++d) { const unsigned wd = w4[d], x0 = xw[2 * d], x1 = xw[2 * d + 1];
          s = __builtin_amdgcn_fdot2(__builtin_amdgcn_cvt_scalef32_pk_f16_fp8(wd, 1.0f, false), __builtin_bit_cast(h16x2, x0), s, false);
          s = __builtin_amdgcn_fdot2(__builtin_amdgcn_cvt_scalef32_pk_f16_fp8(wd, 1.0f, true), __builtin_bit_cast(h16x2, x1), s, false); }
        sv[i] = s;
      }
      const bool c2 = (lane & 4) != 0, c1 = (lane & 2) != 0, c0 = (lane & 1) != 0;
      float q8[8], q4[4], q2[2];
#define DPP_F(v, ctrl) __uint_as_float(__builtin_amdgcn_update_dpp(0, (int)__float_as_uint(v), (ctrl), 0xf, 0xf, false))
#pragma unroll
      for (int c = 0; c < 8; ++c) { const float keep = c2 ? sv[c + 8] : sv[c], send = c2 ? sv[c] : sv[c + 8]; const float m = DPP_F(send, 0x141); q8[c] = keep + DPP_F(m, 0x1B); }
#pragma unroll
      for (int c = 0; c < 4; ++c) { const float keep = c1 ? q8[c + 4] : q8[c], send = c1 ? q8[c] : q8[c + 4]; q4[c] = keep + DPP_F(send, 0x4E); }
#pragma unroll
      for (int c = 0; c < 2; ++c) { const float keep = c0 ? q4[c + 2] : q4[c], send = c0 ? q4[c] : q4[c + 2]; q2[c] = keep + DPP_F(send, 0xB1); }
      const float h0 = q2[0], h1 = q2[1];
      *(unsigned*)(HP + (size_t)t * 128) = pk_f16(h0, h1);
    } else {
      h16x2 acc2[8];
#pragma unroll
      for (int j = 0; j < 8; ++j) acc2[j] = (h16x2){(_Float16)0.f, (_Float16)0.f};
#pragma unroll
      for (int i = 0; i < 16; ++i) {
        const unsigned w4[4] = {gw[gs][i].x, gw[gs][i].y, gw[gs][i].z, gw[gs][i].w}; const unsigned aw = xw[i >> 1]; const h16x2 a2 = __builtin_bit_cast(h16x2, aw);
        const h16x2 aa = (i & 1) ? (h16x2){a2.y, a2.y} : (h16x2){a2.x, a2.x};
#pragma unroll
        for (int d = 0; d < 4; ++d) { const unsigned wd = w4[d]; const h16x2 lo = __builtin_amdgcn_cvt_scalef32_pk_f16_fp8(wd, 1.0f, false), hi = __builtin_amdgcn_cvt_scalef32_pk_f16_fp8(wd, 1.0f, true);
          acc2[2 * d] = lo * aa + acc2[2 * d]; acc2[2 * d + 1] = hi * aa + acc2[2 * d + 1]; }
      }
      float acc[16];
#pragma unroll
      for (int j = 0; j < 8; ++j) { acc[2 * j] = (float)acc2[j].x; acc[2 * j + 1] = (float)acc2[j].y; }
      const bool b3 = (lane & 8) != 0;
      float r8[8], r4[4], r2[2];
#pragma unroll
      for (int c = 0; c < 8; ++c) { const auto sw = __builtin_amdgcn_permlane32_swap(__float_as_uint(acc[c]), __float_as_uint(acc[c + 8]), false, false); r8[c] = __uint_as_float(sw[0]) + __uint_as_float(sw[1]); }
#pragma unroll
      for (int c = 0; c < 4; ++c) { const auto sw = __builtin_amdgcn_permlane16_swap(__float_as_uint(r8[c]), __float_as_uint(r8[c + 4]), false, false); r4[c] = __uint_as_float(sw[0]) + __uint_as_float(sw[1]); }
#pragma unroll
      for (int c = 0; c < 2; ++c) { const float keep = b3 ? r4[c + 2] : r4[c], send = b3 ? r4[c] : r4[c + 2];
        r2[c] = keep + __uint_as_float(__builtin_amdgcn_update_dpp(0, (int)__float_as_uint(send), 0x128, 0xf, 0xf, false)); }
      float* op = OUT + (size_t)t * D_;
      const unsigned xr = xres[gs]; const h16x2 xh = __builtin_bit_cast(h16x2, xr);
      f32x2 o; o[0] = (float)xh.x + r2[0] * (1.0f / V8_SCALE); o[1] = (float)xh.y + r2[1] * (1.0f / V8_SCALE); if (!DRY || o[0] == 123456.789f) *(f32x2*)op = o;
    }
  }
#undef G_META
#undef G_ISSUE
}
template <int SIDE, bool DRY> __device__ __forceinline__ void phase_gather_sliced(const Params& p, unsigned char* smem) {
  const int tid = ptid(), lane = tid & 63, w = __builtin_amdgcn_readfirstlane(tid >> 6);
  volatile LAS int* ql = (volatile LAS int*)((LAS unsigned char*)smem + 131072);
  unsigned* ctrl = (unsigned*)p.ws;
  const int NCH = S_ / (8 * NTOK), QB = SIDE + (DRY ? 2 : 0);
  int x = (int)(xb_xcc_id() & 7u), cur = 0;
  if (tid == 0) ql[0] = (int)__hip_atomic_fetch_add(&ctrl[GQ_WORD(QB, x)], 1u, __ATOMIC_RELAXED, __HIP_MEMORY_SCOPE_AGENT);
  __syncthreads();
  for (;;) {
    const int ch = __builtin_amdgcn_readfirstlane(ql[cur]);
    if (ch < NCH) {
      unsigned nxt = 0u;
      if (tid == 0) nxt = __hip_atomic_fetch_add(&ctrl[GQ_WORD(QB, x)], 1u, __ATOMIC_RELAXED, __HIP_MEMORY_SCOPE_AGENT);
      gather_wave_chunk<SIDE, DRY>(p, ch * 8 * NTOK + w * NTOK, x, lane);
      if (tid == 0) ql[cur ^ 1] = (int)nxt;
      __syncthreads();
      cur ^= 1;
    } else {
      if (tid < 8) ql[8 + tid] = (int)__hip_atomic_load(&ctrl[GQ_WORD(QB, tid)], __ATOMIC_RELAXED, __HIP_MEMORY_SCOPE_AGENT);
      __syncthreads();
      int nx = -1;
#pragma unroll
      for (int s = 7; s >= 1; --s) { const int y = (x + s) & 7; if (__builtin_amdgcn_readfirstlane(ql[8 + y]) < NCH) nx = y; }
      __syncthreads();
      if (nx < 0) break;
      x = nx;
      if (tid == 0) ql[cur] = (int)__hip_atomic_fetch_add(&ctrl[GQ_WORD(QB, x)], 1u, __ATOMIC_RELAXED, __HIP_MEMORY_SCOPE_AGENT);
      __syncthreads();
    }
  }
}
__device__ __forceinline__ f32x4 ld4h(const u16* p) { const uint2 w = *(const uint2*)p; const unsigned a = w.x, b = w.y; const h16x2 lo = __builtin_bit_cast(h16x2, a), hi = __builtin_bit_cast(h16x2, b); return (f32x4){(float)lo.x, (float)lo.y, (float)hi.x, (float)hi.y}; }
__device__ __forceinline__ void phase_areduce(const Params& p) {
  const u16* HP = (const u16*)(p.ws + WS_HP); const float* GW = (const float*)(p.ws + WS_G); const float* SSQ = (const float*)(p.ws + WS_SSQ); u16* A = (u16*)(p.ws + WS_A);
  const int gt = blockIdx.x * 512 + ptid(), GT = gridDim.x * 512, NQ = S_ * 128 / 4;
  for (int b0 = gt; b0 < NQ; b0 += 4 * GT) {
    f32x4 s[4], g[4]; float rq[4];
#pragma unroll
    for (int k = 0; k < 4; ++k) { const int qd = b0 + k * GT < NQ ? b0 + k * GT : b0, i = qd * 4; s[k] = ld4h(HP + i); g[k] = *(const f32x4*)(GW + i); rq[k] = SSQ[i >> 7]; }
#pragma unroll
    for (int x = 1; x < 8; ++x)
#pragma unroll
      for (int k = 0; k < 4; ++k) { const int qd = b0 + k * GT < NQ ? b0 + k * GT : b0; s[k] += ld4h(HP + (size_t)x * S_ * 128 + qd * 4); }
#pragma unroll
    for (int k = 0; k < 4; ++k) { const int qd = b0 + k * GT; if (qd < NQ) { const int i = qd * 4; const float rs = rsqrtf(rq[k] * (1.0f / D_) + 1e-6f) * (1.0f / U8_SCALE);
      uint2 o; o.x = pk_f16(gelu_tanh_f(s[k][0] * rs) * g[k][0], gelu_tanh_f(s[k][1] * rs) * g[k][1]); o.y = pk_f16(gelu_tanh_f(s[k][2] * rs) * g[k][2], gelu_tanh_f(s[k][3] * rs) * g[k][3]);
      *(uint2*)(A + i) = o; } }
  }
}

#define WS_ST16 WS_SQ
#define DO_KV (0 * MB_)
__device__ __forceinline__ s16x8 cat4(s16x4 x, s16x4 y) { return __builtin_shufflevector(x, y, 0, 1, 2, 3, 4, 5, 6, 7); }
__device__ __forceinline__ s16x4 tr32(LAS unsigned char* base, int st, int kb, int nb, int lane) {
  const int q = (lane & 15) >> 2, pp = lane & 3, blk = (lane >> 4) & 1;
  return __builtin_amdgcn_ds_read_tr16_b64_v4i16((LAS s16x4*)(base + (kb + q) * st + (nb + 16 * blk + 4 * pp) * 2));
}
__device__ __forceinline__ s16x4 tr16(LAS unsigned char* base, int st, int kb, int nb, int lane) {
  const int q = (lane & 15) >> 2, pp = lane & 3;
  return __builtin_amdgcn_ds_read_tr16_b64_v4i16((LAS s16x4*)(base + (kb + q) * st + (nb + 4 * pp) * 2));
}
__device__ __forceinline__ void norm16(u32x4 lo, u32x4 hi, int part, const float* __restrict__ gain, float (&a)[8], float (&b)[8]) {
  unpack8_bf16(lo, a); unpack8_bf16(hi, b);
  float ss = 0.f;
#pragma unroll
  for (int i = 0; i < 8; ++i) ss += a[i] * a[i] + b[i] * b[i];
  ss += __shfl_xor(ss, 1); ss += __shfl_xor(ss, 2);
  const float r = rsqrtf(ss * (1.0f / 64.0f) + 1e-6f);
  const f32x4 g0 = *(const f32x4*)(gain + 8 * part), g1 = *(const f32x4*)(gain + 8 * part + 4), g2 = *(const f32x4*)(gain + 32 + 8 * part), g3 = *(const f32x4*)(gain + 36 + 8 * part);
#pragma unroll
  for (int i = 0; i < 4; ++i) { a[i] *= r * g0[i]; a[4 + i] *= r * g1[i]; b[i] *= r * g2[i]; b[4 + i] *= r * g3[i]; }
}
__device__ __forceinline__ void rope16(float (&a)[8], float (&b)[8], const float* __restrict__ rc, const float* __restrict__ rs, int t, int part, float scale) {
  const f32x4 c0 = *(const f32x4*)(rc + t * 32 + 8 * part), c1 = *(const f32x4*)(rc + t * 32 + 8 * part + 4), s0 = *(const f32x4*)(rs + t * 32 + 8 * part), s1 = *(const f32x4*)(rs + t * 32 + 8 * part + 4);
#pragma unroll
  for (int i = 0; i < 8; ++i) { const float c = i < 4 ? c0[i & 3] : c1[i & 3], s = i < 4 ? s0[i & 3] : s1[i & 3]; const float x1 = a[i], x2 = b[i]; a[i] = (x1 * c - x2 * s) * scale; b[i] = (x1 * s + x2 * c) * scale; }
}
__device__ __forceinline__ void store_row16(LAS unsigned char* rowp, int part, const float (&a)[8], const float (&b)[8]) {
  u32x4 wa, wb; wa.x = pk_bf16(a[0], a[1]); wa.y = pk_bf16(a[2], a[3]); wa.z = pk_bf16(a[4], a[5]); wa.w = pk_bf16(a[6], a[7]);
  wb.x = pk_bf16(b[0], b[1]); wb.y = pk_bf16(b[2], b[3]); wb.z = pk_bf16(b[4], b[5]); wb.w = pk_bf16(b[6], b[7]);
  *(LAS u32x4*)(rowp + 16 * part) = wa; *(LAS u32x4*)(rowp + 64 + 16 * part) = wb;
}

struct KvRegs { u32x4 k0, k1, v[4]; };
__device__ __forceinline__ void kv_load(const Params& p, int item, KvRegs& R) {
  const int tid = ptid(), c = item >> 3, h = item & 7, t0 = c * 128;
  const u16* RK = (const u16*)(p.ws + WS_RK); const u16* RV = (const u16*)(p.ws + WS_RV);
  { const int j = tid >> 2, part = tid & 3; const u16* pp = RK + (size_t)(t0 + j) * 512 + h * 64 + part * 8; R.k0 = *(const u32x4*)pp; R.k1 = *(const u32x4*)(pp + 32); }
#pragma unroll
  for (int it = 0; it < 4; ++it) { const int q = tid + 512 * it, row = q >> 4, ch = q & 15; R.v[it] = *(const u32x4*)(RV + (size_t)(t0 + row) * 1024 + h * 128 + ch * 8); }
}
__device__ __forceinline__ void kv_item(const Params& p, LAS unsigned char* lds, int item, u16* __restrict__ KV, const KvRegs& R) {
  const int tid = ptid(), lane = tid & 63, w = __builtin_amdgcn_readfirstlane(tid >> 6), hh = lane >> 5, r = lane & 31;
  const int c = item >> 3, h = item & 7, t0 = c * 128;
  LAS unsigned char* Ks = lds; LAS unsigned char* Vs = lds + 128 * 192;
  const float* RC = (const float*)(p.ws + WS_ROPE_C); const float* RS = (const float*)(p.ws + WS_ROPE_S);
  { const int j = tid >> 2, part = tid & 3, t = t0 + j;
    float a[8], b[8]; norm16(R.k0, R.k1, part, p.ret_k_norm, a, b);
    rope16(a, b, RC, RS, t, part, 0.125f * exp2f((float)(127 - j) * p.l2g[h])); store_row16(Ks + j * 192, part, a, b); }
#pragma unroll
  for (int it = 0; it < 4; ++it) { const int q = tid + 512 * it, row = q >> 4, ch = q & 15; *(LAS u32x4*)(Vs + row * 320 + ch * 16) = R.v[it]; }
  __syncthreads();
  const int mb = w & 1, nb = w >> 1;
  f32x16 acc;
#pragma unroll
  for (int i = 0; i < 16; ++i) acc[i] = 0.f;
#pragma unroll
  for (int ks = 0; ks < 8; ++ks) { const int kb = 16 * ks + 8 * hh;
    const s16x8 af = cat4(tr32(Ks, 192, kb, 32 * mb, lane), tr32(Ks, 192, kb + 4, 32 * mb, lane));
    const s16x8 bf = cat4(tr32(Vs, 320, kb, 32 * nb, lane), tr32(Vs, 320, kb + 4, 32 * nb, lane));
    acc = MFMA32(af, bf, acc); }
  u16* op = KV + ((size_t)(c * 8 + h) * 128 + 32 * nb + r) * 64 + 32 * mb + 4 * hh;
#pragma unroll
  for (int g4 = 0; g4 < 4; ++g4) { uint2 o; o.x = pk_bf16(acc[4 * g4], acc[4 * g4 + 1]); o.y = pk_bf16(acc[4 * g4 + 2], acc[4 * g4 + 3]); *(uint2*)(op + 8 * g4) = o; }
  __syncthreads();
}

__device__ __forceinline__ void phase_scan(const Params& p, unsigned char* smem, const u16* __restrict__ KV) {
  const int tid = ptid(), q = tid & 63, g = tid >> 6;
  f32x4* tot = (f32x4*)smem;
  u16* ST = (u16*)(p.ws + WS_ST16);
  for (int batch = blockIdx.x; batch < 256; batch += gridDim.x) {
    const int q4 = batch * 64 + q, h = q4 >> 11;
    const float cd = exp2f(128.0f * p.l2g[h]);
    f32x4 v[16];
#pragma unroll
    for (int i = 0; i < 16; ++i) { const uint2 w = *(const uint2*)(KV + ((size_t)(16 * g + i) * 16384 + q4) * 4);
      v[i] = (f32x4){__uint_as_float(w.x << 16), __uint_as_float(w.x & 0xffff0000u), __uint_as_float(w.y << 16), __uint_as_float(w.y & 0xffff0000u)}; }
    f32x4 run = (f32x4){0.f, 0.f, 0.f, 0.f};
#pragma unroll
    for (int i = 0; i < 16; ++i) { const f32x4 tmp = v[i]; v[i] = run; run = run * cd + tmp; }
    tot[g * 64 + q] = run;
    __syncthreads();
    float cd16 = cd; cd16 *= cd16; cd16 *= cd16; cd16 *= cd16; cd16 *= cd16;
    f32x4 C = (f32x4){0.f, 0.f, 0.f, 0.f};
    for (int gg = 0; gg < g; ++gg) C = C * cd16 + tot[gg * 64 + q];
    float pw = 1.0f;
#pragma unroll
    for (int i = 0; i < 16; ++i) { const f32x4 s = v[i] + C * pw; pw *= cd;
      uint2 o; o.x = pk_bf16(s[0], s[1]); o.y = pk_bf16(s[2], s[3]); *(uint2*)(ST + ((size_t)(16 * g + i) * 16384 + q4) * 4) = o; }
    __syncthreads();
  }
}

struct RetRegs { u32x4 q0, q1, k0, k1, st[2], v[4], gate[4]; };
__device__ __forceinline__ void retout_load(const Params& p, int item, RetRegs& R) {
  const int tid = ptid(), c = item >> 3, h = item & 7, t0 = c * 128;
  const u16* RQ = (const u16*)(p.ws + WS_RQ); const u16* RK = (const u16*)(p.ws + WS_RK); const u16* RV = (const u16*)(p.ws + WS_RV); const u16* ST = (const u16*)(p.ws + WS_ST16);
  { const int j = tid >> 2, part = tid & 3; const u16* pq = RQ + (size_t)(t0 + j) * 512 + h * 64 + part * 8; R.q0 = *(const u32x4*)pq; R.q1 = *(const u32x4*)(pq + 32);
    const u16* pk = RK + (size_t)(t0 + j) * 512 + h * 64 + part * 8; R.k0 = *(const u32x4*)pk; R.k1 = *(const u32x4*)(pk + 32); }
#pragma unroll
  for (int it = 0; it < 2; ++it) { const int q = tid + 512 * it, row = q >> 3, ch = q & 7; R.st[it] = *(const u32x4*)(ST + ((size_t)(c * 8 + h) * 128 + row) * 64 + ch * 8); }
  { const int lane = tid & 63, w = tid >> 6, ib = w >> 1, eh = w & 1; const u16* RG = (const u16*)(p.ws + WS_RG);
#pragma unroll
    for (int k = 0; k < 4; ++k) R.gate[k] = *(const u32x4*)(RG + (size_t)(t0 + 32 * ib + (lane >> 3) + 8 * k) * 1024 + h * 128 + 64 * eh + 8 * (lane & 7)); }
#pragma unroll
  for (int it = 0; it < 4; ++it) { const int q = tid + 512 * it, row = q >> 4, ch = q & 15; R.v[it] = *(const u32x4*)(RV + (size_t)(t0 + row) * 1024 + h * 128 + ch * 8); }
}
template <bool DRY> __device__ __forceinline__ void retout_item(const Params& p, LAS unsigned char* lds, int item, const RetRegs& R) {
  const int tid = ptid(), lane = tid & 63, w = __builtin_amdgcn_readfirstlane(tid >> 6), hh = lane >> 5, r = lane & 31;
  const int c = item >> 3, h = item & 7, t0 = c * 128;
  LAS unsigned char* Qs = lds; LAS unsigned char* Ks = lds + 18432; LAS unsigned char* STs = lds + 36864; LAS unsigned char* Vs = lds + 55296; LAS f32x2* red = (LAS f32x2*)(lds + 96256);
  u16* RG = (u16*)(p.ws + WS_RG);
  const float* RC = (const float*)(p.ws + WS_ROPE_C); const float* RS = (const float*)(p.ws + WS_ROPE_S);
  const float l2g = p.l2g[h];
  { const int j = tid >> 2, part = tid & 3, t = t0 + j; float a[8], b[8];
    norm16(R.q0, R.q1, part, p.ret_q_norm, a, b); rope16(a, b, RC, RS, t, part, 1.0f); store_row16(Qs + j * 144, part, a, b);
    norm16(R.k0, R.k1, part, p.ret_k_norm, a, b); rope16(a, b, RC, RS, t, part, 0.125f); store_row16(Ks + j * 144, part, a, b); }
#pragma unroll
  for (int it = 0; it < 2; ++it) { const int q = tid + 512 * it, row = q >> 3, ch = q & 7; *(LAS u32x4*)(STs + row * 144 + ch * 16) = R.st[it]; }
#pragma unroll
  for (int it = 0; it < 4; ++it) { const int q = tid + 512 * it, row = q >> 4, ch = q & 15; *(LAS u32x4*)(Vs + row * 320 + ch * 16) = R.v[it]; }
  __syncthreads();
  const int ib = w >> 1, eh = w & 1;
  f32x16 acc[2];
#pragma unroll
  for (int et = 0; et < 2; ++et)
#pragma unroll
    for (int i = 0; i < 16; ++i) acc[et][i] = 0.f;
  s16x8 bq[4];
#pragma unroll
  for (int ks = 0; ks < 4; ++ks) bq[ks] = *(const LAS s16x8*)(Qs + (32 * ib + r) * 144 + (16 * ks + 8 * hh) * 2);
#pragma unroll
  for (int et = 0; et < 2; ++et)
#pragma unroll
    for (int ks = 0; ks < 4; ++ks) { const s16x8 af = *(const LAS s16x8*)(STs + (32 * (2 * eh + et) + r) * 144 + (16 * ks + 8 * hh) * 2); acc[et] = MFMA32(af, bq[ks], acc[et]); }
  { const float qd = exp2f((float)(32 * ib + r + 1) * l2g);
#pragma unroll
    for (int et = 0; et < 2; ++et)
#pragma unroll
      for (int i = 0; i < 16; ++i) acc[et][i] *= qd; }
  float rowdec[16];
#pragma unroll
  for (int i = 0; i < 16; ++i) rowdec[i] = __builtin_amdgcn_exp2f(-(float)((i & 3) + 8 * (i >> 2) + 4 * hh) * l2g);
  for (int jb = 0; jb <= ib; ++jb) {
    f32x16 sc;
#pragma unroll
    for (int i = 0; i < 16; ++i) sc[i] = 0.f;
#pragma unroll
    for (int ks = 0; ks < 4; ++ks) { const s16x8 af = *(const LAS s16x8*)(Ks + (32 * jb + r) * 144 + (16 * ks + 8 * hh) * 2); sc = MFMA32(af, bq[ks], sc); }
    float pv[16];
    const float fcol = __builtin_amdgcn_exp2f((float)(32 * (ib - jb) + r) * l2g);
#pragma unroll
    for (int i = 0; i < 16; ++i) { const int jl = 32 * jb + (i & 3) + 8 * (i >> 2) + 4 * hh, diff = 32 * ib + r - jl; pv[i] = diff >= 0 ? sc[i] * (fcol * rowdec[i]) : 0.f; }
#pragma unroll
    for (int s = 0; s < 2; ++s) {
      u32x4 bw; bw.x = pk_bf16(pv[8 * s], pv[8 * s + 1]); bw.y = pk_bf16(pv[8 * s + 2], pv[8 * s + 3]); bw.z = pk_bf16(pv[8 * s + 4], pv[8 * s + 5]); bw.w = pk_bf16(pv[8 * s + 6], pv[8 * s + 7]);
      const s16x8 bf = __builtin_bit_cast(s16x8, bw);
#pragma unroll
      for (int et = 0; et < 2; ++et) { const int kb = 32 * jb + 16 * s + 4 * hh, nb = 32 * (2 * eh + et);
        const s16x8 af = cat4(tr32(Vs, 320, kb, nb, lane), tr32(Vs, 320, kb + 8, nb, lane)); acc[et] = MFMA32(af, bf, acc[et]); }
    }
  }
  float s1 = 0.f, s2 = 0.f;
#pragma unroll
  for (int et = 0; et < 2; ++et)
#pragma unroll
    for (int i = 0; i < 16; ++i) { const float v = acc[et][i]; s1 += v; s2 += v * v; }
  s1 += __shfl_xor(s1, 32); s2 += __shfl_xor(s2, 32);
  if (hh == 0) red[(32 * ib + r) * 2 + eh] = (f32x2){s1, s2};
  __syncthreads();
  const f32x2 ra = red[(32 * ib + r) * 2], rb = red[(32 * ib + r) * 2 + 1];
  const float mu = (ra.x + rb.x) * (1.0f / 128.0f), var = fmaxf((ra.y + rb.y) * (1.0f / 128.0f) - mu * mu, 0.f), rstd = rsqrtf(var + 1e-6f);
  LAS unsigned char* wt = lds + 98304 + w * 4608;
#pragma unroll
  for (int et = 0; et < 2; ++et)
#pragma unroll
    for (int g4 = 0; g4 < 4; ++g4) { typedef unsigned u32x2_t __attribute__((ext_vector_type(2))); u32x2_t o;
      o.x = pk_bf16((acc[et][4 * g4] - mu) * rstd, (acc[et][4 * g4 + 1] - mu) * rstd); o.y = pk_bf16((acc[et][4 * g4 + 2] - mu) * rstd, (acc[et][4 * g4 + 3] - mu) * rstd);
      *(LAS u32x2_t*)(wt + r * 144 + (32 * et + 8 * g4 + 4 * hh) * 2) = o; }
  { u32x4 yv[4]; f32x4 ga[4], gb[4];
#pragma unroll
    for (int k = 0; k < 4; ++k) { const int row = (lane >> 3) + 8 * k, ch = lane & 7, col = h * 128 + 64 * eh + 8 * ch;
      yv[k] = *(const LAS u32x4*)(wt + row * 144 + ch * 16); ga[k] = *(const f32x4*)(p.ret_gn + col); gb[k] = *(const f32x4*)(p.ret_gn + col + 4); }
#pragma unroll
    for (int k = 0; k < 4; ++k) { const int row = (lane >> 3) + 8 * k, ch = lane & 7, col = h * 128 + 64 * eh + 8 * ch;
      float y[8], g[8]; unpack8_bf16(yv[k], y); unpack8_bf16(R.gate[k], g); f32x4 o0, o1;
#pragma unroll
      for (int i = 0; i < 4; ++i) { o0[i] = y[i] * ga[k][i] * g[i] * sigmoidf_(g[i]); o1[i] = y[4 + i] * gb[k][i] * g[4 + i] * sigmoidf_(g[4 + i]); }
      const u32x4 ov = pack8_bf16(o0, o1); if (!DRY || ov.x == 0x12345678u) *(u32x4*)(RG + (size_t)(t0 + 32 * ib + row) * 1024 + col) = ov; } }
  __syncthreads();
}

__device__ __forceinline__ void sb_item(const Params& p, LAS unsigned char* lds, int item, u16* __restrict__ SB) {
  const int tid = ptid(), lane = tid & 63, w = __builtin_amdgcn_readfirstlane(tid >> 6), g = lane >> 4, lt = lane & 15;
  const int qb = item >> 3, h = item & 7, t0 = qb * 128;
  LAS unsigned char* Qs = lds; LAS unsigned* flags = (LAS unsigned*)(lds + 61440);
  const u16* SQ = (const u16*)(p.ws + WS_SQ); const u16* SK = (const u16*)(p.ws + WS_SK); const u16* SV = (const u16*)(p.ws + WS_SV);
  { const int j = tid >> 2, part = tid & 3, t = t0 + j; float a[8], b[8];
    const u16* pq = SQ + (size_t)t * 512 + h * 64 + part * 8; norm16(*(const u32x4*)pq, *(const u32x4*)(pq + 32), part, p.sb_q_norm, a, b);
#pragma unroll
    for (int i = 0; i < 8; ++i) { a[i] *= 0.18033688011112042f; b[i] *= 0.18033688011112042f; }
    store_row16(Qs + j * 144, part, a, b); }
  u32x4 r0, r1;
  const bool kthr = tid < 256; const int krow = tid >> 2, kpart = tid & 3, vq = tid - 256;
#define SB_LOAD(kt) do { if (kthr) { const u16* pk = SK + (size_t)((kt) * 64 + krow) * 512 + h * 64 + kpart * 8; r0 = *(const u32x4*)pk; r1 = *(const u32x4*)(pk + 32); } \
    else { r0 = *(const u32x4*)(SV + (size_t)((kt) * 64 + (vq >> 3)) * 512 + h * 64 + (vq & 7) * 8); r1 = *(const u32x4*)(SV + (size_t)((kt) * 64 + 32 + (vq >> 3)) * 512 + h * 64 + (vq & 7) * 8); } } while (0)
#define SB_WRITE(buf) do { LAS unsigned char* kb_ = lds + 18432 + (buf) * 21504; if (kthr) { float a[8], b[8]; norm16(r0, r1, kpart, p.sb_k_norm, a, b); store_row16(kb_ + krow * 144, kpart, a, b); } \
    else { *(LAS u32x4*)(kb_ + 9216 + (vq >> 3) * 192 + (vq & 7) * 16) = r0; *(LAS u32x4*)(kb_ + 9216 + (32 + (vq >> 3)) * 192 + (vq & 7) * 16) = r1; } } while (0)
  const int ktmax = 2 * qb + 1;
  SB_LOAD(ktmax); SB_WRITE(0);
  __syncthreads();
  s16x8 qf[2];
#pragma unroll
  for (int ks = 0; ks < 2; ++ks) qf[ks] = *(const LAS s16x8*)(Qs + (16 * w + lt) * 144 + (32 * ks + 8 * g) * 2);
  float carry = 0.f; f32x4 o[4];
#pragma unroll
  for (int et = 0; et < 4; ++et) o[et] = (f32x4){0.f, 0.f, 0.f, 0.f};
  const int tq = t0 + 16 * w + lt;
  for (int kt = ktmax, it = 0; kt >= 0; --kt, ++it) {
    const int buf = it & 1; LAS unsigned char* Ks = lds + 18432 + buf * 21504; LAS unsigned char* Vs = Ks + 9216;
    if (kt > 0) SB_LOAD(kt - 1);
    const bool wskip = (kt * 64 >= t0 + 16 * w + 16) || __all(carry < -150.1f);
    if (!wskip) {
    f32x4 z[4];
#pragma unroll
    for (int a = 0; a < 4; ++a) { z[a] = (f32x4){0.f, 0.f, 0.f, 0.f};
#pragma unroll
      for (int ks = 0; ks < 2; ++ks) { const s16x8 af = *(const LAS s16x8*)(Ks + (16 * a + lt) * 144 + (32 * ks + 8 * g) * 2); z[a] = MFMA16(af, qf[ks], z[a]); } }
    float ls[4][4], zl[4][4], G[4], T[4], suf[4];
    const bool masked = kt * 64 + 64 > t0 + 16 * w;
#pragma unroll
    for (int a = 0; a < 4; ++a) { G[a] = 0.f;
#pragma unroll
      for (int rr = 0; rr < 4; ++rr) { const float zv = z[a][rr];
        const float sp = fmaxf(zv, 0.f) + __builtin_amdgcn_logf(1.0f + __builtin_amdgcn_exp2f(-fabsf(zv)));
        ls[a][rr] = -sp; zl[a][rr] = zv - sp; } }
    if (masked) {
#pragma unroll
      for (int a = 0; a < 4; ++a)
#pragma unroll
        for (int rr = 0; rr < 4; ++rr) { const bool valid = (kt * 64 + 16 * a + 4 * g + rr) < tq; ls[a][rr] = valid ? ls[a][rr] : 0.f; zl[a][rr] = valid ? zl[a][rr] : -1.0e30f; }
    }
#pragma unroll
    for (int a = 0; a < 4; ++a) G[a] = (ls[a][0] + ls[a][1]) + (ls[a][2] + ls[a][3]);
#pragma unroll
    for (int a = 0; a < 4; ++a) { const float x1 = __shfl_xor(G[a], 16), x2 = __shfl_xor(G[a], 32), x3 = __shfl_xor(G[a], 48);
      T[a] = G[a] + x1 + x2 + x3; suf[a] = g == 0 ? (x1 + x2 + x3) : (g == 1 ? (x2 + x3) : (g == 2 ? x1 : 0.f)); }
    float wv[4][4];
    { float after = 0.f;
#pragma unroll
      for (int a = 3; a >= 0; --a) { float base = carry + after + suf[a];
#pragma unroll
        for (int rr = 3; rr >= 0; --rr) { wv[a][rr] = __builtin_amdgcn_exp2f(zl[a][rr] + base); base += ls[a][rr]; }
        after += T[a]; }
      carry += after; }
#pragma unroll
    for (int ap = 0; ap < 2; ++ap) {
      u32x4 bw; bw.x = pk_bf16(wv[2 * ap][0], wv[2 * ap][1]); bw.y = pk_bf16(wv[2 * ap][2], wv[2 * ap][3]); bw.z = pk_bf16(wv[2 * ap + 1][0], wv[2 * ap + 1][1]); bw.w = pk_bf16(wv[2 * ap + 1][2], wv[2 * ap + 1][3]);
      const s16x8 bf = __builtin_bit_cast(s16x8, bw);
#pragma unroll
      for (int et = 0; et < 4; ++et) { const s16x8 af = cat4(tr16(Vs, 192, 32 * ap + 4 * g, 16 * et, lane), tr16(Vs, 192, 32 * ap + 16 + 4 * g, 16 * et, lane)); o[et] = MFMA16(af, bf, o[et]); }
    }
    }
    const bool done = __all(carry < -150.1f);
    if (lane == 0) flags[buf * 8 + w] = done ? 1u : 0u;
    if (kt > 0) SB_WRITE(buf ^ 1);
    __syncthreads();
    if (kt > 0) { unsigned all = 1u;
#pragma unroll
      for (int i = 0; i < 8; ++i) all &= flags[buf * 8 + i];
      if (all) break; }
  }
  { u16* op = SB + (size_t)tq * 512 + h * 64 + 4 * g;
#pragma unroll
    for (int et = 0; et < 4; ++et) { uint2 ov; ov.x = pk_bf16(o[et][0], o[et][1]); ov.y = pk_bf16(o[et][2], o[et][3]); *(uint2*)(op + 16 * et) = ov; } }
  __syncthreads();
#undef SB_LOAD
#undef SB_WRITE
}
__device__ __forceinline__ void phase_mixA(const Params& p, unsigned char* smem, char* dob) {
  LAS unsigned char* lds = (LAS unsigned char*)smem;
  { KvRegs cur, nxt; int item = blockIdx.x; if (item < 1024) kv_load(p, item, cur);
    for (; item < 1024; item += gridDim.x) { const int ni = item + gridDim.x; if (ni < 1024) kv_load(p, ni, nxt); kv_item(p, lds, item, (u16*)(dob + DO_KV), cur); cur = nxt; }
    for (; item < 2048; item += gridDim.x) sb_item(p, lds, item - 1024, (u16*)(dob + DO_SB)); }
}
template <bool DRY> __device__ __forceinline__ void phase_retout(const Params& p, unsigned char* smem) {
  LAS unsigned char* lds = (LAS unsigned char*)smem;
  RetRegs cur, nxt; int item = blockIdx.x; if (item < 1024) retout_load(p, item, cur);
  for (; item < 1024; item += gridDim.x) { const int ni = item + gridDim.x; if (ni < 1024) retout_load(p, ni, nxt); retout_item<DRY>(p, lds, item, cur); cur = nxt; }
}


#define XB_TMO      128
#define XB_XCNT(j)  (256  + 64 * (j))
#define XB_XSUB(j)  (1280 + 64 * (j))
#define XB_XGEN(j)  (2304 + 64 * (j))
#define XB_TOP      3328
#define XB_TOPGEN   3392
#define XCD_BAR_WORDS 3456
#define XB_SPIN_CAP (1u << 22)
__device__ __forceinline__ unsigned xb_ld(unsigned* p)              { return __hip_atomic_load(p, __ATOMIC_RELAXED, __HIP_MEMORY_SCOPE_AGENT); }
__device__ __forceinline__ unsigned xb_add(unsigned* p, unsigned v) { return __hip_atomic_fetch_add(p, v, __ATOMIC_RELAXED, __HIP_MEMORY_SCOPE_AGENT); }
__device__ __forceinline__ unsigned xb_xcc_id() { return (unsigned)__builtin_amdgcn_s_getreg((3 << 11) | 20) & 0xFu; }
#define XB_SPIN(cond, bar) do { unsigned _sp = 0; while (cond) { __builtin_amdgcn_s_sleep(1); \
    if ((++_sp & 255u) == 0u) { if (xb_ld(&(bar)[XB_TMO])) break; if (_sp > XB_SPIN_CAP) { atomicAdd(&(bar)[XB_TMO], 1u); break; } } } } while (0)
struct XcdBarrier { unsigned* bar; unsigned x; volatile LAS unsigned* st; };
__device__ __forceinline__ XcdBarrier xcd_barrier_post(unsigned* bar, volatile LAS unsigned* st) {
  XcdBarrier b; b.bar = bar; b.x = xb_xcc_id(); b.st = st;
  if (ptid() == 0) (void)xb_add(&bar[XB_XCNT(b.x)], 1u);
  return b;
}
__device__ __forceinline__ void xcd_barrier_complete(unsigned* bar, unsigned x, unsigned& nloc, unsigned& nx) {
  const unsigned G = gridDim.x * gridDim.y * gridDim.z;
  unsigned sum, cnt, mine, sp = 0u;
  for (;;) {
    sum = 0u; cnt = 0u; mine = 0u;
#pragma unroll
    for (unsigned j = 0; j < 16; ++j) { const unsigned c = xb_ld(&bar[XB_XCNT(j)]); sum += c; cnt += (c > 0u) ? 1u : 0u; mine = (j == x) ? c : mine; }
    if (sum == G) break;
    __builtin_amdgcn_s_sleep(1);
    if ((++sp & 255u) == 0u) { if (xb_ld(&bar[XB_TMO])) break; if (sp > XB_SPIN_CAP) { atomicAdd(&bar[XB_TMO], 1u); break; } }
  }
  nloc = mine > 0u ? mine : 1u; nx = cnt > 0u ? cnt : 1u;
}
__device__ __forceinline__ void xcd_barrier(const XcdBarrier& b) {
  asm volatile("s_waitcnt vmcnt(0)" ::: "memory");
  __syncthreads();
  if (ptid() == 0) {
    unsigned* bar = b.bar;
    __builtin_amdgcn_s_waitcnt(0);
    unsigned nloc = b.st[0], nx = b.st[1];
    if (nloc == 0u) { xcd_barrier_complete(bar, b.x, nloc, nx); b.st[0] = nloc; b.st[1] = nx; }
    const unsigned old = xb_add(&bar[XB_XSUB(b.x)], 1u);
    const unsigned gen = old / nloc;
    if (old + 1u == (gen + 1u) * nloc) {
      __builtin_amdgcn_fence(__ATOMIC_RELEASE, "agent");
      asm volatile("s_waitcnt vmcnt(0)" ::: "memory");
      const unsigned og = xb_add(&bar[XB_TOP], 1u);
      const unsigned tg = og / nx;
      if (og + 1u == (tg + 1u) * nx) xb_add(&bar[XB_TOPGEN], 1u);
      else XB_SPIN(xb_ld(&bar[XB_TOPGEN]) == tg, bar);
      __builtin_amdgcn_fence(__ATOMIC_ACQUIRE, "agent");
      xb_add(&bar[XB_XGEN(b.x)], 1u);
      asm volatile("s_waitcnt vmcnt(0)" ::: "memory");
    } else {
      XB_SPIN(xb_ld(&bar[XB_XGEN(b.x)]) == gen, bar);
      __builtin_amdgcn_fence(__ATOMIC_ACQUIRE, "agent");
      asm volatile("s_waitcnt vmcnt(0)" ::: "memory");
    }
  }
  __syncthreads();
}

#define LDS_BYTES 147456
#ifndef PROBE_DUP
#define PROBE_DUP -1
#endif
#define LDS_BAR_OFF 147440
__global__ __launch_bounds__(512, 2) void k_mega(Params p) {
  extern __shared__ __attribute__((aligned(16))) unsigned char smem[];
  cg::grid_group grid = cg::this_grid();
  char* dob = (char*)p.out; char* ws = p.ws;
  PG8_LAS unsigned char* lds = (PG8_LAS unsigned char*)smem;
  u16* XN = (u16*)(dob + DO_XN); u16* WINT = (u16*)(dob + DO_WINT); u16* SB = (u16*)(dob + DO_SB); u16* WBRAT = (u16*)(dob + DO_WBRAT); u16* WBRBT = (u16*)(dob + DO_WBRBT);
  u16* WOUTT = (u16*)(ws + WS_WOUTT); u16* WQT = (u16*)(ws + WS_WQT); float* SSQ = (float*)(ws + WS_SSQ);
  u16* RQ = (u16*)(ws + WS_RQ); u16* RK = (u16*)(ws + WS_RK); u16* RV = (u16*)(ws + WS_RV); u16* SQ = (u16*)(ws + WS_SQ); u16* SK = (u16*)(ws + WS_SK);
  u16* SV = (u16*)(ws + WS_SV); u16* RG = (u16*)(ws + WS_RG); u16* GA = (u16*)(ws + WS_GA); u16* GB = (u16*)(ws + WS_GB);
  u16* MIXED = (u16*)(ws + WS_MIXED); u16* X1H = (u16*)(ws + WS_X1H); u16* Q = (u16*)(ws + WS_Q);
  const int G = (int)gridDim.x, c = (int)blockIdx.x;
  volatile LAS unsigned* xst = (volatile LAS unsigned*)((LAS unsigned char*)smem + LDS_BAR_OFF);
  if (ptid() < 4) xst[ptid()] = 0u;
  __syncthreads();
  const XcdBarrier xb = xcd_barrier_post((unsigned*)ws, xst);
  if (p.use_cg) grid.sync();
#define GRID_SYNC() xcd_barrier(xb)
#if PROBE_DUP == 100
  for (int i = 0; i < 10; ++i) GRID_SYNC();
#endif
#if PROBE_DUP == 0
  phase_prologue(p, smem, dob); __syncthreads();
#endif
  phase_prologue(p, smem, dob);
  GRID_SYNC();
#if PROBE_DUP == 1
  { FEpiInProj e{RQ, RK, RV, RG, SQ, SK, SV, GA, GB}; pg8::StaticOrder S; S.init(S_, 6656, G, c); pg8::gemm_phase<false>(lds, pg8::Gemm{XN, WINT, S_, 6656, 1024, 0}, S, e); }
#endif
  { FEpiInProj e{RQ, RK, RV, RG, SQ, SK, SV, GA, GB}; pg8::StaticOrder S; S.init(S_, 6656, G, c); pg8::gemm_phase<false>(lds, pg8::Gemm{XN, WINT, S_, 6656, 1024, 0}, S, e);
    const int rem = S.nwg % G;
    if (rem && c >= rem) conv_table(p, 0, c - rem, G - rem); }
  GRID_SYNC();
#if PROBE_DUP == 2
  phase_mixA(p, smem, dob);
#endif
  phase_mixA(p, smem, dob);
  GRID_SYNC();
#if PROBE_DUP == 3
  phase_scan(p, smem, (const u16*)(dob + DO_KV));
#endif
  phase_scan(p, smem, (const u16*)(dob + DO_KV));
  GRID_SYNC();
#if PROBE_DUP == 4
  phase_retout<true>(p, smem);
#endif
  phase_retout<false>(p, smem);
  GRID_SYNC();
  { const int rem = ((S_ / 256) * (6656 / 256)) % G; if (!rem) conv_table(p, 0, c, G); }
  __syncthreads();
#if PROBE_DUP == 51
  { FEpiMixB e{MIXED, GB}; pg8::StaticOrder S; S.init(S_, 1024, G, c); pg8::gemm_phase<false>(lds, pg8::Gemm{SB, WBRBT, S_, 1024, 512, 0}, S, e); }
  { FEpiMixA e{MIXED, GA}; pg8::StaticOrder S; S.init(S_, 1024, G, c); pg8::gemm_phase<false>(lds, pg8::Gemm{RG, WBRAT, S_, 1024, 1024, 0}, S, e); }
#endif
  { FEpiMixB e0{MIXED, GB}; FEpiMixA e1{MIXED, GA}; pg8::StaticOrder S; S.init(S_, 1024, G, c);
    pg8::gemm_phase2(lds, pg8::Gemm{SB, WBRBT, S_, 1024, 512, 0}, pg8::Gemm{RG, WBRAT, S_, 1024, 1024, 0}, S, e0, e1); }
  GRID_SYNC();
#if PROBE_DUP == 6
  { FEpiOut e{p.x, p.out, X1H, nullptr}; pg8::StaticOrder S; S.init(S_, 1024, G, c); pg8::gemm_phase<false>(lds, pg8::Gemm{MIXED, WOUTT, S_, 1024, 1024, 0}, S, e); }
#endif
  { FEpiOut e{p.x, p.out, X1H, SSQ}; pg8::StaticOrder S; S.init(S_, 1024, G, c); pg8::gemm_phase<false>(lds, pg8::Gemm{MIXED, WOUTT, S_, 1024, 1024, 0}, S, e); }
  GRID_SYNC();
  { FEpiQ e{SSQ, Q}; pg8::StaticOrder S; S.init(S_, 2048, G, c); pg8::gemm_phase<true>(lds, pg8::Gemm{X1H, WQT, S_, 2048, 1024, 0}, S, e);
    __syncthreads();
#if PROBE_DUP == 8
    phase_select(p, smem, S); __syncthreads();
#endif
    phase_select(p, smem, S); }
  GRID_SYNC();
#if PROBE_DUP == 9
  phase_gather_sliced<0, true>(p, smem);
#endif
  phase_gather_sliced<0, false>(p, smem);
  GRID_SYNC();
#if PROBE_DUP == 10
  phase_areduce(p);
#endif
  phase_areduce(p);
  GRID_SYNC();
#if PROBE_DUP == 11
  phase_gather_sliced<1, true>(p, smem);
#endif
  phase_gather_sliced<1, false>(p, smem);
}

extern "C" void kernel_launch(void* const* d_in, const int* in_sizes, int n_in, void* d_out, int out_size, void* d_ws, size_t ws_size, hipStream_t stream) {
  if (ws_size < WS_NEED || n_in != 17) return;
  static int grid_blocks = 0;
  if (!grid_blocks) {
    int dev = 0, cus = 0, per_cu = 0;
    (void)hipGetDevice(&dev);
    (void)hipDeviceGetAttribute(&cus, hipDeviceAttributeMultiprocessorCount, dev);
    (void)hipFuncSetAttribute((const void*)k_mega, hipFuncAttributeMaxDynamicSharedMemorySize, LDS_BYTES);
    (void)hipOccupancyMaxActiveBlocksPerMultiprocessor(&per_cu, (const void*)k_mega, 512, LDS_BYTES);
    if (per_cu < 1) { fprintf(stderr, "k_mega: occupancy query says %d blocks per CU\n", per_cu); grid_blocks = -1; }
    else grid_blocks = cus * per_cu;
  }
  if (grid_blocks < 0) return;
  Params P{};
  P.x = (const float*)d_in[0]; P.norm_attn = (const float*)d_in[1]; P.w_in = (const float*)d_in[2]; P.ret_q_norm = (const float*)d_in[3]; P.ret_k_norm = (const float*)d_in[4];
  P.ret_gn = (const float*)d_in[5]; P.sb_q_norm = (const float*)d_in[6]; P.sb_k_norm = (const float*)d_in[7]; P.w_bra = (const float*)d_in[8]; P.w_brb = (const float*)d_in[9];
  P.w_out = (const float*)d_in[10]; P.norm_ffn = (const float*)d_in[11]; P.w_q = (const float*)d_in[12]; P.sk1 = (const float*)d_in[13]; P.sk2 = (const float*)d_in[14];
  P.peer_u = (const float*)d_in[15]; P.peer_v = (const float*)d_in[16]; P.out = (float*)d_out; P.ws = (char*)d_ws;
  for (int h = 0; h < 8; ++h) P.l2g[h] = (float)log2(1.0 - exp2(-5.0 - (double)h));
  P.use_cg = 0; P.pad = 0;
  (void)hipMemsetAsync(d_ws, 0, 32768, stream);
  void* args[] = {&P};
  hipError_t e = hipLaunchCooperativeKernel((const void*)k_mega, dim3(grid_blocks), dim3(512), args, LDS_BYTES, stream);
  if (e != hipSuccess) fprintf(stderr, "cooperative launch failed: %s (grid %d)\n", hipGetErrorString(e), grid_blocks);
}
```

```cpp
#include <utility>
#include <hip/hip_runtime.h>
#include <hip/hip_cooperative_groups.h>
#include <stdint.h>
#include <cstdio>
#include <cmath>
namespace cg = cooperative_groups;

typedef unsigned short u16;
#define S_ 16384
#define D_ 1024
#define MB_ ((size_t)1 << 20)

#define WS_WOUTT (1 * MB_)
#define WS_WQT (3 * MB_)
#define WS_K1 (7 * MB_)
#define WS_K2 (7 * MB_ + 65536)
#define WS_ROPE_C (8 * MB_)
#define WS_ROPE_S (10 * MB_)
#define WS_SSQ (12 * MB_)
#define WS_RQ (16 * MB_)
#define WS_RK (32 * MB_)
#define WS_RV (48 * MB_)
#define WS_SQ (80 * MB_)
#define WS_SK (96 * MB_)
#define WS_SV (112 * MB_)
#define WS_RG (128 * MB_)
#define WS_GA (160 * MB_)
#define WS_GB (192 * MB_)
#define WS_IDX (224 * MB_)
#define WS_G (232 * MB_)
#define WS_IDXT (228 * MB_)
#define WS_NEED (256 * MB_)
#define WS_U16 WS_RQ
#define WS_V16 WS_RV
#define WS_MIXED WS_SQ
#define WS_X1H WS_RG
#define WS_Q WS_GA
#define DO_XN (0 * MB_)
#define DO_W8T (36 * MB_)
#define DO_XN8 (44 * MB_)
#define W8_SCALE 32.0f
#define DO_WINT (32 * MB_)
#define DO_SB (32 * MB_)
#define DO_WBRAT (60 * MB_)
#define DO_WBRBT (62 * MB_)

__device__ __forceinline__ int ptid() { int t = (int)threadIdx.x; asm volatile("" : "+v"(t)); return t; }
__device__ __forceinline__ u16 f2bf(float f) { unsigned u = __float_as_uint(f); u += 0x7FFFu + ((u >> 16) & 1u); return (u16)(u >> 16); }
__device__ __forceinline__ float bf2f(u16 b) { return __uint_as_float(((unsigned)b) << 16); }
__device__ __forceinline__ u16 f2h(float f) { _Float16 h = (_Float16)f; return *(u16*)&h; }
__device__ __forceinline__ float h2f(u16 b) { _Float16 h = *(_Float16*)&b; return (float)h; }
template <bool F16> __device__ __forceinline__ float ld16(const u16* p) { return F16 ? h2f(*p) : bf2f(*p); }
__device__ __forceinline__ float sigmoidf_(float x) { return 1.0f / (1.0f + __expf(-x)); }

namespace pg8 {
#define PG8_LAS __attribute__((address_space(3)))
typedef short bf16x8 __attribute__((ext_vector_type(8)));
typedef _Float16 f16x8 __attribute__((ext_vector_type(8)));
typedef float f32x4 __attribute__((ext_vector_type(4)));
typedef unsigned u32x4 __attribute__((ext_vector_type(4)));
constexpr int BM = 256, BK = 64, HALF = 128, HTB = HALF * BK * 2, STAGE_BYTES = 8 * HTB, NXCD = 8, WGM = 4;
__host__ __device__ __forceinline__ int lds_byte(int r, int c) { const int st = (r >> 4) * 2 + (c >> 5), rr = r & 15, cc = c & 31, ob = rr * 64 + cc * 2; return st * 1024 + (ob ^ (((ob >> 9) & 1) << 5)); }
__host__ __device__ __forceinline__ void stage_rc(int b, int& R, int& C) { const int st = b / 1024, sb = b % 1024, swz = sb ^ (((sb >> 9) & 1) << 5); R = (st >> 1) * 16 + swz / 64; C = (st & 1) * 32 + (swz % 64) / 2; }
__host__ __device__ __forceinline__ int perm32(int rho) { const int n = rho >> 4, i = rho & 15; return 8 * (i >> 2) + 4 * n + (i & 3); }
struct Unit { int pm, pn; };
struct Gemm { const u16* A; const u16* Bt; int M, N, K, pad; };
struct StaticOrder {
  int nM, nN, nwg, G, c;
  __host__ __device__ void init(int M, int N, int G_, int c_) { nM = M / BM; nN = N / BM; nwg = nM * nN; G = G_; c = c_; }
  __host__ __device__ bool next(int i, Unit& u) const {
    const long L = (long)i * G + c; if (L >= nwg) return false;
    int wgid = (int)L; { const int q = nwg / NXCD, r = nwg % NXCD, xcd = wgid % NXCD, off = wgid / NXCD; wgid = (xcd < r ? xcd * (q + 1) : r * (q + 1) + (xcd - r) * q) + off; }
    const int nig = WGM * nN, gid = wgid / nig, fm = gid * WGM, gsz = (nM - fm) < WGM ? (nM - fm) : WGM;
    u.pm = fm + ((wgid % nig) % gsz); u.pn = (wgid % nig) / gsz; return true;
  }
};
__device__ __forceinline__ unsigned cvt_pk_bf16(float lo, float hi) { unsigned r; asm volatile("v_cvt_pk_bf16_f32 %0, %1, %2" : "=v"(r) : "v"(lo), "v"(hi)); return r; }
__device__ __forceinline__ unsigned cvt_pk_f16(float lo, float hi) { typedef _Float16 h2 __attribute__((ext_vector_type(2))); h2 v; v.x = (_Float16)lo; v.y = (_Float16)hi; return __builtin_bit_cast(unsigned, v); }

struct RangeOrder { int first, count, nM;
  __host__ __device__ bool next(int i, Unit& u) const { if (i >= count) return false; const int L = first + i; u.pn = L / nM; u.pm = L % nM; return true; } };
typedef int v4i_t __attribute__((ext_vector_type(4)));
typedef int v8i_t __attribute__((ext_vector_type(8)));
__device__ __forceinline__ v8i_t cat8i(bf16x8 a, bf16x8 b) { return __builtin_shufflevector(__builtin_bit_cast(v4i_t, a), __builtin_bit_cast(v4i_t, b), 0, 1, 2, 3, 4, 5, 6, 7); }
template <int MODE, class Epi, class Sched>
__device__ __forceinline__ void gemm_phase(PG8_LAS unsigned char* lds, const Gemm g, const Sched& S, const Epi& E) {
  const int tid = ptid(), wid = __builtin_amdgcn_readfirstlane(tid >> 6), lane = tid & 63, wr = wid >> 2, wc = wid & 3, fr = lane & 15, fq = lane >> 4;
  const int K = g.K, nt = K / BK;
  unsigned voffA[2], voffB[2];
#pragma unroll
  for (int i = 0; i < 2; ++i) { int R, C; stage_rc(tid * 16 + i * 8192, R, C); const int Rb = ((R & ~31) + perm32(R & 31));
    voffA[i] = (unsigned)(R * K + C) * 2u; voffB[i] = (unsigned)(Rb * K + C) * 2u; }
  const size_t kstep = (size_t)(BK * 2);
  const size_t hstep = (size_t)HALF * K * 2;
  const size_t tstep = 2 * hstep;
  const unsigned ldsw = (unsigned)wid * 1024u;
  const int aoff = lds_byte(wr * 64 + fr, fq * 8), boff = lds_byte(wc * 32 + fr, fq * 8);
#define PG8_SA(b, h) (((b) * 2 + (h)) * HTB)
#define PG8_SB(b, h) ((4 + (b) * 2 + (h)) * HTB)
#define PG8_STAGE(bufoff, gbase, voff) do { _Pragma("unroll") for (int _i = 0; _i < 2; ++_i) \
    __builtin_amdgcn_global_load_lds((const unsigned*)((const char*)(gbase) + (voff)[_i]), (PG8_LAS unsigned*)(lds + (bufoff) + ldsw + _i * 8192), 16, 0, 0); } while (0)
#define PG8_LDA(dst, b, h) do { _Pragma("unroll") for (int m = 0; m < 4; ++m) _Pragma("unroll") for (int k = 0; k < 2; ++k) { const bf16x8 x_ = *(const PG8_LAS bf16x8*)(lds + PG8_SA(b, h) + aoff + m * 2048 + k * 1024); \
    if constexpr (MODE == 2) { if (k == 0) dst##8[m].lo = __builtin_bit_cast(v4i_t, x_); else dst##8[m].hi = __builtin_bit_cast(v4i_t, x_); } else dst[m][k] = x_; } } while (0)
#define PG8_LDB(dst, b, h) do { _Pragma("unroll") for (int n = 0; n < 2; ++n) _Pragma("unroll") for (int k = 0; k < 2; ++k) { const bf16x8 x_ = *(const PG8_LAS bf16x8*)(lds + PG8_SB(b, h) + boff + n * 2048 + k * 1024); \
    if constexpr (MODE == 2) { if (k == 0) dst##8[n].lo = __builtin_bit_cast(v4i_t, x_); else dst##8[n].hi = __builtin_bit_cast(v4i_t, x_); } else dst[n][k] = x_; } } while (0)
#define PG8_MMA(ai, bj, At, Bt) do { __builtin_amdgcn_s_setprio(1); _Pragma("unroll") for (int m = 0; m < 4; ++m) _Pragma("unroll") for (int n = 0; n < 2; ++n) { \
    if constexpr (MODE == 2) asm volatile("v_mfma_scale_f32_16x16x128_f8f6f4 %0, %1, %2, %0, %3, %4 op_sel_hi:[0,0,0]" : "+v"(acc[ai][bj][m][n]) : "v"(Bt##8[n]), "v"(At##8[m]), "v"(mxscalew), "v"(mxscale));   \
    else _Pragma("unroll") for (int k = 0; k < 2; ++k) { \
    if constexpr (MODE == 1) acc[ai][bj][m][n] = __builtin_amdgcn_mfma_f32_16x16x32_f16(__builtin_bit_cast(f16x8, Bt[n][k]), __builtin_bit_cast(f16x8, At[m][k]), acc[ai][bj][m][n], 0, 0, 0); \
    else acc[ai][bj][m][n] = __builtin_amdgcn_mfma_f32_16x16x32_bf16(Bt[n][k], At[m][k], acc[ai][bj][m][n], 0, 0, 0); } } __builtin_amdgcn_s_setprio(0); } while (0)
#define PG8_WAIT_V(n) asm volatile("s_waitcnt vmcnt(" #n ")" ::: "memory")
#define PG8_WAIT_L(n) asm volatile("s_waitcnt lgkmcnt(" #n ")" ::: "memory")
#define PG8_BAR __builtin_amdgcn_s_barrier()
#define PG8_SCHED __builtin_amdgcn_sched_barrier(0)
  Unit cur, nxt; int ui = 0;
  if (!S.next(0, cur)) return;
  f32x4 acc[2][2][4][2];
#pragma unroll
  for (int a = 0; a < 2; ++a)
#pragma unroll
    for (int b = 0; b < 2; ++b)
#pragma unroll
      for (int m = 0; m < 4; ++m)
#pragma unroll
        for (int n = 0; n < 2; ++n) acc[a][b][m][n] = (f32x4){0.f, 0.f, 0.f, 0.f};
  const int mxscale = 0x7F7F7F7F, mxscalew = 0x7A7A7A7A;
  bf16x8 At[4][2], B0[2][2], B1[2][2]; v8i_t At8[4], B08[2], B18[2];
  const char* cA = (const char*)g.A + (size_t)cur.pm * tstep; const char* cB = (const char*)g.Bt + (size_t)cur.pn * tstep;
  PG8_STAGE(PG8_SB(0, 0), cB, voffB); PG8_STAGE(PG8_SA(0, 0), cA, voffA); PG8_STAGE(PG8_SB(0, 1), cB + hstep, voffB); PG8_STAGE(PG8_SA(0, 1), cA + hstep, voffA);
  if (wr == 1) PG8_BAR;
  PG8_WAIT_V(4); PG8_BAR;
  PG8_STAGE(PG8_SB(1, 0), cB + kstep, voffB); PG8_STAGE(PG8_SA(1, 0), cA + kstep, voffA); PG8_STAGE(PG8_SB(1, 1), cB + hstep + kstep, voffB);
  PG8_WAIT_V(6); PG8_BAR;
  for (;;) {
    const bool has_next = S.next(ui + 1, nxt);
    const char* nA = has_next ? (const char*)g.A + (size_t)nxt.pm * tstep : cA; const char* nB = has_next ? (const char*)g.Bt + (size_t)nxt.pn * tstep : cB;
    for (int t = 0; t < nt; t += 2) {
      const bool last = (t == nt - 2);
      const char* a1 = cA + (size_t)(t + 1) * kstep;
      const char* a2 = last ? nA : cA + (size_t)(t + 2) * kstep; const char* b2 = last ? nB : cB + (size_t)(t + 2) * kstep;
      const char* a3 = a2 + kstep; const char* b3 = b2 + kstep;
      PG8_LDB(B0, 0, 0); PG8_SCHED; PG8_LDA(At, 0, 0); PG8_STAGE(PG8_SA(1, 1), a1 + hstep, voffA);
      PG8_WAIT_L(8); PG8_BAR; PG8_WAIT_L(0); PG8_MMA(0, 0, At, B0); PG8_BAR; PG8_SCHED;
      PG8_LDB(B1, 0, 1); PG8_STAGE(PG8_SB(0, 0), b2, voffB);
      PG8_BAR; PG8_WAIT_L(0); PG8_MMA(0, 1, At, B1); PG8_BAR;
      PG8_LDA(At, 0, 1); PG8_STAGE(PG8_SA(0, 0), a2, voffA);
      PG8_BAR; PG8_WAIT_L(0); PG8_MMA(1, 0, At, B0); PG8_BAR; PG8_SCHED;
      PG8_STAGE(PG8_SB(0, 1), b2 + hstep, voffB);
      PG8_WAIT_V(6); PG8_BAR; PG8_MMA(1, 1, At, B1); PG8_BAR;
      PG8_LDB(B0, 1, 0); PG8_SCHED; PG8_LDA(At, 1, 0); PG8_STAGE(PG8_SA(0, 1), a2 + hstep, voffA);
      PG8_WAIT_L(8); PG8_BAR; PG8_WAIT_L(0); PG8_MMA(0, 0, At, B0); PG8_BAR; PG8_SCHED;
      PG8_LDB(B1, 1, 1); PG8_STAGE(PG8_SB(1, 0), b3, voffB);
      PG8_BAR; PG8_WAIT_L(0); PG8_MMA(0, 1, At, B1); PG8_BAR;
      PG8_LDA(At, 1, 1); PG8_STAGE(PG8_SA(1, 0), a3, voffA);
      PG8_BAR; PG8_WAIT_L(0); PG8_MMA(1, 0, At, B0); PG8_BAR; PG8_SCHED;
      PG8_STAGE(PG8_SB(1, 1), b3 + hstep, voffB);
      PG8_WAIT_V(6); PG8_BAR; PG8_MMA(1, 1, At, B1); PG8_BAR;
    }
    E(acc, cur, wr, wc, fr, fq);
    if (!has_next) break;
#pragma unroll
    for (int a = 0; a < 2; ++a)
#pragma unroll
      for (int b = 0; b < 2; ++b)
#pragma unroll
        for (int m = 0; m < 4; ++m)
#pragma unroll
          for (int n = 0; n < 2; ++n) acc[a][b][m][n] = (f32x4){0.f, 0.f, 0.f, 0.f};
    cur = nxt; cA = nA; cB = nB; ++ui;
  }
  PG8_WAIT_V(0);
  if (wr == 0) PG8_BAR;
  PG8_BAR;
#undef PG8_SA
#undef PG8_SB
#undef PG8_STAGE
#undef PG8_LDA
#undef PG8_LDB
#undef PG8_MMA
#undef PG8_WAIT_V
#undef PG8_WAIT_L
#undef PG8_BAR
#undef PG8_SCHED
}

template <class Epi0, class Epi1>
__device__ __forceinline__ void gemm_phase2(PG8_LAS unsigned char* lds, const Gemm g0, const Gemm g1, const StaticOrder& S, const Epi0& E0, const Epi1& E1) {
  const int tid = ptid(), wid = __builtin_amdgcn_readfirstlane(tid >> 6), lane = tid & 63, wr = wid >> 2, wc = wid & 3, fr = lane & 15, fq = lane >> 4;
  unsigned rA2[2], rB2[2], c2[2];
#pragma unroll
  for (int i = 0; i < 2; ++i) { int R, C; stage_rc(tid * 16 + i * 8192, R, C); rA2[i] = 2u * (unsigned)R; rB2[i] = 2u * (unsigned)((R & ~31) + perm32(R & 31)); c2[i] = 2u * (unsigned)C; }
  const size_t kstep = (size_t)(BK * 2);
  const unsigned ldsw = (unsigned)wid * 1024u;
  const int aoff = lds_byte(wr * 64 + fr, fq * 8), boff = lds_byte(wc * 32 + fr, fq * 8);
#define PG8_SA(b, h) (((b) * 2 + (h)) * HTB)
#define PG8_SB(b, h) ((4 + (b) * 2 + (h)) * HTB)
#define PG8_STAGE2(bufoff, gbase, r2, kk) do { \
    __builtin_amdgcn_global_load_lds((const unsigned*)((const char*)(gbase) + ((r2)[0] * (unsigned)(kk) + c2[0])), (PG8_LAS unsigned*)(lds + (bufoff) + ldsw), 16, 0, 0); \
    __builtin_amdgcn_global_load_lds((const unsigned*)((const char*)(gbase) + ((r2)[1] * (unsigned)(kk) + c2[1])), (PG8_LAS unsigned*)(lds + (bufoff) + ldsw + 8192), 16, 0, 0); } while (0)
#define PG8_LDA(dst, b, h) do { _Pragma("unroll") for (int m = 0; m < 4; ++m) _Pragma("unroll") for (int k = 0; k < 2; ++k) dst[m][k] = *(const PG8_LAS bf16x8*)(lds + PG8_SA(b, h) + aoff + m * 2048 + k * 1024); } while (0)
#define PG8_LDB(dst, b, h) do { _Pragma("unroll") for (int n = 0; n < 2; ++n) _Pragma("unroll") for (int k = 0; k < 2; ++k) dst[n][k] = *(const PG8_LAS bf16x8*)(lds + PG8_SB(b, h) + boff + n * 2048 + k * 1024); } while (0)
#define PG8_MMA(ai, bj, At, Bt) do { __builtin_amdgcn_s_setprio(1); _Pragma("unroll") for (int m = 0; m < 4; ++m) _Pragma("unroll") for (int n = 0; n < 2; ++n) _Pragma("unroll") for (int k = 0; k < 2; ++k) \
    acc[ai][bj][m][n] = __builtin_amdgcn_mfma_f32_16x16x32_bf16(Bt[n][k], At[m][k], acc[ai][bj][m][n], 0, 0, 0); __builtin_amdgcn_s_setprio(0); } while (0)
#define PG8_WAIT_V(n) asm volatile("s_waitcnt vmcnt(" #n ")" ::: "memory")
#define PG8_WAIT_L(n) asm volatile("s_waitcnt lgkmcnt(" #n ")" ::: "memory")
#define PG8_BAR __builtin_amdgcn_s_barrier()
#define PG8_SCHED __builtin_amdgcn_sched_barrier(0)
  Unit cur, nxtu; int ui = 0, which = 0;
  if (!S.next(0, cur)) return;
  f32x4 acc[2][2][4][2];
#pragma unroll
  for (int a = 0; a < 2; ++a)
#pragma unroll
    for (int b = 0; b < 2; ++b)
#pragma unroll
      for (int m = 0; m < 4; ++m)
#pragma unroll
        for (int n = 0; n < 2; ++n) acc[a][b][m][n] = (f32x4){0.f, 0.f, 0.f, 0.f};
  bf16x8 At[4][2], B0[2][2], B1[2][2];
  int K = g0.K; size_t hstep = (size_t)HALF * K * 2;
  const char* cA = (const char*)g0.A + (size_t)cur.pm * 2 * hstep; const char* cB = (const char*)g0.Bt + (size_t)cur.pn * 2 * hstep;
  PG8_STAGE2(PG8_SB(0, 0), cB, rB2, K); PG8_STAGE2(PG8_SA(0, 0), cA, rA2, K); PG8_STAGE2(PG8_SB(0, 1), cB + hstep, rB2, K); PG8_STAGE2(PG8_SA(0, 1), cA + hstep, rA2, K);
  if (wr == 1) PG8_BAR;
  PG8_WAIT_V(4); PG8_BAR;
  PG8_STAGE2(PG8_SB(1, 0), cB + kstep, rB2, K); PG8_STAGE2(PG8_SA(1, 0), cA + kstep, rA2, K); PG8_STAGE2(PG8_SB(1, 1), cB + hstep + kstep, rB2, K);
  PG8_WAIT_V(6); PG8_BAR;
  for (;;) {
    bool has_next; int nwhich; Unit nu = cur;
    if (which == 0) { has_next = true; nwhich = 1; } else { has_next = S.next(ui + 1, nxtu); nwhich = 0; if (has_next) nu = nxtu; }
    const u16* gnA = nwhich ? g1.A : g0.A; const u16* gnB = nwhich ? g1.Bt : g0.Bt; const int gnK = nwhich ? g1.K : g0.K;
    const int nK = has_next ? gnK : K; const size_t nhstep = (size_t)HALF * nK * 2;
    const char* nA = has_next ? (const char*)gnA + (size_t)nu.pm * 2 * nhstep : cA; const char* nB = has_next ? (const char*)gnB + (size_t)nu.pn * 2 * nhstep : cB;
    const int nt = K / BK;
    for (int t = 0; t < nt; t += 2) {
      const bool last = (t == nt - 2);
      const char* a1 = cA + (size_t)(t + 1) * kstep;
      const char* a2 = last ? nA : cA + (size_t)(t + 2) * kstep; const char* b2 = last ? nB : cB + (size_t)(t + 2) * kstep;
      const char* a3 = a2 + kstep; const char* b3 = b2 + kstep;
      const size_t h2 = last ? nhstep : hstep;
      const int K2 = last ? nK : K;
      PG8_LDB(B0, 0, 0); PG8_SCHED; PG8_LDA(At, 0, 0); PG8_STAGE2(PG8_SA(1, 1), a1 + hstep, rA2, K);
      PG8_WAIT_L(8); PG8_BAR; PG8_WAIT_L(0); PG8_MMA(0, 0, At, B0); PG8_BAR; PG8_SCHED;
      PG8_LDB(B1, 0, 1); PG8_STAGE2(PG8_SB(0, 0), b2, rB2, K2);
      PG8_BAR; PG8_WAIT_L(0); PG8_MMA(0, 1, At, B1); PG8_BAR;
      PG8_LDA(At, 0, 1); PG8_STAGE2(PG8_SA(0, 0), a2, rA2, K2);
      PG8_BAR; PG8_WAIT_L(0); PG8_MMA(1, 0, At, B0); PG8_BAR; PG8_SCHED;
      PG8_STAGE2(PG8_SB(0, 1), b2 + h2, rB2, K2);
      PG8_WAIT_V(6); PG8_BAR; PG8_MMA(1, 1, At, B1); PG8_BAR;
      PG8_LDB(B0, 1, 0); PG8_SCHED; PG8_LDA(At, 1, 0); PG8_STAGE2(PG8_SA(0, 1), a2 + h2, rA2, K2);
      PG8_WAIT_L(8); PG8_BAR; PG8_WAIT_L(0); PG8_MMA(0, 0, At, B0); PG8_BAR; PG8_SCHED;
      PG8_LDB(B1, 1, 1); PG8_STAGE2(PG8_SB(1, 0), b3, rB2, K2);
      PG8_BAR; PG8_WAIT_L(0); PG8_MMA(0, 1, At, B1); PG8_BAR;
      PG8_LDA(At, 1, 1); PG8_STAGE2(PG8_SA(1, 0), a3, rA2, K2);
      PG8_BAR; PG8_WAIT_L(0); PG8_MMA(1, 0, At, B0); PG8_BAR; PG8_SCHED;
      PG8_STAGE2(PG8_SB(1, 1), b3 + h2, rB2, K2);
      PG8_WAIT_V(6); PG8_BAR; PG8_MMA(1, 1, At, B1); PG8_BAR;
    }
    if (which == 0) E0(acc, cur, wr, wc, fr, fq); else E1(acc, cur, wr, wc, fr, fq);
    if (!has_next) break;
#pragma unroll
    for (int a = 0; a < 2; ++a)
#pragma unroll
      for (int b = 0; b < 2; ++b)
#pragma unroll
        for (int m = 0; m < 4; ++m)
#pragma unroll
          for (int n = 0; n < 2; ++n) acc[a][b][m][n] = (f32x4){0.f, 0.f, 0.f, 0.f};
    if (which == 1) { cur = nu; ++ui; }
    which = nwhich; K = nK; hstep = nhstep; cA = nA; cB = nB;
  }
  PG8_WAIT_V(0);
  if (wr == 0) PG8_BAR;
  PG8_BAR;
#undef PG8_SA
#undef PG8_SB
#undef PG8_STAGE2
#undef PG8_LDA
#undef PG8_LDB
#undef PG8_MMA
#undef PG8_WAIT_V
#undef PG8_WAIT_L
#undef PG8_BAR
#undef PG8_SCHED
}
}

typedef pg8::f32x4 f32x4; typedef pg8::u32x4 u32x4;
template <class F> __device__ __forceinline__ void epi_walk(const f32x4 (&acc)[2][2][4][2], const pg8::Unit& u, int wr, int wc, int fr, int fq, F&& f) {
  const int row0 = u.pm * 256 + wr * 64 + fr, col0 = u.pn * 256 + wc * 32 + 8 * fq;
#pragma unroll
  for (int ai = 0; ai < 2; ++ai)
#pragma unroll
    for (int m = 0; m < 4; ++m)
#pragma unroll
      for (int bj = 0; bj < 2; ++bj) f(row0 + ai * 128 + m * 16, col0 + bj * 128, acc[ai][bj][m][0], acc[ai][bj][m][1]);
}
__device__ __forceinline__ u32x4 pack8_bf16(f32x4 v0, f32x4 v1) { u32x4 w; w.x = pg8::cvt_pk_bf16(v0[0], v0[1]); w.y = pg8::cvt_pk_bf16(v0[2], v0[3]); w.z = pg8::cvt_pk_bf16(v1[0], v1[1]); w.w = pg8::cvt_pk_bf16(v1[2], v1[3]); return w; }
__device__ __forceinline__ u32x4 pack8_f16(f32x4 v0, f32x4 v1) { u32x4 w; w.x = pg8::cvt_pk_f16(v0[0], v0[1]); w.y = pg8::cvt_pk_f16(v0[2], v0[3]); w.z = pg8::cvt_pk_f16(v1[0], v1[1]); w.w = pg8::cvt_pk_f16(v1[2], v1[3]); return w; }
__device__ __forceinline__ void unpack8_bf16(u32x4 w, float (&f)[8]) {
  f[0] = __uint_as_float(w.x << 16); f[1] = __uint_as_float(w.x & 0xffff0000u); f[2] = __uint_as_float(w.y << 16); f[3] = __uint_as_float(w.y & 0xffff0000u);
  f[4] = __uint_as_float(w.z << 16); f[5] = __uint_as_float(w.z & 0xffff0000u); f[6] = __uint_as_float(w.w << 16); f[7] = __uint_as_float(w.w & 0xffff0000u); }

typedef unsigned u32x2v __attribute__((ext_vector_type(2)));
__device__ __forceinline__ u32x2v pack8_fp8(f32x4 v0, f32x4 v1) { int a = 0, b = 0;
  a = __builtin_amdgcn_cvt_pk_fp8_f32(v0[0], v0[1], a, false); a = __builtin_amdgcn_cvt_pk_fp8_f32(v0[2], v0[3], a, true);
  b = __builtin_amdgcn_cvt_pk_fp8_f32(v1[0], v1[1], b, false); b = __builtin_amdgcn_cvt_pk_fp8_f32(v1[2], v1[3], b, true);
  u32x2v r; r.x = (unsigned)a; r.y = (unsigned)b; return r; }
__device__ __forceinline__ void unpack8_fp8(u32x2v w, float (&f)[8]) { const int a = (int)w.x, b = (int)w.y;
  const auto p0 = __builtin_amdgcn_cvt_pk_f32_fp8(a, false), p1 = __builtin_amdgcn_cvt_pk_f32_fp8(a, true), p2 = __builtin_amdgcn_cvt_pk_f32_fp8(b, false), p3 = __builtin_amdgcn_cvt_pk_f32_fp8(b, true);
  f[0] = p0[0]; f[1] = p0[1]; f[2] = p1[0]; f[3] = p1[1]; f[4] = p2[0]; f[5] = p2[1]; f[6] = p3[0]; f[7] = p3[1]; }
struct FEpiInProj {
  u16 *rq, *rk, *rv, *rg, *sq, *sk, *sv, *ga, *gb;
  __device__ __forceinline__ void operator()(const f32x4 (&acc)[2][2][4][2], const pg8::Unit& u, int wr, int wc, int fr, int fq) const {
    const int c = u.pn * 256; u16* b; int ld, c0;
    if (c < 512) { b = rq; ld = 512; c0 = 0; } else if (c < 1024) { b = rk; ld = 512; c0 = 512; } else if (c < 2048) { b = rv; ld = 1024; c0 = 1024; }
    else if (c < 3072) { b = rg; ld = 1024; c0 = 2048; } else if (c < 3584) { b = sq; ld = 512; c0 = 3072; } else if (c < 4096) { b = sk; ld = 512; c0 = 3584; }
    else if (c < 4608) { b = sv; ld = 512; c0 = 4096; } else if (c < 5632) { b = ga; ld = 1024; c0 = 4608; } else { b = gb; ld = 1024; c0 = 5632; }
    if (c >= 4608) {
      unsigned char* g8 = (unsigned char*)b;
      epi_walk(acc, u, wr, wc, fr, fq, [&](int row, int col, f32x4 v0, f32x4 v1) { *(u32x2v*)(g8 + (size_t)row * 1024 + (col - c0)) = pack8_fp8(v0, v1); });
    } else
    epi_walk(acc, u, wr, wc, fr, fq, [&](int row, int col, f32x4 v0, f32x4 v1) { *(u32x4*)(b + (size_t)row * ld + (col - c0)) = pack8_bf16(v0, v1); });
  }
};
__device__ __forceinline__ size_t gate_frag_off(int pm, int pnl, int wr, int wc, int ai, int m, int bj, int lane) {
  return ((((size_t)(pm * 4 + pnl) * 8 + (wr * 4 + wc)) * 16 + ((ai * 4 + m) * 2 + bj)) * 64 + lane) * 8;
}
struct FEpiQK { char* ws;
  __device__ __forceinline__ void operator()(const f32x4 (&acc)[2][2][4][2], const pg8::Unit& u, int wr, int wc, int fr, int fq) const {
    const int c = u.pn * 256, c0 = c & ~511; const size_t off = c < 512 ? (size_t)WS_RQ : (c < 1024 ? (size_t)WS_RK : (c < 1536 ? (size_t)WS_SQ : (size_t)WS_SK));
    u16* b = (u16*)(ws + off);
    epi_walk(acc, u, wr, wc, fr, fq, [&](int row, int col, f32x4 v0, f32x4 v1) { *(u32x4*)(b + (size_t)row * 512 + (col - c0)) = pack8_bf16(v0, v1); });
  }
};
struct FEpiMX { char* ws;
  __device__ __forceinline__ void operator()(const f32x4 (&acc)[2][2][4][2], const pg8::Unit& u, int wr, int wc, int fr, int fq) const {
    const int c = u.pn * 256;
    if (c >= 2560) { const size_t off = c < 3584 ? (size_t)WS_GA : (size_t)WS_GB; unsigned char* g8 = (unsigned char*)(ws + off); const int pnl = (u.pn - 10) & 3, lane = fq * 16 + fr;
#pragma unroll
      for (int ai = 0; ai < 2; ++ai)
#pragma unroll
        for (int m = 0; m < 4; ++m)
#pragma unroll
          for (int bj = 0; bj < 2; ++bj) *(u32x2v*)(g8 + gate_frag_off(u.pm, pnl, wr, wc, ai, m, bj, lane)) = pack8_fp8(acc[ai][bj][m][0], acc[ai][bj][m][1]);
    } else { const size_t off = c < 1024 ? (size_t)WS_RV : (c < 2048 ? (size_t)WS_RG : (size_t)WS_SV); const int c0 = c < 1024 ? 0 : (c < 2048 ? 1024 : 2048), ld = c < 2048 ? 1024 : 512; u16* b = (u16*)(ws + off);
      epi_walk(acc, u, wr, wc, fr, fq, [&](int row, int col, f32x4 v0, f32x4 v1) { *(u32x4*)(b + (size_t)row * ld + (col - c0)) = pack8_bf16(v0, v1); }); }
  }
};
struct FEpiMixB { u16* mixed  ; const u16* gb;
  __device__ __forceinline__ void operator()(const f32x4 (&acc)[2][2][4][2], const pg8::Unit& u, int wr, int wc, int fr, int fq) const {
    const int row0 = u.pm * 256 + wr * 64 + fr, col0 = u.pn * 256 + wc * 32 + 8 * fq, lane = fq * 16 + fr;
    u32x2v gw[2][4][2];
#pragma unroll
    for (int ai = 0; ai < 2; ++ai)
#pragma unroll
      for (int m = 0; m < 4; ++m)
#pragma unroll
        for (int bj = 0; bj < 2; ++bj) gw[ai][m][bj] = __builtin_nontemporal_load((const u32x2v*)((const unsigned char*)gb + gate_frag_off(u.pm, u.pn, wr, wc, ai, m, bj, lane)));
#pragma unroll
    for (int ai = 0; ai < 2; ++ai)
#pragma unroll
      for (int m = 0; m < 4; ++m)
#pragma unroll
        for (int bj = 0; bj < 2; ++bj) { const size_t i = (size_t)(row0 + ai * 128 + m * 16) * D_ + col0 + bj * 128; float g[8]; unpack8_fp8(gw[ai][m][bj], g);
          const f32x4 v0 = acc[ai][bj][m][0], v1 = acc[ai][bj][m][1]; f32x4 a, b2;
          a[0] = sigmoidf_(g[0]) * v0[0]; a[1] = sigmoidf_(g[1]) * v0[1]; a[2] = sigmoidf_(g[2]) * v0[2]; a[3] = sigmoidf_(g[3]) * v0[3];
          b2[0] = sigmoidf_(g[4]) * v1[0]; b2[1] = sigmoidf_(g[5]) * v1[1]; b2[2] = sigmoidf_(g[6]) * v1[2]; b2[3] = sigmoidf_(g[7]) * v1[3];
          *(u32x4*)((unsigned char*)mixed + 2 * gate_frag_off(u.pm, u.pn, wr, wc, ai, m, bj, lane)) = pack8_bf16(a, b2); (void)i; }
  }
};
struct FEpiMixA { u16* mixed; const u16* ga; const u16* part;
  __device__ __forceinline__ void operator()(const f32x4 (&acc)[2][2][4][2], const pg8::Unit& u, int wr, int wc, int fr, int fq) const {
    const int row0 = u.pm * 256 + wr * 64 + fr, col0 = u.pn * 256 + wc * 32 + 8 * fq, lane = fq * 16 + fr;
    u32x2v gw[2][4][2];
#pragma unroll
    for (int ai = 0; ai < 2; ++ai)
#pragma unroll
      for (int m = 0; m < 4; ++m)
#pragma unroll
        for (int bj = 0; bj < 2; ++bj) gw[ai][m][bj] = __builtin_nontemporal_load((const u32x2v*)((const unsigned char*)ga + gate_frag_off(u.pm, u.pn, wr, wc, ai, m, bj, lane)));
#pragma unroll
    for (int ai = 0; ai < 2; ++ai)
#pragma unroll
      for (int mh = 0; mh < 2; ++mh) {
        u32x4 ow[2][2];
#pragma unroll
        for (int mm = 0; mm < 2; ++mm)
#pragma unroll
          for (int bj = 0; bj < 2; ++bj) ow[mm][bj] = *(const u32x4*)((const unsigned char*)part + 2 * gate_frag_off(u.pm, u.pn, wr, wc, ai, 2 * mh + mm, bj, lane));
#pragma unroll
        for (int mm = 0; mm < 2; ++mm)
#pragma unroll
          for (int bj = 0; bj < 2; ++bj) { const int m = 2 * mh + mm; const size_t i = (size_t)(row0 + ai * 128 + m * 16) * D_ + col0 + bj * 128; float g[8], o[8]; unpack8_fp8(gw[ai][m][bj], g); unpack8_bf16(ow[mm][bj], o);
            const f32x4 v0 = acc[ai][bj][m][0], v1 = acc[ai][bj][m][1]; f32x4 a, b2;
            a[0] = o[0] + sigmoidf_(g[0]) * v0[0]; a[1] = o[1] + sigmoidf_(g[1]) * v0[1]; a[2] = o[2] + sigmoidf_(g[2]) * v0[2]; a[3] = o[3] + sigmoidf_(g[3]) * v0[3];
            b2[0] = o[4] + sigmoidf_(g[4]) * v1[0]; b2[1] = o[5] + sigmoidf_(g[5]) * v1[1]; b2[2] = o[6] + sigmoidf_(g[6]) * v1[2]; b2[3] = o[7] + sigmoidf_(g[7]) * v1[3];
            *(u32x4*)(mixed + i) = pack8_bf16(a, b2); }
      }
  }
};
struct FEpiOut { const float* x; float* x1; u16* x1h; float* ssq;
  __device__ __forceinline__ void operator()(const f32x4 (&acc)[2][2][4][2], const pg8::Unit& u, int wr, int wc, int fr, int fq) const {
    const int row0 = u.pm * 256 + wr * 64 + fr, col0 = u.pn * 256 + wc * 32 + 8 * fq;
#pragma unroll
    for (int ai = 0; ai < 2; ++ai) {
      f32x4 xa[4][2], xb[4][2];
#pragma unroll
      for (int m = 0; m < 4; ++m)
#pragma unroll
        for (int bj = 0; bj < 2; ++bj) { const size_t i = (size_t)(row0 + ai * 128 + m * 16) * D_ + col0 + bj * 128; xa[m][bj] = *(const f32x4*)(x + i); xb[m][bj] = *(const f32x4*)(x + i + 4); }
#pragma unroll
      for (int m = 0; m < 4; ++m) {
        const int row = row0 + ai * 128 + m * 16; float ss = 0.f;
#pragma unroll
        for (int bj = 0; bj < 2; ++bj) {
          const size_t i = (size_t)row * D_ + col0 + bj * 128;
          const f32x4 a = xa[m][bj] + acc[ai][bj][m][0], b2 = xb[m][bj] + acc[ai][bj][m][1];
          *(u32x4*)(x1h + i) = pack8_f16(a, b2);
          ss += a[0] * a[0] + a[1] * a[1] + a[2] * a[2] + a[3] * a[3] + b2[0] * b2[0] + b2[1] * b2[1] + b2[2] * b2[2] + b2[3] * b2[3];
        }
        ss += __shfl_xor(ss, 16); ss += __shfl_xor(ss, 32);
        if (fq == 0 && ssq) atomicAdd(ssq + row, ss);
      }
    }
  }
};
struct FEpiQ { const float* ssq; u16* q;
  __device__ __forceinline__ void operator()(const f32x4 (&acc)[2][2][4][2], const pg8::Unit& u, int wr, int wc, int fr, int fq) const {
    const int row0 = u.pm * 256 + wr * 64 + fr;
    float rs[2][4];
#pragma unroll
    for (int ai = 0; ai < 2; ++ai)
#pragma unroll
      for (int m = 0; m < 4; ++m) rs[ai][m] = ssq[row0 + ai * 128 + m * 16];
#pragma unroll
    for (int ai = 0; ai < 2; ++ai)
#pragma unroll
      for (int m = 0; m < 4; ++m) { const float rstd = rsqrtf(rs[ai][m] * (1.0f / D_) + 1e-6f);
#pragma unroll
        for (int bj = 0; bj < 2; ++bj) {
          const int tokblk = 4 * ai + 2 * wr + (m >> 1), r = 16 * (m & 1) + fr, k = 2 * wc + (fq >> 1), hh = fq & 1;
          const size_t o = ((((((size_t)(u.pm * 8 + u.pn) * 8 + tokblk) * 2 + bj) * 8 + k) * 2 + hh) * 32 + r) * 8;
          *(u32x4*)(q + o) = pack8_bf16(acc[ai][bj][m][0] * rstd, acc[ai][bj][m][1] * rstd); } }
  }
};

#define LAS __attribute__((address_space(3)))
typedef short s16x8 __attribute__((ext_vector_type(8)));
typedef short s16x4 __attribute__((ext_vector_type(4)));
typedef float f32x16 __attribute__((ext_vector_type(16)));
typedef float f32x2 __attribute__((ext_vector_type(2)));
typedef __bf16 bf16x2_t __attribute__((ext_vector_type(2)));
typedef _Float16 h16x2 __attribute__((ext_vector_type(2)));
__device__ __forceinline__ unsigned pk_bf16(float lo, float hi) { f32x2 v = {lo, hi}; return __builtin_bit_cast(unsigned, __builtin_convertvector(v, bf16x2_t)); }
__device__ __forceinline__ unsigned pk_f16(float lo, float hi) { f32x2 v = {lo, hi}; return __builtin_bit_cast(unsigned, __builtin_convertvector(v, h16x2)); }
#define MFMA32(a, b, c) __builtin_amdgcn_mfma_f32_32x32x16_bf16((a), (b), (c), 0, 0, 0)
#define MFMA16(a, b, c) __builtin_amdgcn_mfma_f32_16x16x32_bf16((a), (b), (c), 0, 0, 0)

struct Params {
  const float *x, *norm_attn, *w_in, *ret_q_norm, *ret_k_norm, *ret_gn, *sb_q_norm, *sb_k_norm, *w_bra, *w_brb, *w_out, *norm_ffn, *w_q, *sk1, *sk2, *peer_u, *peer_v;
  float* out; char* ws;
  float l2g[8];
  int use_cg, pad;
};

__device__ __forceinline__ float4 ldnt4(const float* p) { const f32x4 v = __builtin_nontemporal_load((const f32x4*)p); return make_float4(v[0], v[1], v[2], v[3]); }
template <bool F16> __device__ __forceinline__ void transpose_tile(const float* __restrict__ W, u16* __restrict__ Wt, int K, int N, int k0, int n0, const float* __restrict__ scale, float* tile  , int drow0 = -1  ) {
  const int tid = ptid();
  { const int r = tid >> 4, c4 = tid & 15;
#pragma unroll
    for (int hh = 0; hh < 2; ++hh) { const int k = k0 + r + 32 * hh; float4 v = ldnt4(W + (size_t)k * N + n0 + 4 * c4); const float s = scale ? scale[k] : 1.0f;
      float* tp = tile + (r + 32 * hh) * 65 + 4 * c4; tp[0] = v.x * s; tp[1] = v.y * s; tp[2] = v.z * s; tp[3] = v.w * s; } }
  __syncthreads();
  { const int n = tid >> 3, kc = tid & 7; float f[8];
#pragma unroll
    for (int i = 0; i < 8; ++i) f[i] = tile[(8 * kc + i) * 65 + n];
    u32x4 w;
    if (F16) { w.x = pk_f16(f[0], f[1]); w.y = pk_f16(f[2], f[3]); w.z = pk_f16(f[4], f[5]); w.w = pk_f16(f[6], f[7]); }
    else { w.x = pk_bf16(f[0], f[1]); w.y = pk_bf16(f[2], f[3]); w.z = pk_bf16(f[4], f[5]); w.w = pk_bf16(f[6], f[7]); }
    *(u32x4*)(Wt + (size_t)((drow0 < 0 ? n0 : drow0) + n) * K + k0 + 8 * kc) = w; }
  __syncthreads();
}
__device__ __forceinline__ void transpose_tile_fp8(const float* __restrict__ W, unsigned char* __restrict__ Wt8, int K, int N, int k0, int n0, int nrow0, float* tile) {
  const int tid = ptid();
  { const int r = tid >> 4, c4 = tid & 15;
#pragma unroll
    for (int hh = 0; hh < 2; ++hh) { const int k = k0 + r + 32 * hh; float4 v = ldnt4(W + (size_t)k * N + n0 + 4 * c4);
      float* tp = tile + (r + 32 * hh) * 65 + 4 * c4; tp[0] = v.x * W8_SCALE; tp[1] = v.y * W8_SCALE; tp[2] = v.z * W8_SCALE; tp[3] = v.w * W8_SCALE; } }
  __syncthreads();
  { const int n = tid >> 3, kc = tid & 7; float f[8];
#pragma unroll
    for (int i = 0; i < 8; ++i) f[i] = tile[(8 * kc + i) * 65 + n];
    int w0 = 0, w1 = 0;
    w0 = __builtin_amdgcn_cvt_pk_fp8_f32(f[0], f[1], w0, false); w0 = __builtin_amdgcn_cvt_pk_fp8_f32(f[2], f[3], w0, true);
    w1 = __builtin_amdgcn_cvt_pk_fp8_f32(f[4], f[5], w1, false); w1 = __builtin_amdgcn_cvt_pk_fp8_f32(f[6], f[7], w1, true);
    *(uint2*)(Wt8 + (size_t)(nrow0 + n) * K + k0 + 8 * kc) = make_uint2((unsigned)w0, (unsigned)w1); }
  __syncthreads();
}
template <int MODE> __device__ __forceinline__ void transpose_wide(const float* __restrict__ W, void* __restrict__ Wt, int K, int N, int k0, int n0, int drow0, const float* __restrict__ scale, float* tile) {
  const int tid = ptid();
  { const int r = tid >> 3, c8 = tid & 7; const float s = (scale ? scale[k0 + r] : 1.0f) * (MODE == 2 ? W8_SCALE : 1.0f);
    float4 v[8];
#pragma unroll
    for (int i = 0; i < 8; ++i) v[i] = ldnt4(W + (size_t)(k0 + r) * N + n0 + 4 * (c8 + 8 * i));
#pragma unroll
    for (int i = 0; i < 8; ++i) { float* tp = tile + r * 257 + 4 * (c8 + 8 * i); tp[0] = v[i].x * s; tp[1] = v[i].y * s; tp[2] = v[i].z * s; tp[3] = v[i].w * s; } }
  __syncthreads();
#pragma unroll
  for (int i = 0; i < 4; ++i) { const int task = tid + 512 * i, n = task >> 3, kc = task & 7; float f[8];
#pragma unroll
    for (int j = 0; j < 8; ++j) f[j] = tile[(8 * kc + j) * 257 + n];
    if (MODE == 2) { int w0 = 0, w1 = 0;
      w0 = __builtin_amdgcn_cvt_pk_fp8_f32(f[0], f[1], w0, false); w0 = __builtin_amdgcn_cvt_pk_fp8_f32(f[2], f[3], w0, true);
      w1 = __builtin_amdgcn_cvt_pk_fp8_f32(f[4], f[5], w1, false); w1 = __builtin_amdgcn_cvt_pk_fp8_f32(f[6], f[7], w1, true);
      *(uint2*)((unsigned char*)Wt + (size_t)(drow0 + n) * K + k0 + 8 * kc) = make_uint2((unsigned)w0, (unsigned)w1);
    } else { u32x4 w;
      if (MODE == 1) { w.x = pk_f16(f[0], f[1]); w.y = pk_f16(f[2], f[3]); w.z = pk_f16(f[4], f[5]); w.w = pk_f16(f[6], f[7]); }
      else { w.x = pk_bf16(f[0], f[1]); w.y = pk_bf16(f[2], f[3]); w.z = pk_bf16(f[4], f[5]); w.w = pk_bf16(f[6], f[7]); }
      *(u32x4*)((u16*)Wt + (size_t)(drow0 + n) * K + k0 + 8 * kc) = w; } }
  __syncthreads();
}
__device__ __forceinline__ void phase_prologue(const Params& p, unsigned char* smem, char* dob) {
  const int tid = ptid(), lane = tid & 63, w = tid >> 6, G = gridDim.x, b = blockIdx.x;
  u16* XN = (u16*)(dob + DO_XN);
  for (int t0 = b * 8 + w; t0 < S_; t0 += 2 * G * 8) {
    float4 v[2][4]; float4 gq[4];
#pragma unroll
    for (int i = 0; i < 4; ++i) gq[i] = *(const float4*)(p.norm_attn + 4 * (lane + 64 * i));
#pragma unroll
    for (int rr = 0; rr < 2; ++rr) { const int t = t0 + rr * G * 8 < S_ ? t0 + rr * G * 8 : t0; const float* xp = p.x + (size_t)t * D_;
#pragma unroll
      for (int i = 0; i < 4; ++i) v[rr][i] = ldnt4(xp + 4 * (lane + 64 * i)); }
#pragma unroll
    for (int rr = 0; rr < 2; ++rr) { const int t = t0 + rr * G * 8; if (t < S_) {
      float ss = 0.f;
#pragma unroll
      for (int i = 0; i < 4; ++i) ss += v[rr][i].x * v[rr][i].x + v[rr][i].y * v[rr][i].y + v[rr][i].z * v[rr][i].z + v[rr][i].w * v[rr][i].w;
#pragma unroll
      for (int o = 32; o > 0; o >>= 1) ss += __shfl_xor(ss, o);
      const float r = rsqrtf(ss * (1.0f / D_) + 1e-6f);
      u16* op = XN + (size_t)t * D_; unsigned char* op8 = (unsigned char*)(dob + DO_XN8) + (size_t)t * D_;
#pragma unroll
      for (int i = 0; i < 4; ++i) { const float y0 = v[rr][i].x * r * gq[i].x, y1 = v[rr][i].y * r * gq[i].y, y2 = v[rr][i].z * r * gq[i].z, y3 = v[rr][i].w * r * gq[i].w;
        *(uint2*)(op + 4 * (lane + 64 * i)) = make_uint2(pk_bf16(y0, y1), pk_bf16(y2, y3));
        int q = 0; q = __builtin_amdgcn_cvt_pk_fp8_f32(y0, y1, q, false); q = __builtin_amdgcn_cvt_pk_fp8_f32(y2, y3, q, true);
        *(int*)(op8 + 4 * (lane + 64 * i)) = q; } } }
  }
  float* tile = (float*)smem;
  for (int j = b; j < 704; j += G) {
    if (j < 416) { const int k0 = (j / 26) * 64, n0 = (j % 26) * 256;
      if (n0 < 1024) transpose_wide<0>(p.w_in, dob + DO_WINT, 1024, 6656, k0, n0, n0, nullptr, tile);
      else if (n0 >= 3072 && n0 < 4096) transpose_wide<0>(p.w_in, dob + DO_WINT, 1024, 6656, k0, n0, n0 - 2048, nullptr, tile);
      else transpose_wide<2>(p.w_in, dob + DO_W8T, 1024, 6656, k0, n0, n0 < 3072 ? n0 - 1024 : n0 - 2048, nullptr, tile); }
    else if (j < 480) { const int q = j - 416; transpose_wide<0>(p.w_bra, dob + DO_WBRAT, 1024, 1024, (q / 4) * 64, (q % 4) * 256, (q % 4) * 256, nullptr, tile); }
    else if (j < 512) { const int q = j - 480; transpose_wide<0>(p.w_brb, dob + DO_WBRBT, 512, 1024, (q / 4) * 64, (q % 4) * 256, (q % 4) * 256, nullptr, tile); }
    else if (j < 576) { const int q = j - 512; transpose_wide<0>(p.w_out, p.ws + WS_WOUTT, 1024, 1024, (q / 4) * 64, (q % 4) * 256, (q % 4) * 256, nullptr, tile); }
    else { const int q = j - 576; transpose_wide<1>(p.w_q, p.ws + WS_WQT, 1024, 2048, (q / 8) * 64, (q % 8) * 256, (q % 8) * 256, p.norm_ffn, tile); }
  }
  const int gt = b * 512 + tid, GT = G * 512;
  for (int i = gt; i < 16384; i += GT) { ((u16*)(p.ws + WS_K1))[i] = f2bf(p.sk1[i]); ((u16*)(p.ws + WS_K2))[i] = f2bf(p.sk2[i]); ((float*)(p.ws + WS_SSQ))[i] = 0.f; }
  for (int i = gt; i < S_ * 32; i += GT) { const int t = i >> 5, f = i & 31; const float freq = powf(10000.0f, -(float)f / 32.0f); float sn, cs; sincosf((float)t * freq, &sn, &cs);
    ((float*)(p.ws + WS_ROPE_C))[i] = cs; ((float*)(p.ws + WS_ROPE_S))[i] = sn; }
}

#define WS_U8 (240 * MB_)
#define WS_V8 WS_RK
#define WS_HP WS_GA
#define WS_A WS_RV
#define WS_A8 (WS_RV)
#define WS_ASC (WS_RV + 8 * MB_)
#define U8_SCALE 256.0f
#define V8_SCALE 32.0f
#define SLICE_BYTES (16384 * 128)
__device__ __forceinline__ void conv_table(const Params& p, int which, int part, int nparts) {
  const size_t gt = (size_t)part * 512 + ptid(), GT = (size_t)nparts * 512, NC = (size_t)S_ * D_ / 8;
  unsigned char* T8 = (unsigned char*)(p.ws + (which == 0 ? WS_U8 : WS_V8)); const float* src = which == 0 ? p.peer_u : p.peer_v; const float sc = which == 0 ? U8_SCALE : V8_SCALE;
  for (size_t c0 = gt; c0 < NC; c0 += 4 * GT) {
    float4 a0[4], a1[4], g0[4], g1[4];
#pragma unroll
    for (int k = 0; k < 4; ++k) { const size_t c = c0 + k * GT < NC ? c0 + k * GT : c0, i = c * 8; const int col = (int)(i & (D_ - 1));
      a0[k] = *(const float4*)(src + i); a1[k] = *(const float4*)(src + i + 4);
      if (which == 0) { g0[k] = *(const float4*)(p.norm_ffn + col); g1[k] = *(const float4*)(p.norm_ffn + col + 4); } else { g0[k] = make_float4(1.f, 1.f, 1.f, 1.f); g1[k] = g0[k]; } }
#pragma unroll
    for (int k = 0; k < 4; ++k) { const size_t c = c0 + k * GT; if (c < NC) { const size_t i = c * 8; const int col = (int)(i & (D_ - 1)), e = (int)(i >> 10);
      const size_t dst = (size_t)(col >> 7) * SLICE_BYTES + (size_t)e * 128 + (col & 127);
      int w0 = 0, w1 = 0;
      w0 = __builtin_amdgcn_cvt_pk_fp8_f32(a0[k].x * g0[k].x * sc, a0[k].y * g0[k].y * sc, w0, false); w0 = __builtin_amdgcn_cvt_pk_fp8_f32(a0[k].z * g0[k].z * sc, a0[k].w * g0[k].w * sc, w0, true);
      w1 = __builtin_amdgcn_cvt_pk_fp8_f32(a1[k].x * g1[k].x * sc, a1[k].y * g1[k].y * sc, w1, false); w1 = __builtin_amdgcn_cvt_pk_fp8_f32(a1[k].z * g1[k].z * sc, a1[k].w * g1[k].w * sc, w1, true);
      *(uint2*)(T8 + dst) = make_uint2((unsigned)w0, (unsigned)w1); } }
  }
}


#define WS_SU (12 * MB_ + 131072)
__device__ __forceinline__ void conv_u4(const Params& p, int part, int nparts) {
  const int tid = ptid(), lane = tid & 63, w = tid >> 6;
  unsigned char* T4 = (unsigned char*)(p.ws + WS_U8); float* SU = (float*)(p.ws + WS_SU);
  float4 gq[4];
#pragma unroll
  for (int i = 0; i < 4; ++i) gq[i] = *(const float4*)(p.norm_ffn + 4 * (lane + 64 * i));
  const int NW = nparts * 8;
  for (int e0 = part * 8 + w; e0 < 16384; e0 += 2 * NW) {
    float4 v[2][4];
#pragma unroll
    for (int rr = 0; rr < 2; ++rr) { const int e = e0 + rr * NW < 16384 ? e0 + rr * NW : e0; const float* up = p.peer_u + (size_t)e * D_;
#pragma unroll
      for (int i = 0; i < 4; ++i) v[rr][i] = ldnt4(up + 4 * (lane + 64 * i)); }
#pragma unroll
    for (int rr = 0; rr < 2; ++rr) { const int e = e0 + rr * NW; if (e < 16384) {
      float f[16];
#pragma unroll
      for (int i = 0; i < 4; ++i) { f[4 * i] = v[rr][i].x * gq[i].x; f[4 * i + 1] = v[rr][i].y * gq[i].y; f[4 * i + 2] = v[rr][i].z * gq[i].z; f[4 * i + 3] = v[rr][i].w * gq[i].w; }
      float am = 0.f;
#pragma unroll
      for (int i = 0; i < 16; ++i) am = fmaxf(am, fabsf(f[i]));
#pragma unroll
      for (int o = 32; o > 0; o >>= 1) am = fmaxf(am, __shfl_xor(am, o));
      const float s = am > 1e-30f ? am * (1.0f / 6.0f) : 1.0f, inv = 1.0f / s;
#pragma unroll
      for (int i = 0; i < 4; ++i) { unsigned q = 0;
        q = __builtin_amdgcn_cvt_scalef32_pk_fp4_f32(q, f[4 * i] * inv, f[4 * i + 1] * inv, 1.0f, 0); q = __builtin_amdgcn_cvt_scalef32_pk_fp4_f32(q, f[4 * i + 2] * inv, f[4 * i + 3] * inv, 1.0f, 1);
        *(u16*)(T4 + (size_t)i * SLICE_BYTES + (size_t)e * 128 + 2 * lane) = (u16)q; }
      if (lane == 0) SU[e] = s; } }
  }
}

#define SEL_KSTR 272
#define INSERT16(V, x) do { const float _x = (x); _Pragma("unroll") for (int _j = 15; _j >= 1; --_j) V[_j] = __builtin_amdgcn_fmed3f(V[_j - 1], V[_j], _x); V[0] = fmaxf(V[0], _x); } while (0)
#define MERGE16(V) do { float _c[16]; _Pragma("unroll") for (int _i = 0; _i < 16; ++_i) _c[_i] = __shfl_xor(V[_i], 32); \
  _Pragma("unroll") for (int _i = 0; _i < 16; ++_i) V[_i] = fmaxf(V[_i], _c[15 - _i]); \
  _Pragma("unroll") for (int _k = 8; _k >= 1; _k >>= 1) { _Pragma("unroll") for (int _i = 0; _i < 16; ++_i) if ((_i & _k) == 0) { const float _hi = fmaxf(V[_i], V[_i + _k]), _lo = fminf(V[_i], V[_i + _k]); V[_i] = _hi; V[_i + _k] = _lo; } } } while (0)
#define SCE_(K_, a, b) do { const float _h = fmaxf(K_[a], K_[b]), _l = fminf(K_[a], K_[b]); K_[a] = _h; K_[b] = _l; } while (0)
#define SORT16(K_) do { SCE_(K_, 0,1); SCE_(K_, 2,3); SCE_(K_, 0,2); SCE_(K_, 1,3); SCE_(K_, 1,2); SCE_(K_, 4,5); SCE_(K_, 6,7); SCE_(K_, 4,6); SCE_(K_, 5,7); SCE_(K_, 5,6); SCE_(K_, 0,4); SCE_(K_, 2,6); SCE_(K_, 2,4); SCE_(K_, 1,5); SCE_(K_, 3,7); SCE_(K_, 3,5); SCE_(K_, 1,2); SCE_(K_, 3,4); SCE_(K_, 5,6); SCE_(K_, 8,9); SCE_(K_, 10,11); SCE_(K_, 8,10); SCE_(K_, 9,11); SCE_(K_, 9,10); SCE_(K_, 12,13); SCE_(K_, 14,15); SCE_(K_, 12,14); SCE_(K_, 13,15); SCE_(K_, 13,14); SCE_(K_, 8,12); SCE_(K_, 10,14); SCE_(K_, 10,12); SCE_(K_, 9,13); SCE_(K_, 11,15); SCE_(K_, 11,13); SCE_(K_, 9,10); SCE_(K_, 11,12); SCE_(K_, 13,14); SCE_(K_, 0,8); SCE_(K_, 4,12); SCE_(K_, 4,8); SCE_(K_, 2,10); SCE_(K_, 6,14); SCE_(K_, 6,10); SCE_(K_, 2,4); SCE_(K_, 6,8); SCE_(K_, 10,12); SCE_(K_, 1,9); SCE_(K_, 5,13); SCE_(K_, 5,9); SCE_(K_, 3,11); SCE_(K_, 7,15); SCE_(K_, 7,11); SCE_(K_, 3,5); SCE_(K_, 7,9); SCE_(K_, 11,13); SCE_(K_, 1,2); SCE_(K_, 3,4); SCE_(K_, 5,6); SCE_(K_, 7,8); SCE_(K_, 9,10); SCE_(K_, 11,12); SCE_(K_, 13,14); } while (0)
#define MERGETOP16(V, K_) do { _Pragma("unroll") for (int _i = 0; _i < 16; ++_i) V[_i] = fmaxf(V[_i], K_[15 - _i]); \
  _Pragma("unroll") for (int _k = 8; _k >= 1; _k >>= 1) { _Pragma("unroll") for (int _i = 0; _i < 16; ++_i) if ((_i & _k) == 0) { const float _hi = fmaxf(V[_i], V[_i + _k]), _lo = fminf(V[_i], V[_i + _k]); V[_i] = _hi; V[_i + _k] = _lo; } } } while (0)
__device__ __forceinline__ void select_side(const u16* __restrict__ qrow  , LAS unsigned char* ks, int lane, float (&V)[16]) {
  const int hh = lane >> 5, r = lane & 31;
  s16x8 bq[8];
#pragma unroll
  for (int k = 0; k < 8; ++k) bq[k] = *(const s16x8*)(qrow + ((2 * k + hh) * 32 + r) * 8);
#pragma unroll
  for (int j = 0; j < 16; ++j) V[j] = -3.0e38f;
#pragma unroll
  for (int a = 0; a < 4; ++a) {
    f32x16 acc;
#pragma unroll
    for (int i = 0; i < 16; ++i) acc[i] = 0.f;
#pragma unroll
    for (int k = 0; k < 8; ++k) { const s16x8 af = *(const LAS s16x8*)(ks + (32 * a + r) * SEL_KSTR + (16 * k + 8 * hh) * 2); acc = MFMA32(af, bq[k], acc); }
    float K[16];
#pragma unroll
    for (int i = 0; i < 16; ++i) { const int n = 32 * a + (i & 3) + 8 * (i >> 2) + 4 * hh; K[i] = __uint_as_float((__float_as_uint(acc[i]) & 0xFFFFFF80u) | (unsigned)n); }
    SORT16(K);
    if (a == 0) {
#pragma unroll
      for (int i = 0; i < 16; ++i) V[i] = K[i];
    } else MERGETOP16(V, K);
  }
  MERGE16(V);
}
struct ConvRegs { float4 a0[4], a1[4]; };
#define WS_SVS (12 * MB_ + 196608)
#define CONVV_PIECES 4
__device__ __forceinline__ void convv_load(const Params& p, int j, ConvRegs& R) {
  const int lane = ptid() & 63, gw = blockIdx.x * 8 + (ptid() >> 6), NWV = gridDim.x * 8;
  const int e0 = gw + NWV * (2 * j), e1 = gw + NWV * (2 * j + 1);
  const float* p0 = p.peer_v + (size_t)(e0 < 16384 ? e0 : gw) * D_; const float* p1 = p.peer_v + (size_t)(e1 < 16384 ? e1 : gw) * D_;
#pragma unroll
  for (int k = 0; k < 4; ++k) { R.a0[k] = ldnt4(p0 + 4 * (lane + 64 * k)); R.a1[k] = ldnt4(p1 + 4 * (lane + 64 * k)); }
}
__device__ __forceinline__ void convv_row(const Params& p, int e, const float4 (&v)[4], int lane) {
  float f[16];
#pragma unroll
  for (int i = 0; i < 4; ++i) { f[4 * i] = v[i].x; f[4 * i + 1] = v[i].y; f[4 * i + 2] = v[i].z; f[4 * i + 3] = v[i].w; }
  float am = 0.f;
#pragma unroll
  for (int i = 0; i < 16; ++i) am = fmaxf(am, fabsf(f[i]));
#pragma unroll
  for (int o = 32; o > 0; o >>= 1) am = fmaxf(am, __shfl_xor(am, o));
  const float s = am > 1e-30f ? am * (1.0f / 6.0f) : 1.0f, inv = 1.0f / s;
  if (e < 16384) {
#pragma unroll
    for (int i = 0; i < 4; ++i) { unsigned q = 0;
      q = __builtin_amdgcn_cvt_scalef32_pk_fp4_f32(q, f[4 * i] * inv, f[4 * i + 1] * inv, 1.0f, 0); q = __builtin_amdgcn_cvt_scalef32_pk_fp4_f32(q, f[4 * i + 2] * inv, f[4 * i + 3] * inv, 1.0f, 1);
      *(u16*)((unsigned char*)(p.ws + WS_V8) + (size_t)i * SLICE_BYTES + (size_t)e * 128 + 2 * lane) = (u16)q; }
    if (lane == 0) ((float*)(p.ws + WS_SVS))[e] = s; }
}
__device__ __forceinline__ void convv_store(const Params& p, int j, const ConvRegs& R) {
  const int lane = ptid() & 63, gw = blockIdx.x * 8 + (ptid() >> 6), NWV = gridDim.x * 8;
  convv_row(p, gw + NWV * (2 * j), R.a0, lane); convv_row(p, gw + NWV * (2 * j + 1), R.a1, lane);
}
__device__ __forceinline__ void phase_select(const Params& p, unsigned char* smem, const pg8::StaticOrder& S) {
  const int tid = ptid(), lane = tid & 63, w = tid >> 6, hh = lane >> 5;
  LAS unsigned char* lds = (LAS unsigned char*)smem;
  LAS unsigned char* k1s = lds; LAS unsigned char* k2s = lds + 128 * SEL_KSTR; LAS unsigned* scr = (LAS unsigned*)(lds + 2 * 128 * SEL_KSTR + w * 4096);
  const u16* K1 = (const u16*)(p.ws + WS_K1); const u16* K2 = (const u16*)(p.ws + WS_K2); const u16* Q = (const u16*)(p.ws + WS_Q);
  u16* IDX = (u16*)(p.ws + WS_IDX); float* GW = (float*)(p.ws + WS_G);
  for (int c = tid; c < 2048; c += 512) { const int n = c >> 4, ch = c & 15;
    *(LAS u32x4*)(k1s + n * SEL_KSTR + ch * 16) = *(const u32x4*)(K1 + n * 128 + ch * 8); *(LAS u32x4*)(k2s + n * SEL_KSTR + ch * 16) = *(const u32x4*)(K2 + n * 128 + ch * 8); }
  __syncthreads();
  pg8::Unit un;
  const int npieces = (16384 + 2 * gridDim.x * 8 - 1) / (2 * gridDim.x * 8); int cj = 0;
  for (int ui = 0; S.next(ui, un); ++ui) {
    const int tb = un.pm * 8 + w, h = un.pn, t = tb * 32 + (lane & 31);
    const u16* qrow = Q + (size_t)((un.pm * 8 + h) * 8 + w) * 8192;
    float v1[16], v2[16];
    { ConvRegs cr; const bool cv = cj < npieces; if (cv) convv_load(p, cj, cr);
      select_side(qrow, k1s, lane, v1);
      if (cv) { convv_store(p, cj, cr); ++cj; } }
    { ConvRegs cr; const bool cv = cj < npieces; if (cv) convv_load(p, cj, cr);
      select_side(qrow + 4096, k2s, lane, v2);
      if (cv) { convv_store(p, cj, cr); ++cj; } }
    if (hh == 0) {
#pragma unroll
      for (int i = 0; i < 16; ++i) { scr[(lane & 31) * 32 + i] = __float_as_uint(v1[i]); scr[(lane & 31) * 32 + 16 + i] = __float_as_uint(v2[i]); } }
    float c[16];
#pragma unroll
    for (int j = 0; j < 16; ++j) c[j] = -3.0e38f;
    { int ci = 0; float pend = 0.f; unsigned pcode = 0;
#pragma unroll
      for (int a = 0; a < 16; ++a)
#pragma unroll
        for (int bb = 0; bb < 16; ++bb) if ((a + 1) * (bb + 1) <= 16) {
          const float s = v1[a] + v2[bb]; const unsigned code = (unsigned)(a * 16 + bb);
          if ((ci & 1) == 0) { pend = s; pcode = code; }
          else { const float x = hh ? s : pend; const unsigned cd = hh ? code : pcode; INSERT16(c, __uint_as_float((__float_as_uint(x) & 0xFFFFFF00u) | cd)); }
          ++ci; }
    }
    MERGE16(c);
    float sum = 0.f, e[16];
#pragma unroll
    for (int j = 0; j < 16; ++j) { e[j] = __expf(c[j] - c[0]); sum += e[j]; }
    const float inv = 1.0f / sum;
    unsigned ids[8]; float gs[8];
#pragma unroll
    for (int j = 0; j < 8; ++j) { float cl = c[j], ch = c[8 + j], el = e[j], eh = e[8 + j]; asm volatile("" : "+v"(cl), "+v"(ch), "+v"(el), "+v"(eh));
      const float cj = hh ? ch : cl; const unsigned code = __float_as_uint(cj) & 0xFFu; gs[j] = (hh ? eh : el) * inv;
      const unsigned k1 = scr[(lane & 31) * 32 + (code >> 4)], k2 = scr[(lane & 31) * 32 + 16 + (code & 15)]; ids[j] = (k1 & 127u) * 128u + (k2 & 127u); }
    u32x4 iw; iw.x = ids[0] | (ids[1] << 16); iw.y = ids[2] | (ids[3] << 16); iw.z = ids[4] | (ids[5] << 16); iw.w = ids[6] | (ids[7] << 16);
    *(u32x4*)(IDX + (size_t)t * 128 + h * 16 + 8 * hh) = iw;
    { u16* it = (u16*)(p.ws + WS_IDXT) + (size_t)t * 128 + 64 * hh + h;
#pragma unroll
      for (int j = 0; j < 8; ++j) it[8 * j] = (u16)ids[j]; }
    float* gp = GW + (size_t)t * 128 + h * 16 + 8 * hh; *(f32x4*)gp = (f32x4){gs[0], gs[1], gs[2], gs[3]}; *(f32x4*)(gp + 4) = (f32x4){gs[4], gs[5], gs[6], gs[7]};
  }
  for (; cj < npieces; ++cj) { ConvRegs cr; convv_load(p, cj, cr); convv_store(p, cj, cr); }
}

__device__ __forceinline__ unsigned xb_xcc_id();
#define LDS_BAR_OFF 147440
__device__ __forceinline__ float gelu_tanh_f(float x) { const float u = 0.7978845608028654f * (x + 0.044715f * x * x * x); const float e = __expf(2.0f * u); return x * (1.0f - 1.0f / (e + 1.0f)); }
#define GQ_WORD(ph, x) (4096 + 64 * ((ph) * 8 + (x)))
#define GCHUNK 32
__device__ __forceinline__ int gq_next(unsigned* ctr, volatile LAS int* slot) {
  if (ptid() == 0) *slot = (int)__hip_atomic_fetch_add(ctr, 1u, __ATOMIC_RELAXED, __HIP_MEMORY_SCOPE_AGENT);
  __syncthreads(); const int v = *slot; __syncthreads(); return v;
}
#define NTOK 32
template <int SIDE, bool DRY> __device__ __forceinline__ void gather_wave_chunk(const Params& p, int tb, int x, int lane) {
  const int ps = lane >> 3, k8 = lane & 7;
  const u16* AUX = (SIDE == 0) ? (const u16*)(p.ws + WS_X1H) + 128 * x + 16 * k8 : (const u16*)(p.ws + WS_A) + 16 * ps;
  const int auxld = (SIDE == 0) ? D_ : 128;
  const u16* IDX = (const u16*)(p.ws + WS_IDX) + 16 * ps;
  const unsigned char* T8 = (const unsigned char*)(p.ws + (SIDE == 0 ? WS_U8 : WS_V8)) + (size_t)x * SLICE_BYTES;
  const unsigned loff = 16u * (unsigned)k8;
  u16* HP = (u16*)(p.ws + WS_HP) + (size_t)x * S_ * 128 + 2 * lane;
  float* OUT = p.out + 128 * x + 16 * k8 + 2 * ps; const u16* X1R = (const u16*)(p.ws + WS_X1H) + 128 * x + 16 * k8 + 2 * ps;
  u32x4 mi[2][2], ax[2][2], gw[2][16]; unsigned xres[2];
#define G_META(kk) do { mi[(kk) & 1][0] = *(const u32x4*)(IDX + (size_t)(tb + (kk)) * 128); mi[(kk) & 1][1] = *(const u32x4*)(IDX + (size_t)(tb + (kk)) * 128 + 8); } while (0)
#define G_ISSUE(kk) do { const int s_ = (kk) & 1; const int t_ = tb + (kk); const unsigned iw_[8] = {mi[s_][0].x, mi[s_][0].y, mi[s_][0].z, mi[s_][0].w, mi[s_][1].x, mi[s_][1].y, mi[s_][1].z, mi[s_][1].w}; \
    _Pragma("unroll") for (int i_ = 0; i_ < 16; ++i_) { const unsigned e_ = (i_ & 1) ? (iw_[i_ >> 1] >> 16) : (iw_[i_ >> 1] & 0xFFFFu); gw[s_][i_] = *(const u32x4*)(T8 + (e_ * 128u + loff)); } \
    ax[s_][0] = *(const u32x4*)(AUX + (size_t)t_ * auxld); ax[s_][1] = *(const u32x4*)(AUX + (size_t)t_ * auxld + 8); \
    if (SIDE == 1) xres[s_] = *(const unsigned*)(X1R + (size_t)t_ * D_); } while (0)
  G_META(0); G_META(1); G_ISSUE(0);
#pragma unroll
  for (int k = 0; k < NTOK; ++k) {
    const int gs = k & 1, t = tb + k;
    if (k + 1 < NTOK) G_ISSUE(k + 1);
    if (k + 2 < NTOK) G_META(k + 2);
    const unsigned xw[8] = {ax[gs][0].x, ax[gs][0].y, ax[gs][0].z, ax[gs][0].w, ax[gs][1].x, ax[gs][1].y, ax[gs][1].z, ax[gs][1].w};
    if (SIDE == 0) {
      float sv[16];
#pragma unroll
      for (int i = 0; i < 16; ++i) {
        const unsigned w4[4] = {gw[gs][i].x, gw[gs][i].y, gw[gs][i].z, gw[gs][i].w};
        float s = 0.f;
#pragma unroll
        for (int d = 0; d < 4; ++d) { const unsigned wd = w4[d], x0 = xw[2 * d], x1 = xw[2 * d + 1];
          s = __builtin_amdgcn_fdot2(__builtin_amdgcn_cvt_scalef32_pk_f16_fp8(wd, 1.0f, false), __builtin_bit_cast(h16x2, x0), s, false);
          s = __builtin_amdgcn_fdot2(__builtin_amdgcn_cvt_scalef32_pk_f16_fp8(wd, 1.0f, true), __builtin_bit_cast(h16x2, x1), s, false); }
        sv[i] = s;
      }
      const bool c2 = (lane & 4) != 0, c1 = (lane & 2) != 0, c0 = (lane & 1) != 0;
      float q8[8], q4[4], q2[2];
#define DPP_F(v, ctrl) __uint_as_float(__builtin_amdgcn_update_dpp(0, (int)__float_as_uint(v), (ctrl), 0xf, 0xf, false))
#pragma unroll
      for (int c = 0; c < 8; ++c) { const float keep = c2 ? sv[c + 8] : sv[c], send = c2 ? sv[c] : sv[c + 8]; const float m = DPP_F(send, 0x141); q8[c] = keep + DPP_F(m, 0x1B); }
#pragma unroll
      for (int c = 0; c < 4; ++c) { const float keep = c1 ? q8[c + 4] : q8[c], send = c1 ? q8[c] : q8[c + 4]; q4[c] = keep + DPP_F(send, 0x4E); }
#pragma unroll
      for (int c = 0; c < 2; ++c) { const float keep = c0 ? q4[c + 2] : q4[c], send = c0 ? q4[c] : q4[c + 2]; q2[c] = keep + DPP_F(send, 0xB1); }
      const float h0 = q2[0], h1 = q2[1];
      *(unsigned*)(HP + (size_t)t * 128) = pk_f16(h0, h1);
    } else {
      h16x2 acc2[8];
#pragma unroll
      for (int j = 0; j < 8; ++j) acc2[j] = (h16x2){(_Float16)0.f, (_Float16)0.f};
#pragma unroll
      for (int i = 0; i < 16; ++i) {
        const unsigned w4[4] = {gw[gs][i].x, gw[gs][i].y, gw[gs][i].z, gw[gs][i].w}; const unsigned aw = xw[i >> 1]; const h16x2 a2 = __builtin_bit_cast(h16x2, aw);
        const h16x2 aa = (i & 1) ? (h16x2){a2.y, a2.y} : (h16x2){a2.x, a2.x};
#pragma unroll
        for (int d = 0; d < 4; ++d) { const unsigned wd = w4[d]; const h16x2 lo = __builtin_amdgcn_cvt_scalef32_pk_f16_fp8(wd, 1.0f, false), hi = __builtin_amdgcn_cvt_scalef32_pk_f16_fp8(wd, 1.0f, true);
          acc2[2 * d] = lo * aa + acc2[2 * d]; acc2[2 * d + 1] = hi * aa + acc2[2 * d + 1]; }
      }
      float acc[16];
#pragma unroll
      for (int j = 0; j < 8; ++j) { acc[2 * j] = (float)acc2[j].x; acc[2 * j + 1] = (float)acc2[j].y; }
      const bool b3 = (lane & 8) != 0;
      float r8[8], r4[4], r2[2];
#pragma unroll
      for (int c = 0; c < 8; ++c) { const auto sw = __builtin_amdgcn_permlane32_swap(__float_as_uint(acc[c]), __float_as_uint(acc[c + 8]), false, false); r8[c] = __uint_as_float(sw[0]) + __uint_as_float(sw[1]); }
#pragma unroll
      for (int c = 0; c < 4; ++c) { const auto sw = __builtin_amdgcn_permlane16_swap(__float_as_uint(r8[c]), __float_as_uint(r8[c + 4]), false, false); r4[c] = __uint_as_float(sw[0]) + __uint_as_float(sw[1]); }
#pragma unroll
      for (int c = 0; c < 2; ++c) { const float keep = b3 ? r4[c + 2] : r4[c], send = b3 ? r4[c] : r4[c + 2];
        r2[c] = keep + __uint_as_float(__builtin_amdgcn_update_dpp(0, (int)__float_as_uint(send), 0x128, 0xf, 0xf, false)); }
      float* op = OUT + (size_t)t * D_;
      const unsigned xr = xres[gs]; const h16x2 xh = __builtin_bit_cast(h16x2, xr);
      f32x2 o; o[0] = (float)xh.x + r2[0] * (1.0f / V8_SCALE); o[1] = (float)xh.y + r2[1] * (1.0f / V8_SCALE); if (!DRY || o[0] == 123456.789f) *(f32x2*)op = o;
    }
  }
#undef G_META
#undef G_ISSUE
}

typedef int v4i_t __attribute__((ext_vector_type(4)));
typedef int v8i_t __attribute__((ext_vector_type(8)));
template <int N> __device__ __forceinline__ void wait_vm() { asm volatile("s_waitcnt vmcnt(%0)" :: "n"(N) : "memory"); }
template <int N> struct IC_ { static constexpr int v = N; };
template <class F, int... Is> __device__ __forceinline__ void static_for_impl(F&& f, std::integer_sequence<int, Is...>) { (f(IC_<Is>{}), ...); }
template <int N, class F> __device__ __forceinline__ void static_for(F&& f) { static_for_impl(f, std::make_integer_sequence<int, N>{}); }
__device__ __forceinline__ v4i_t lds_rd128(unsigned a) { v4i_t r; asm volatile("ds_read_b128 %0, %1" : "=v"(r) : "v"(a) : "memory"); return r; }
__device__ __forceinline__ v4i_t lds_rd128_64(unsigned a) { v4i_t r; asm volatile("ds_read_b128 %0, %1 offset:64" : "=v"(r) : "v"(a) : "memory"); return r; }
#define G1_XOFF 132096
template <bool DRY> __device__ __forceinline__ void g1_mfma_chunk(const Params& p, LAS unsigned char* lds, int w, int tb, int sl  , int lane) {
  const int L3 = lane >> 3, k8 = lane & 7, e16 = lane & 15, g = lane >> 4;
  LAS unsigned char* ring = lds + w * 16384;
  const unsigned ringa = (unsigned)(size_t)ring, xsa = (unsigned)(size_t)(lds + G1_XOFF + w * 512);
  const unsigned char* T8 = (const unsigned char*)(p.ws + WS_U8) + (size_t)sl * SLICE_BYTES;
  const unsigned loff0 = 16u * (unsigned)(k8 ^ (L3 >> 1)), loff1 = 16u * (unsigned)(k8 ^ (4 + (L3 >> 1)));
  const unsigned rrow = ringa + (unsigned)((e16 >> 3) * 1024 + (e16 & 7) * 128);
  const unsigned rdA = rrow + (unsigned)(((g ^ (e16 >> 1)) & 7) * 16), rdB = rrow + (unsigned)((((g + 4) ^ (e16 >> 1)) & 7) * 16);
  const unsigned xrd = xsa + (unsigned)((e16 & 3) * 128 + 16 * g), xwr = xsa + 2u * (unsigned)lane;
  unsigned sc[4];
#pragma unroll
  for (int v = 0; v < 4; ++v) sc[v] = ((e16 >> 2) == v) ? (0x80808080u - 0x01010101u * (unsigned)((e16 & 3) == 0 ? 0 : 3 * (e16 & 3) - 1)) : 0u;
  const unsigned one = 0x7F7F7F7Fu;
  const u16* IDXT = (const u16*)(p.ws + WS_IDXT) + L3 * 8;
  const u16* XH = (const u16*)(p.ws + WS_X1H) + 256 * sl + 4 * lane;
  u16* HP = (u16*)(p.ws + WS_HP) + (size_t)sl * S_ * 128 + lane;
  u32x4 mi[2][2]; u32x2v xw[2];
#define M_META(kk) do { const u16* q_ = IDXT + (size_t)(tb + (kk)) * 128; u32x4 a_, b_; asm volatile("global_load_dwordx4 %0, %1, off" : "=v"(a_) : "v"(q_) : "memory"); \
    asm volatile("global_load_dwordx4 %0, %1, off offset:128" : "=v"(b_) : "v"(q_) : "memory"); mi[(kk) & 1][0] = a_; mi[(kk) & 1][1] = b_; } while (0)
#define M_XLOAD(kk) do { const u16* q_ = XH + (size_t)(tb + (kk)) * D_; u32x2v a_; asm volatile("global_load_dwordx2 %0, %1, off" : "=v"(a_) : "v"(q_) : "memory"); xw[(kk) & 1] = a_; } while (0)
#define M_ISSUE(kk, h) do { const int s_ = (kk) & 1; const unsigned wa_ = mi[s_][0][(h) >> 1], wb_ = mi[s_][1][(h) >> 1]; \
    const unsigned ia_ = ((h) & 1) ? (wa_ >> 16) : (wa_ & 0xFFFFu), ib_ = ((h) & 1) ? (wb_ >> 16) : (wb_ & 0xFFFFu); \
    __builtin_amdgcn_global_load_lds((const unsigned*)(T8 + (ia_ * 128u + loff0)), (LAS unsigned*)(ring + (h) * 2048), 16, 0, 0); \
    __builtin_amdgcn_global_load_lds((const unsigned*)(T8 + (ib_ * 128u + loff1)), (LAS unsigned*)(ring + (h) * 2048 + 1024), 16, 0, 0); } while (0)
#define M_FENCE asm volatile("" ::: "memory")
  M_META(0); M_META(1); M_XLOAD(0);
  asm volatile("s_waitcnt vmcnt(0)" : "+v"(mi[0][0]), "+v"(mi[0][1]), "+v"(mi[1][0]), "+v"(mi[1][1]), "+v"(xw[0]) :: "memory");
#pragma unroll
  for (int h = 0; h < 8; ++h) M_ISSUE(0, h);
  M_FENCE;
  static_for<NTOK>([&](auto kc) __attribute__((always_inline)) {
    constexpr int k = decltype(kc)::v;
    constexpr bool more = (k + 1 < NTOK);
    constexpr int oth = ((k + 2 < NTOK) ? 2 : 0) + (more ? 1 : 0), st = (k > 0) ? 2 : 0;
    M_FENCE;
    if constexpr (k + 2 < NTOK) M_META(k + 2);
    if constexpr (more) M_XLOAD(k + 1);
    M_FENCE;
    v4i_t X[2]; f32x4 acc[2][2];
    static_for<8>([&](auto hc) __attribute__((always_inline)) {
      constexpr int h = decltype(hc)::v;
      constexpr int NW = 2 * (7 - h) + st + oth + (more ? 2 * h : 0);
      if constexpr (h == 0 && k > 0) {
        u32x4 ma = mi[(k + 1) & 1][0], mb = mi[(k + 1) & 1][1]; u32x2v xv = xw[k & 1];
        asm volatile("s_waitcnt vmcnt(%3)" : "+v"(ma), "+v"(mb), "+v"(xv) : "n"(NW) : "memory");
        mi[(k + 1) & 1][0] = ma; mi[(k + 1) & 1][1] = mb; xw[k & 1] = xv;
      } else wait_vm<NW>();
      if constexpr (h == 0) {
        const u32x2v wv = xw[k & 1]; const unsigned w0_ = wv.x, w1_ = wv.y; const h16x2 ha = __builtin_bit_cast(h16x2, w0_), hb = __builtin_bit_cast(h16x2, w1_);
        const float f0 = __builtin_amdgcn_fmed3f((float)ha.x * 16.0f, -448.0f, 448.0f), f1 = __builtin_amdgcn_fmed3f((float)ha.y * 16.0f, -448.0f, 448.0f);
        const float f2 = __builtin_amdgcn_fmed3f((float)hb.x * 16.0f, -448.0f, 448.0f), f3 = __builtin_amdgcn_fmed3f((float)hb.y * 16.0f, -448.0f, 448.0f);
        float r0 = f0 * 0.03125f, r1 = f1 * 0.03125f, r2 = f2 * 0.03125f, r3 = f3 * 0.03125f;
        r0 = __builtin_amdgcn_fmed3f(r0, -6.0f, 6.0f); r1 = __builtin_amdgcn_fmed3f(r1, -6.0f, 6.0f); r2 = __builtin_amdgcn_fmed3f(r2, -6.0f, 6.0f); r3 = __builtin_amdgcn_fmed3f(r3, -6.0f, 6.0f);
        const unsigned xwl = xwr;
#pragma unroll
        for (int j = 0; j < 4; ++j) {
          const float sj = (j == 0) ? 1.0f : (j == 1) ? 4.0f : (j == 2) ? 32.0f : 256.0f, ij = 1.0f / sj;
          unsigned q = 0;
          q = __builtin_amdgcn_cvt_scalef32_pk_fp4_f32(q, r0 * sj, r1 * sj, 1.0f, 0); q = __builtin_amdgcn_cvt_scalef32_pk_fp4_f32(q, r2 * sj, r3 * sj, 1.0f, 1);
          const auto b01 = __builtin_amdgcn_cvt_scalef32_pk_f32_fp4(q, 1.0f, 0), b23 = __builtin_amdgcn_cvt_scalef32_pk_f32_fp4(q, 1.0f, 1);
          r0 -= b01[0] * ij; r1 -= b01[1] * ij; r2 -= b23[0] * ij; r3 -= b23[1] * ij;
          if (j == 0) asm volatile("ds_write_b16 %0, %1" :: "v"(xwl), "v"(q) : "memory");
          else if (j == 1) asm volatile("ds_write_b16 %0, %1 offset:128" :: "v"(xwl), "v"(q) : "memory");
          else if (j == 2) asm volatile("ds_write_b16 %0, %1 offset:256" :: "v"(xwl), "v"(q) : "memory");
          else asm volatile("ds_write_b16 %0, %1 offset:384" :: "v"(xwl), "v"(q) : "memory");
        }
        v4i_t xa, xc; const unsigned xrl = xrd;
        asm volatile("ds_read_b128 %0, %2\n\tds_read_b128 %1, %2 offset:64\n\ts_waitcnt lgkmcnt(0)" : "=&v"(xa), "=&v"(xc) : "v"(xrl) : "memory");
        X[0] = xa; X[1] = xc;
      }
      v4i_t ua = lds_rd128(rdA + (unsigned)(h * 2048)), ub = lds_rd128(rdB + (unsigned)(h * 2048));
      asm volatile("s_waitcnt lgkmcnt(0)" : "+v"(ua), "+v"(ub) :: "memory");
      if constexpr (more) M_ISSUE(k + 1, h);
      f32x4 ac0, ac1; const v4i_t X0 = X[0], X1 = X[1]; const unsigned scl = sc[h & 3], onel = one;
      if constexpr ((h & 3) == 0) {
        asm volatile("v_mfma_scale_f32_16x16x128_f8f6f4 %0, %1, %2, 0, %3, %4 op_sel_hi:[0,0,0] cbsz:4 blgp:4" : "=&v"(ac0) : "v"(X0), "v"(ua), "v"(scl), "v"(onel));
        asm volatile("v_mfma_scale_f32_16x16x128_f8f6f4 %0, %1, %2, 0, %3, %4 op_sel_hi:[0,0,0] cbsz:4 blgp:4" : "=&v"(ac1) : "v"(X1), "v"(ub), "v"(scl), "v"(onel));
      } else { ac0 = acc[0][h >> 2]; ac1 = acc[1][h >> 2];
        asm volatile("v_mfma_scale_f32_16x16x128_f8f6f4 %0, %1, %2, %0, %3, %4 op_sel_hi:[0,0,0] cbsz:4 blgp:4" : "+v"(ac0) : "v"(X0), "v"(ua), "v"(scl), "v"(onel));
        asm volatile("v_mfma_scale_f32_16x16x128_f8f6f4 %0, %1, %2, %0, %3, %4 op_sel_hi:[0,0,0] cbsz:4 blgp:4" : "+v"(ac1) : "v"(X1), "v"(ub), "v"(scl), "v"(onel)); }
      acc[0][h >> 2] = ac0; acc[1][h >> 2] = ac1;
    });
    { f32x4 a0 = acc[0][0], a1 = acc[0][1], a2 = acc[1][0], a3 = acc[1][1]; asm volatile("s_nop 15\n\ts_nop 15" : "+v"(a0), "+v"(a1), "+v"(a2), "+v"(a3)); acc[0][0] = a0; acc[0][1] = a1; acc[1][0] = a2; acc[1][1] = a3; }
    M_FENCE;
    { const f32x4 t0 = acc[0][0] + acc[1][0], t1 = acc[0][1] + acc[1][1]; const float s0 = (t0[0] + t0[1]) + (t0[2] + t0[3]), s1 = (t1[0] + t1[1]) + (t1[2] + t1[3]);
      u16* hp = HP + (size_t)(tb + k) * 128;
      const _Float16 h0 = (_Float16)s0, h1 = (_Float16)s1;
      hp[0] = __builtin_bit_cast(u16, h0); hp[64] = __builtin_bit_cast(u16, h1); }
    M_FENCE;
  });
  asm volatile("s_waitcnt vmcnt(0)" ::: "memory");
#undef M_META
#undef M_XLOAD
#undef M_ISSUE
#undef M_FENCE
}

typedef int v2i_t __attribute__((ext_vector_type(2)));
template <bool DRY> __device__ __forceinline__ void g2_mfma_chunk(const Params& p, LAS unsigned char* lds, int w, int tb, int sl  , int lane) {
  const int L3 = lane >> 3, k8 = lane & 7, n16 = lane & 15, g = lane >> 4;
  LAS unsigned char* ring = lds + w * 16384;
  const unsigned ringa = (unsigned)(size_t)ring;
  const unsigned char* T8 = (const unsigned char*)(p.ws + WS_V8) + (size_t)sl * SLICE_BYTES;
  const unsigned loff0 = 16u * (unsigned)(k8 ^ (L3 >> 1)), loff1 = 16u * (unsigned)(k8 ^ (4 + (L3 >> 1)));
  const unsigned trb = ringa + (unsigned)((2 * g) * 2048 + (n16 >> 3) * 1024 + (n16 & 7) * 128);
  unsigned tra[8];
#pragma unroll
  for (int pc = 0; pc < 8; ++pc) tra[pc] = trb + (((unsigned)pc ^ (unsigned)(n16 >> 1)) << 4);
  unsigned sca[4];
#pragma unroll
  for (int v = 0; v < 4; ++v) sca[v] = ((n16 >> 2) == v) ? (0x7F7F7F7Fu - 0x01010101u * (unsigned)((n16 & 3) == 0 ? 0 : 3 * (n16 & 3) - 1)) : 0u;
  const unsigned one = 0x7F7F7F7Fu;
  const u16* IDXT = (const u16*)(p.ws + WS_IDXT) + L3 * 8;
  const unsigned char* A4 = (const unsigned char*)(p.ws + WS_A8) + (n16 & 3) * 64 + g * 16;
  const float* ASC = (const float*)(p.ws + WS_ASC);
  const u16* X1R = (const u16*)(p.ws + WS_X1H) + 256 * sl + lane;
  float* OUT = p.out + 256 * sl + lane;
  u32x4 mi[2][2]; v4i_t aop[2]; unsigned xr[2][4]; float asc[2];
#define M_META(kk) do { const u16* q_ = IDXT + (size_t)(tb + (kk)) * 128; u32x4 a_, b_; asm volatile("global_load_dwordx4 %0, %1, off" : "=v"(a_) : "v"(q_) : "memory"); \
    asm volatile("global_load_dwordx4 %0, %1, off offset:128" : "=v"(b_) : "v"(q_) : "memory"); mi[(kk) & 1][0] = a_; mi[(kk) & 1][1] = b_; } while (0)
#define M_AUX(kk) do { const unsigned char* q_ = A4 + (size_t)(tb + (kk)) * 256; v4i_t a_; asm volatile("global_load_dwordx4 %0, %1, off" : "=v"(a_) : "v"(q_) : "memory"); aop[(kk) & 1] = a_; \
    const float* s_ = ASC + (tb + (kk)); float c_; asm volatile("global_load_dword %0, %1, off" : "=v"(c_) : "v"(s_) : "memory"); asc[(kk) & 1] = c_; \
    const u16* r_ = X1R + (size_t)(tb + (kk)) * D_; unsigned d0_, d1_, d2_, d3_; asm volatile("global_load_ushort %0, %1, off" : "=v"(d0_) : "v"(r_) : "memory"); \
    asm volatile("global_load_ushort %0, %1, off offset:128" : "=v"(d1_) : "v"(r_) : "memory"); asm volatile("global_load_ushort %0, %1, off offset:256" : "=v"(d2_) : "v"(r_) : "memory"); \
    asm volatile("global_load_ushort %0, %1, off offset:384" : "=v"(d3_) : "v"(r_) : "memory"); xr[(kk) & 1][0] = d0_; xr[(kk) & 1][1] = d1_; xr[(kk) & 1][2] = d2_; xr[(kk) & 1][3] = d3_; } while (0)
#define M_ISSUE(kk, h) do { const int s_ = (kk) & 1; const unsigned wa_ = mi[s_][0][(h) >> 1], wb_ = mi[s_][1][(h) >> 1]; \
    const unsigned ia_ = ((h) & 1) ? (wa_ >> 16) : (wa_ & 0xFFFFu), ib_ = ((h) & 1) ? (wb_ >> 16) : (wb_ & 0xFFFFu); \
    __builtin_amdgcn_global_load_lds((const unsigned*)(T8 + (ia_ * 128u + loff0)), (LAS unsigned*)(ring + (h) * 2048), 16, 0, 0); \
    __builtin_amdgcn_global_load_lds((const unsigned*)(T8 + (ib_ * 128u + loff1)), (LAS unsigned*)(ring + (h) * 2048 + 1024), 16, 0, 0); } while (0)
#define M_FENCE asm volatile("" ::: "memory")
  M_META(0); M_META(1); M_AUX(0);
  asm volatile("s_waitcnt vmcnt(0)" : "+v"(mi[0][0]), "+v"(mi[0][1]), "+v"(mi[1][0]), "+v"(mi[1][1]), "+v"(aop[0]), "+v"(asc[0]), "+v"(xr[0][0]), "+v"(xr[0][1]), "+v"(xr[0][2]), "+v"(xr[0][3]) :: "memory");
#pragma unroll
  for (int h = 0; h < 8; ++h) M_ISSUE(0, h);
  M_FENCE;
  static_for<NTOK>([&](auto kc) __attribute__((always_inline)) {
    constexpr int k = decltype(kc)::v;
    constexpr bool more = (k + 1 < NTOK);
    constexpr int oth = ((k + 2 < NTOK) ? 2 : 0) + (more ? 6 : 0), st = (k > 0) ? 4 : 0;
    M_FENCE;
    if constexpr (k + 2 < NTOK) M_META(k + 2);
    if constexpr (more) M_AUX(k + 1);
    M_FENCE;
    { u32x4 ma = mi[(k + 1) & 1][0], mb = mi[(k + 1) & 1][1]; v4i_t aa = aop[k & 1]; unsigned x0 = xr[k & 1][0], x1 = xr[k & 1][1], x2 = xr[k & 1][2], x3 = xr[k & 1][3]; float sc_ = asc[k & 1];
      asm volatile("s_waitcnt vmcnt(%8)" : "+v"(ma), "+v"(mb), "+v"(aa), "+v"(x0), "+v"(x1), "+v"(x2), "+v"(x3), "+v"(sc_) : "n"(st + oth) : "memory");
      mi[(k + 1) & 1][0] = ma; mi[(k + 1) & 1][1] = mb; aop[k & 1] = aa; xr[k & 1][0] = x0; xr[k & 1][1] = x1; xr[k & 1][2] = x2; xr[k & 1][3] = x3; asc[k & 1] = sc_; }
    v2i_t B0[16], B1[16];
    static_for<8>([&](auto pc_) __attribute__((always_inline)) {
      constexpr int pc = decltype(pc_)::v; const unsigned ta = tra[pc]; v2i_t r0, r1, r2, r3;
      asm volatile("ds_read_b64_tr_b4 %0, %4\n\tds_read_b64_tr_b4 %1, %4 offset:2048\n\tds_read_b64_tr_b4 %2, %4 offset:8\n\tds_read_b64_tr_b4 %3, %4 offset:2056" : "=&v"(r0), "=&v"(r1), "=&v"(r2), "=&v"(r3) : "v"(ta) : "memory");
      B0[2 * pc] = r0; B1[2 * pc] = r1; B0[2 * pc + 1] = r2; B1[2 * pc + 1] = r3; });
    asm volatile("s_waitcnt lgkmcnt(0)" : "+v"(B0[0]), "+v"(B0[1]), "+v"(B0[2]), "+v"(B0[3]), "+v"(B0[4]), "+v"(B0[5]), "+v"(B0[6]), "+v"(B0[7]), "+v"(B0[8]), "+v"(B0[9]), "+v"(B0[10]), "+v"(B0[11]), "+v"(B0[12]), "+v"(B0[13]), "+v"(B0[14]), "+v"(B0[15]) :: "memory");
    asm volatile("s_waitcnt lgkmcnt(0)" : "+v"(B1[0]), "+v"(B1[1]), "+v"(B1[2]), "+v"(B1[3]), "+v"(B1[4]), "+v"(B1[5]), "+v"(B1[6]), "+v"(B1[7]), "+v"(B1[8]), "+v"(B1[9]), "+v"(B1[10]), "+v"(B1[11]), "+v"(B1[12]), "+v"(B1[13]), "+v"(B1[14]), "+v"(B1[15]) :: "memory");
    if constexpr (more) {
#pragma unroll
      for (int h = 0; h < 8; ++h) M_ISSUE(k + 1, h); }
    f32x4 acc[4];
    static_for<16>([&](auto ic) __attribute__((always_inline)) {
      constexpr int i = decltype(ic)::v; constexpr int db = 4 * (i & 3) + (i >> 2);
      const v4i_t Bv = __builtin_shufflevector(B0[db], B1[db], 0, 1, 2, 3); const v4i_t Av = aop[k & 1]; const unsigned scl = sca[db & 3], onel = one; f32x4 ac;
      if constexpr ((db & 3) == 0) asm volatile("v_mfma_scale_f32_16x16x128_f8f6f4 %0, %1, %2, 0, %3, %4 op_sel_hi:[0,0,0] cbsz:4 blgp:4" : "=&v"(ac) : "v"(Av), "v"(Bv), "v"(scl), "v"(onel));
      else { ac = acc[db >> 2]; asm volatile("v_mfma_scale_f32_16x16x128_f8f6f4 %0, %1, %2, %0, %3, %4 op_sel_hi:[0,0,0] cbsz:4 blgp:4" : "+v"(ac) : "v"(Av), "v"(Bv), "v"(scl), "v"(onel)); }
      acc[db >> 2] = ac; });
    { f32x4 a0 = acc[0], a1 = acc[1], a2 = acc[2], a3 = acc[3]; asm volatile("s_nop 15\n\ts_nop 15" : "+v"(a0), "+v"(a1), "+v"(a2), "+v"(a3)); acc[0] = a0; acc[1] = a1; acc[2] = a2; acc[3] = a3; }
    M_FENCE;
    { const float sc_ = asc[k & 1]; float* op = OUT + (size_t)(tb + k) * D_; float o[4];
#pragma unroll
      for (int j = 0; j < 4; ++j) { const unsigned rr = xr[k & 1][j]; const u16 qh = (u16)rr; o[j] = (float)__builtin_bit_cast(_Float16, qh) + ((acc[j][0] + acc[j][1]) + (acc[j][2] + acc[j][3])) * sc_; }
      if (!DRY || o[0] == 123456.789f) { op[0] = o[0]; op[64] = o[1]; op[128] = o[2]; op[192] = o[3]; } }
    M_FENCE;
  });
  asm volatile("s_waitcnt vmcnt(0)" ::: "memory");
#undef M_META
#undef M_AUX
#undef M_ISSUE
#undef M_FENCE
}
template <int SIDE, bool DRY> __device__ __forceinline__ void phase_gather_sliced(const Params& p, unsigned char* smem) {
  const int tid = ptid(), lane = tid & 63, w = __builtin_amdgcn_readfirstlane(tid >> 6);
  volatile LAS int* ql = (volatile LAS int*)((LAS unsigned char*)smem + 131072);
  unsigned* ctrl = (unsigned*)p.ws;
  const int NCH = S_ / (16 * NTOK), QB = SIDE + (DRY ? 2 : 0);
  int x = (int)(xb_xcc_id() & 7u), cur = 0;
  if (tid == 0) ql[0] = (int)__hip_atomic_fetch_add(&ctrl[GQ_WORD(QB, x)], 1u, __ATOMIC_RELAXED, __HIP_MEMORY_SCOPE_AGENT);
  __syncthreads();
  for (;;) {
    const int ch = __builtin_amdgcn_readfirstlane(ql[cur]);
    if (ch < NCH) {
      unsigned nxt = 0u;
      if (tid == 0) nxt = __hip_atomic_fetch_add(&ctrl[GQ_WORD(QB, x)], 1u, __ATOMIC_RELAXED, __HIP_MEMORY_SCOPE_AGENT);
      if constexpr (SIDE == 0) g1_mfma_chunk<DRY>(p, (LAS unsigned char*)smem, w, (x >> 2) * (S_ / 2) + ch * 8 * NTOK + w * NTOK, x & 3, lane);
      else g2_mfma_chunk<DRY>(p, (LAS unsigned char*)smem, w, (x >> 2) * (S_ / 2) + ch * 8 * NTOK + w * NTOK, x & 3, lane);
      if (tid == 0) ql[cur ^ 1] = (int)nxt;
      __syncthreads();
      cur ^= 1;
    } else {
      if (tid < 8) ql[8 + tid] = (int)__hip_atomic_load(&ctrl[GQ_WORD(QB, tid)], __ATOMIC_RELAXED, __HIP_MEMORY_SCOPE_AGENT);
      __syncthreads();
      int nx = -1;
#pragma unroll
      for (int s = 7; s >= 1; --s) { const int y = (x + s) & 7; if (__builtin_amdgcn_readfirstlane(ql[8 + y]) < NCH) nx = y; }
      __syncthreads();
      if (nx < 0) break;
      x = nx;
      if (tid == 0) ql[cur] = (int)__hip_atomic_fetch_add(&ctrl[GQ_WORD(QB, x)], 1u, __ATOMIC_RELAXED, __HIP_MEMORY_SCOPE_AGENT);
      __syncthreads();
    }
  }
}
__device__ __forceinline__ f32x4 ld4h(const u16* p) { const u32x2v w = __builtin_nontemporal_load((const u32x2v*)p); const unsigned a = w.x, b = w.y; const h16x2 lo = __builtin_bit_cast(h16x2, a), hi = __builtin_bit_cast(h16x2, b); return (f32x4){(float)lo.x, (float)lo.y, (float)hi.x, (float)hi.y}; }
__device__ __forceinline__ void phase_areduce(const Params& p) {
  const u16* HP = (const u16*)(p.ws + WS_HP); const float* GW = (const float*)(p.ws + WS_G); const float* SSQ = (const float*)(p.ws + WS_SSQ);
  unsigned char* A8 = (unsigned char*)(p.ws + WS_A8); float* ASC = (float*)(p.ws + WS_ASC);
  const int gt = blockIdx.x * 512 + ptid(), GT = gridDim.x * 512, NQ = S_ * 128 / 4;
  for (int b0 = gt; b0 < NQ; b0 += 4 * GT) {
    f32x4 s[4], g[4]; float rq[4];
#pragma unroll
    for (int k = 0; k < 4; ++k) { const int qd = b0 + k * GT < NQ ? b0 + k * GT : b0, i = qd * 4; s[k] = ld4h(HP + i); g[k] = __builtin_nontemporal_load((const f32x4*)(GW + i)); rq[k] = SSQ[i >> 7]; }
#pragma unroll
    for (int x = 1; x < 4; ++x)
#pragma unroll
      for (int k = 0; k < 4; ++k) { const int qd = b0 + k * GT < NQ ? b0 + k * GT : b0; s[k] += ld4h(HP + (size_t)x * S_ * 128 + qd * 4); }
#pragma unroll
    for (int k = 0; k < 4; ++k) { const int qd = b0 + k * GT < NQ ? b0 + k * GT : b0; const uint2 iw = *(const uint2*)((const u16*)(p.ws + WS_IDX) + qd * 4);
      const float* SU = (const float*)(p.ws + WS_SU); s[k][0] *= SU[iw.x & 0xFFFFu]; s[k][1] *= SU[iw.x >> 16]; s[k][2] *= SU[iw.y & 0xFFFFu]; s[k][3] *= SU[iw.y >> 16]; }
#pragma unroll
    for (int k = 0; k < 4; ++k) { const int qd = b0 + k * GT < NQ ? b0 + k * GT : b0; { const int i = qd * 4; const float rs = rsqrtf(rq[k] * (1.0f / D_) + 1e-6f);
      const uint2 iw2 = *(const uint2*)((const u16*)(p.ws + WS_IDX) + qd * 4); const float* SV = (const float*)(p.ws + WS_SVS);
      float a[4];
#pragma unroll
      for (int c = 0; c < 4; ++c) a[c] = gelu_tanh_f(s[k][c] * rs) * g[k][c];
      a[0] *= SV[iw2.x & 0xFFFFu]; a[1] *= SV[iw2.x >> 16]; a[2] *= SV[iw2.y & 0xFFFFu]; a[3] *= SV[iw2.y >> 16];
      float am = fmaxf(fmaxf(fabsf(a[0]), fabsf(a[1])), fmaxf(fabsf(a[2]), fabsf(a[3])));
#pragma unroll
      for (int sh = 16; sh >= 1; sh >>= 1) am = fmaxf(am, __shfl_xor(am, sh));
      const bool tiny = am < 1e-30f;
      const float sc = tiny ? 1.0f : 6.0f / am, isc = tiny ? 1.0f : am * (1.0f / 6.0f);
      float r0 = __builtin_amdgcn_fmed3f(a[0] * sc, -6.0f, 6.0f), r1 = __builtin_amdgcn_fmed3f(a[1] * sc, -6.0f, 6.0f), r2 = __builtin_amdgcn_fmed3f(a[2] * sc, -6.0f, 6.0f), r3 = __builtin_amdgcn_fmed3f(a[3] * sc, -6.0f, 6.0f);
      const int t = qd >> 5, qp = qd & 31; unsigned char* ap = (unsigned char*)(p.ws + WS_A8) + (size_t)t * 256 + 2 * qp;
      unsigned q[4];
#pragma unroll
      for (int j = 0; j < 4; ++j) {
        const float sj = (j == 0) ? 1.0f : (j == 1) ? 4.0f : (j == 2) ? 32.0f : 256.0f, ij = 1.0f / sj;
        unsigned qq = 0;
        qq = __builtin_amdgcn_cvt_scalef32_pk_fp4_f32(qq, r0 * sj, r1 * sj, 1.0f, 0); qq = __builtin_amdgcn_cvt_scalef32_pk_fp4_f32(qq, r2 * sj, r3 * sj, 1.0f, 1);
        const auto b01 = __builtin_amdgcn_cvt_scalef32_pk_f32_fp4(qq, 1.0f, 0), b23 = __builtin_amdgcn_cvt_scalef32_pk_f32_fp4(qq, 1.0f, 1);
        r0 -= b01[0] * ij; r1 -= b01[1] * ij; r2 -= b23[0] * ij; r3 -= b23[1] * ij; q[j] = qq;
      }
      if (b0 + k * GT < NQ) {
#pragma unroll
        for (int j = 0; j < 4; ++j) *(u16*)(ap + 64 * j) = (u16)q[j];
        if (qp == 0) ((float*)(p.ws + WS_ASC))[t] = isc; } } }
  }
}

#define WS_ST16 WS_SQ
#define DO_KV (0 * MB_)
__device__ __forceinline__ s16x8 cat4(s16x4 x, s16x4 y) { return __builtin_shufflevector(x, y, 0, 1, 2, 3, 4, 5, 6, 7); }
__device__ __forceinline__ s16x4 tr32(LAS unsigned char* base, int st, int kb, int nb, int lane) {
  const int q = (lane & 15) >> 2, pp = lane & 3, blk = (lane >> 4) & 1;
  return __builtin_amdgcn_ds_read_tr16_b64_v4i16((LAS s16x4*)(base + (kb + q) * st + (nb + 16 * blk + 4 * pp) * 2));
}
__device__ __forceinline__ s16x4 tr16(LAS unsigned char* base, int st, int kb, int nb, int lane) {
  const int q = (lane & 15) >> 2, pp = lane & 3;
  return __builtin_amdgcn_ds_read_tr16_b64_v4i16((LAS s16x4*)(base + (kb + q) * st + (nb + 4 * pp) * 2));
}
__device__ __forceinline__ void norm16(u32x4 lo, u32x4 hi, int part, const float* __restrict__ gain, float (&a)[8], float (&b)[8]) {
  unpack8_bf16(lo, a); unpack8_bf16(hi, b);
  float ss = 0.f;
#pragma unroll
  for (int i = 0; i < 8; ++i) ss += a[i] * a[i] + b[i] * b[i];
  ss += __shfl_xor(ss, 1); ss += __shfl_xor(ss, 2);
  const float r = rsqrtf(ss * (1.0f / 64.0f) + 1e-6f);
  const f32x4 g0 = *(const f32x4*)(gain + 8 * part), g1 = *(const f32x4*)(gain + 8 * part + 4), g2 = *(const f32x4*)(gain + 32 + 8 * part), g3 = *(const f32x4*)(gain + 36 + 8 * part);
#pragma unroll
  for (int i = 0; i < 4; ++i) { a[i] *= r * g0[i]; a[4 + i] *= r * g1[i]; b[i] *= r * g2[i]; b[4 + i] *= r * g3[i]; }
}
__device__ __forceinline__ void rope16(float (&a)[8], float (&b)[8], const float* __restrict__ rc, const float* __restrict__ rs, int t, int part, float scale) {
  const f32x4 c0 = *(const f32x4*)(rc + t * 32 + 8 * part), c1 = *(const f32x4*)(rc + t * 32 + 8 * part + 4), s0 = *(const f32x4*)(rs + t * 32 + 8 * part), s1 = *(const f32x4*)(rs + t * 32 + 8 * part + 4);
#pragma unroll
  for (int i = 0; i < 8; ++i) { const float c = i < 4 ? c0[i & 3] : c1[i & 3], s = i < 4 ? s0[i & 3] : s1[i & 3]; const float x1 = a[i], x2 = b[i]; a[i] = (x1 * c - x2 * s) * scale; b[i] = (x1 * s + x2 * c) * scale; }
}
__device__ __forceinline__ void store_row16(LAS unsigned char* rowp, int part, const float (&a)[8], const float (&b)[8]) {
  u32x4 wa, wb; wa.x = pk_bf16(a[0], a[1]); wa.y = pk_bf16(a[2], a[3]); wa.z = pk_bf16(a[4], a[5]); wa.w = pk_bf16(a[6], a[7]);
  wb.x = pk_bf16(b[0], b[1]); wb.y = pk_bf16(b[2], b[3]); wb.z = pk_bf16(b[4], b[5]); wb.w = pk_bf16(b[6], b[7]);
  *(LAS u32x4*)(rowp + 16 * part) = wa; *(LAS u32x4*)(rowp + 64 + 16 * part) = wb;
}

struct KvRegs { u32x4 k0, k1, v[4]; };
__device__ __forceinline__ void kv_load(const Params& p, int item, KvRegs& R) {
  const int tid = ptid(), c = item >> 3, h = item & 7, t0 = c * 128;
  const u16* RK = (const u16*)(p.ws + WS_RK); const u16* RV = (const u16*)(p.ws + WS_RV);
  { const int j = tid >> 2, part = tid & 3; const u16* pp = RK + (size_t)(t0 + j) * 512 + h * 64 + part * 8; R.k0 = *(const u32x4*)pp; R.k1 = *(const u32x4*)(pp + 32); }
#pragma unroll
  for (int it = 0; it < 4; ++it) { const int q = tid + 512 * it, row = q >> 4, ch = q & 15; R.v[it] = *(const u32x4*)(RV + (size_t)(t0 + row) * 1024 + h * 128 + ch * 8); }
}
__device__ __forceinline__ void kv_item(const Params& p, LAS unsigned char* lds, int item, u16* __restrict__ KV, const KvRegs& R) {
  const int tid = ptid(), lane = tid & 63, w = __builtin_amdgcn_readfirstlane(tid >> 6), hh = lane >> 5, r = lane & 31;
  const int c = item >> 3, h = item & 7, t0 = c * 128;
  LAS unsigned char* Ks = lds; LAS unsigned char* Vs = lds + 128 * 192;
  const float* RC = (const float*)(p.ws + WS_ROPE_C); const float* RS = (const float*)(p.ws + WS_ROPE_S);
  { const int j = tid >> 2, part = tid & 3, t = t0 + j;
    float a[8], b[8]; norm16(R.k0, R.k1, part, p.ret_k_norm, a, b);
    rope16(a, b, RC, RS, t, part, 0.125f * exp2f((float)(127 - j) * p.l2g[h])); store_row16(Ks + j * 192, part, a, b); }
#pragma unroll
  for (int it = 0; it < 4; ++it) { const int q = tid + 512 * it, row = q >> 4, ch = q & 15; *(LAS u32x4*)(Vs + row * 320 + ch * 16) = R.v[it]; }
  __syncthreads();
  const int mb = w & 1, nb = w >> 1;
  f32x16 acc;
#pragma unroll
  for (int i = 0; i < 16; ++i) acc[i] = 0.f;
#pragma unroll
  for (int ks = 0; ks < 8; ++ks) { const int kb = 16 * ks + 8 * hh;
    const s16x8 af = cat4(tr32(Ks, 192, kb, 32 * mb, lane), tr32(Ks, 192, kb + 4, 32 * mb, lane));
    const s16x8 bf = cat4(tr32(Vs, 320, kb, 32 * nb, lane), tr32(Vs, 320, kb + 4, 32 * nb, lane));
    acc = MFMA32(af, bf, acc); }
  u16* op = KV + ((size_t)(c * 8 + h) * 128 + 32 * nb + r) * 64 + 32 * mb + 4 * hh;
#pragma unroll
  for (int g4 = 0; g4 < 4; ++g4) { uint2 o; o.x = pk_bf16(acc[4 * g4], acc[4 * g4 + 1]); o.y = pk_bf16(acc[4 * g4 + 2], acc[4 * g4 + 3]); *(uint2*)(op + 8 * g4) = o; }
  __syncthreads();
}

struct KvRegs2 { u32x4 k0[2], k1[2], v[8]; };
__device__ __forceinline__ void kv_load2(const Params& p, int item, KvRegs2& R) {
  const int ht = ptid() & 255, c = item >> 3, h = item & 7, t0 = c * 128;
  const u16* RK = (const u16*)(p.ws + WS_RK); const u16* RV = (const u16*)(p.ws + WS_RV);
#pragma unroll
  for (int s = 0; s < 2; ++s) { const int j = (ht >> 2) + 64 * s, part = ht & 3; const u16* pp = RK + (size_t)(t0 + j) * 512 + h * 64 + part * 8; R.k0[s] = *(const u32x4*)pp; R.k1[s] = *(const u32x4*)(pp + 32); }
#pragma unroll
  for (int it = 0; it < 8; ++it) { const int q = ht + 256 * it, row = q >> 4, ch = q & 15; R.v[it] = *(const u32x4*)(RV + (size_t)(t0 + row) * 1024 + h * 128 + ch * 8); }
}
__device__ __forceinline__ void kv_item2(const Params& p, LAS unsigned char* lds0, int item, u16* __restrict__ KV, const KvRegs2& R) {
  const int tid = ptid(), ht = tid & 255, lane = tid & 63, w = __builtin_amdgcn_readfirstlane(tid >> 6) & 3, hh = lane >> 5, r = lane & 31;
  const int c = item >> 3, h = item & 7, t0 = c * 128;
  LAS unsigned char* lds = lds0 + (tid >> 8) * 65536;
  LAS unsigned char* Ks = lds; LAS unsigned char* Vs = lds + 128 * 192;
  const float* RC = (const float*)(p.ws + WS_ROPE_C); const float* RS = (const float*)(p.ws + WS_ROPE_S);
#pragma unroll
  for (int s = 0; s < 2; ++s) { const int j = (ht >> 2) + 64 * s, part = ht & 3, t = t0 + j;
    float a[8], b[8]; norm16(R.k0[s], R.k1[s], part, p.ret_k_norm, a, b);
    rope16(a, b, RC, RS, t, part, 0.125f * exp2f((float)(127 - j) * p.l2g[h])); store_row16(Ks + j * 192, part, a, b); }
#pragma unroll
  for (int it = 0; it < 8; ++it) { const int q = ht + 256 * it, row = q >> 4, ch = q & 15; *(LAS u32x4*)(Vs + row * 320 + ch * 16) = R.v[it]; }
  __syncthreads();
  const int mb = w & 1;
#pragma unroll
  for (int n2 = 0; n2 < 2; ++n2) { const int nb = (w >> 1) + 2 * n2;
    f32x16 acc;
#pragma unroll
    for (int i = 0; i < 16; ++i) acc[i] = 0.f;
#pragma unroll
    for (int ks = 0; ks < 8; ++ks) { const int kb = 16 * ks + 8 * hh;
      const s16x8 af = cat4(tr32(Ks, 192, kb, 32 * mb, lane), tr32(Ks, 192, kb + 4, 32 * mb, lane));
      const s16x8 bf = cat4(tr32(Vs, 320, kb, 32 * nb, lane), tr32(Vs, 320, kb + 4, 32 * nb, lane));
      acc = MFMA32(af, bf, acc); }
    u16* op = KV + ((size_t)(c * 8 + h) * 128 + 32 * nb + r) * 64 + 32 * mb + 4 * hh;
#pragma unroll
    for (int g4 = 0; g4 < 4; ++g4) { uint2 o; o.x = pk_bf16(acc[4 * g4], acc[4 * g4 + 1]); o.y = pk_bf16(acc[4 * g4 + 2], acc[4 * g4 + 3]); *(uint2*)(op + 8 * g4) = o; } }
  __syncthreads();
}

__device__ __forceinline__ void phase_scan(const Params& p, unsigned char* smem, const u16* __restrict__ KV) {
  const int tid = ptid(), q = tid & 63, g = tid >> 6;
  f32x4* tot = (f32x4*)smem;
  u16* ST = (u16*)(p.ws + WS_ST16);
  for (int batch = blockIdx.x; batch < 256; batch += gridDim.x) {
    const int q4 = batch * 64 + q, h = q4 >> 11;
    const float cd = exp2f(128.0f * p.l2g[h]);
    f32x4 v[16];
#pragma unroll
    for (int i = 0; i < 16; ++i) { const uint2 w = *(const uint2*)(KV + ((size_t)(16 * g + i) * 16384 + q4) * 4);
      v[i] = (f32x4){__uint_as_float(w.x << 16), __uint_as_float(w.x & 0xffff0000u), __uint_as_float(w.y << 16), __uint_as_float(w.y & 0xffff0000u)}; }
    f32x4 run = (f32x4){0.f, 0.f, 0.f, 0.f};
#pragma unroll
    for (int i = 0; i < 16; ++i) { const f32x4 tmp = v[i]; v[i] = run; run = run * cd + tmp; }
    tot[g * 64 + q] = run;
    __syncthreads();
    float cd16 = cd; cd16 *= cd16; cd16 *= cd16; cd16 *= cd16; cd16 *= cd16;
    f32x4 C = (f32x4){0.f, 0.f, 0.f, 0.f};
    for (int gg = 0; gg < g; ++gg) C = C * cd16 + tot[gg * 64 + q];
    float pw = 1.0f;
#pragma unroll
    for (int i = 0; i < 16; ++i) { const f32x4 s = v[i] + C * pw; pw *= cd;
      uint2 o; o.x = pk_bf16(s[0], s[1]); o.y = pk_bf16(s[2], s[3]); *(uint2*)(ST + ((size_t)(16 * g + i) * 16384 + q4) * 4) = o; }
    __syncthreads();
  }
}

struct RetRegs { u32x4 q0, q1, k0, k1, st[2], v[4], gate[4]; };
__device__ __forceinline__ void retout_load(const Params& p, int item, RetRegs& R) {
  const int tid = ptid(), c = item >> 3, h = item & 7, t0 = c * 128;
  const u16* RQ = (const u16*)(p.ws + WS_RQ); const u16* RK = (const u16*)(p.ws + WS_RK); const u16* RV = (const u16*)(p.ws + WS_RV); const u16* ST = (const u16*)(p.ws + WS_ST16);
  { const int j = tid >> 2, part = tid & 3; const u16* pq = RQ + (size_t)(t0 + j) * 512 + h * 64 + part * 8; R.q0 = *(const u32x4*)pq; R.q1 = *(const u32x4*)(pq + 32);
    const u16* pk = RK + (size_t)(t0 + j) * 512 + h * 64 + part * 8; R.k0 = *(const u32x4*)pk; R.k1 = *(const u32x4*)(pk + 32); }
#pragma unroll
  for (int it = 0; it < 2; ++it) { const int q = tid + 512 * it, row = q >> 3, ch = q & 7; R.st[it] = *(const u32x4*)(ST + ((size_t)(c * 8 + h) * 128 + row) * 64 + ch * 8); }
  { const int lane = tid & 63, w = tid >> 6, ib = w >> 1, eh = w & 1; const u16* RG = (const u16*)(p.ws + WS_RG);
#pragma unroll
    for (int k = 0; k < 4; ++k) R.gate[k] = *(const u32x4*)(RG + (size_t)(t0 + 32 * ib + (lane >> 3) + 8 * k) * 1024 + h * 128 + 64 * eh + 8 * (lane & 7)); }
#pragma unroll
  for (int it = 0; it < 4; ++it) { const int q = tid + 512 * it, row = q >> 4, ch = q & 15; R.v[it] = *(const u32x4*)(RV + (size_t)(t0 + row) * 1024 + h * 128 + ch * 8); }
}
template <bool DRY> __device__ __forceinline__ void retout_item(const Params& p, LAS unsigned char* lds, int item, const RetRegs& R) {
  const int tid = ptid(), lane = tid & 63, w = __builtin_amdgcn_readfirstlane(tid >> 6), hh = lane >> 5, r = lane & 31;
  const int c = item >> 3, h = item & 7, t0 = c * 128;
  LAS unsigned char* Qs = lds; LAS unsigned char* Ks = lds + 18432; LAS unsigned char* STs = lds + 36864; LAS unsigned char* Vs = lds + 55296; LAS f32x2* red = (LAS f32x2*)(lds + 96256);
  u16* RG = (u16*)(p.ws + WS_RG);
  const float* RC = (const float*)(p.ws + WS_ROPE_C); const float* RS = (const float*)(p.ws + WS_ROPE_S);
  const float l2g = p.l2g[h];
  { const int j = tid >> 2, part = tid & 3, t = t0 + j; float a[8], b[8];
    norm16(R.q0, R.q1, part, p.ret_q_norm, a, b); rope16(a, b, RC, RS, t, part, 1.0f); store_row16(Qs + j * 144, part, a, b);
    norm16(R.k0, R.k1, part, p.ret_k_norm, a, b); rope16(a, b, RC, RS, t, part, 0.125f); store_row16(Ks + j * 144, part, a, b); }
#pragma unroll
  for (int it = 0; it < 2; ++it) { const int q = tid + 512 * it, row = q >> 3, ch = q & 7; *(LAS u32x4*)(STs + row * 144 + ch * 16) = R.st[it]; }
#pragma unroll
  for (int it = 0; it < 4; ++it) { const int q = tid + 512 * it, row = q >> 4, ch = q & 15; *(LAS u32x4*)(Vs + row * 320 + ch * 16) = R.v[it]; }
  __syncthreads();
  const int ib = w >> 1, eh = w & 1;
  f32x16 acc[2];
#pragma unroll
  for (int et = 0; et < 2; ++et)
#pragma unroll
    for (int i = 0; i < 16; ++i) acc[et][i] = 0.f;
  s16x8 bq[4];
#pragma unroll
  for (int ks = 0; ks < 4; ++ks) bq[ks] = *(const LAS s16x8*)(Qs + (32 * ib + r) * 144 + (16 * ks + 8 * hh) * 2);
#pragma unroll
  for (int et = 0; et < 2; ++et)
#pragma unroll
    for (int ks = 0; ks < 4; ++ks) { const s16x8 af = *(const LAS s16x8*)(STs + (32 * (2 * eh + et) + r) * 144 + (16 * ks + 8 * hh) * 2); acc[et] = MFMA32(af, bq[ks], acc[et]); }
  { const float qd = exp2f((float)(32 * ib + r + 1) * l2g);
#pragma unroll
    for (int et = 0; et < 2; ++et)
#pragma unroll
      for (int i = 0; i < 16; ++i) acc[et][i] *= qd; }
  float rowdec[16];
#pragma unroll
  for (int i = 0; i < 16; ++i) rowdec[i] = __builtin_amdgcn_exp2f(-(float)((i & 3) + 8 * (i >> 2) + 4 * hh) * l2g);
  for (int jb = 0; jb <= ib; ++jb) {
    f32x16 sc;
#pragma unroll
    for (int i = 0; i < 16; ++i) sc[i] = 0.f;
#pragma unroll
    for (int ks = 0; ks < 4; ++ks) { const s16x8 af = *(const LAS s16x8*)(Ks + (32 * jb + r) * 144 + (16 * ks + 8 * hh) * 2); sc = MFMA32(af, bq[ks], sc); }
    float pv[16];
    const float fcol = __builtin_amdgcn_exp2f((float)(32 * (ib - jb) + r) * l2g);
#pragma unroll
    for (int i = 0; i < 16; ++i) { const int jl = 32 * jb + (i & 3) + 8 * (i >> 2) + 4 * hh, diff = 32 * ib + r - jl; pv[i] = diff >= 0 ? sc[i] * (fcol * rowdec[i]) : 0.f; }
#pragma unroll
    for (int s = 0; s < 2; ++s) {
      u32x4 bw; bw.x = pk_bf16(pv[8 * s], pv[8 * s + 1]); bw.y = pk_bf16(pv[8 * s + 2], pv[8 * s + 3]); bw.z = pk_bf16(pv[8 * s + 4], pv[8 * s + 5]); bw.w = pk_bf16(pv[8 * s + 6], pv[8 * s + 7]);
      const s16x8 bf = __builtin_bit_cast(s16x8, bw);
#pragma unroll
      for (int et = 0; et < 2; ++et) { const int kb = 32 * jb + 16 * s + 4 * hh, nb = 32 * (2 * eh + et);
        const s16x8 af = cat4(tr32(Vs, 320, kb, nb, lane), tr32(Vs, 320, kb + 8, nb, lane)); acc[et] = MFMA32(af, bf, acc[et]); }
    }
  }
  float s1 = 0.f, s2 = 0.f;
#pragma unroll
  for (int et = 0; et < 2; ++et)
#pragma unroll
    for (int i = 0; i < 16; ++i) { const float v = acc[et][i]; s1 += v; s2 += v * v; }
  s1 += __shfl_xor(s1, 32); s2 += __shfl_xor(s2, 32);
  if (hh == 0) red[(32 * ib + r) * 2 + eh] = (f32x2){s1, s2};
  __syncthreads();
  const f32x2 ra = red[(32 * ib + r) * 2], rb = red[(32 * ib + r) * 2 + 1];
  const float mu = (ra.x + rb.x) * (1.0f / 128.0f), var = fmaxf((ra.y + rb.y) * (1.0f / 128.0f) - mu * mu, 0.f), rstd = rsqrtf(var + 1e-6f);
  LAS unsigned char* wt = lds + 98304 + w * 4608;
#pragma unroll
  for (int et = 0; et < 2; ++et)
#pragma unroll
    for (int g4 = 0; g4 < 4; ++g4) { typedef unsigned u32x2_t __attribute__((ext_vector_type(2))); u32x2_t o;
      o.x = pk_bf16((acc[et][4 * g4] - mu) * rstd, (acc[et][4 * g4 + 1] - mu) * rstd); o.y = pk_bf16((acc[et][4 * g4 + 2] - mu) * rstd, (acc[et][4 * g4 + 3] - mu) * rstd);
      *(LAS u32x2_t*)(wt + r * 144 + (32 * et + 8 * g4 + 4 * hh) * 2) = o; }
  { u32x4 yv[4]; f32x4 ga[4], gb[4];
#pragma unroll
    for (int k = 0; k < 4; ++k) { const int row = (lane >> 3) + 8 * k, ch = lane & 7, col = h * 128 + 64 * eh + 8 * ch;
      yv[k] = *(const LAS u32x4*)(wt + row * 144 + ch * 16); ga[k] = *(const f32x4*)(p.ret_gn + col); gb[k] = *(const f32x4*)(p.ret_gn + col + 4); }
#pragma unroll
    for (int k = 0; k < 4; ++k) { const int row = (lane >> 3) + 8 * k, ch = lane & 7, col = h * 128 + 64 * eh + 8 * ch;
      float y[8], g[8]; unpack8_bf16(yv[k], y); unpack8_bf16(R.gate[k], g); f32x4 o0, o1;
#pragma unroll
      for (int i = 0; i < 4; ++i) { o0[i] = y[i] * ga[k][i] * g[i] * sigmoidf_(g[i]); o1[i] = y[4 + i] * gb[k][i] * g[4 + i] * sigmoidf_(g[4 + i]); }
      const u32x4 ov = pack8_bf16(o0, o1); if (!DRY || ov.x == 0x12345678u) *(u32x4*)(RG + (size_t)(t0 + 32 * ib + row) * 1024 + col) = ov; } }
  __syncthreads();
}

__device__ __forceinline__ void sb_item(const Params& p, LAS unsigned char* lds, int item, u16* __restrict__ SB) {
  const int tid = ptid(), lane = tid & 63, w = __builtin_amdgcn_readfirstlane(tid >> 6), g = lane >> 4, lt = lane & 15;
  const int qb = item >> 3, h = item & 7, t0 = qb * 128;
  LAS unsigned char* Qs = lds; LAS unsigned* flags = (LAS unsigned*)(lds + 61440);
  const u16* SQ = (const u16*)(p.ws + WS_SQ); const u16* SK = (const u16*)(p.ws + WS_SK); const u16* SV = (const u16*)(p.ws + WS_SV);
  { const int j = tid >> 2, part = tid & 3, t = t0 + j; float a[8], b[8];
    const u16* pq = SQ + (size_t)t * 512 + h * 64 + part * 8; norm16(*(const u32x4*)pq, *(const u32x4*)(pq + 32), part, p.sb_q_norm, a, b);
#pragma unroll
    for (int i = 0; i < 8; ++i) { a[i] *= 0.18033688011112042f; b[i] *= 0.18033688011112042f; }
    store_row16(Qs + j * 144, part, a, b); }
  u32x4 r0, r1;
  const bool kthr = tid < 256; const int krow = tid >> 2, kpart = tid & 3, vq = tid - 256;
#define SB_LOAD(kt) do { if (kthr) { const u16* pk = SK + (size_t)((kt) * 64 + krow) * 512 + h * 64 + kpart * 8; r0 = *(const u32x4*)pk; r1 = *(const u32x4*)(pk + 32); } \
    else { r0 = *(const u32x4*)(SV + (size_t)((kt) * 64 + (vq >> 3)) * 512 + h * 64 + (vq & 7) * 8); r1 = *(const u32x4*)(SV + (size_t)((kt) * 64 + 32 + (vq >> 3)) * 512 + h * 64 + (vq & 7) * 8); } } while (0)
#define SB_WRITE(buf) do { LAS unsigned char* kb_ = lds + 18432 + (buf) * 21504; if (kthr) { float a[8], b[8]; norm16(r0, r1, kpart, p.sb_k_norm, a, b); store_row16(kb_ + krow * 144, kpart, a, b); } \
    else { *(LAS u32x4*)(kb_ + 9216 + (vq >> 3) * 192 + (vq & 7) * 16) = r0; *(LAS u32x4*)(kb_ + 9216 + (32 + (vq >> 3)) * 192 + (vq & 7) * 16) = r1; } } while (0)
  const int ktmax = 2 * qb + 1;
  SB_LOAD(ktmax); SB_WRITE(0);
  __syncthreads();
  s16x8 qf[2];
#pragma unroll
  for (int ks = 0; ks < 2; ++ks) qf[ks] = *(const LAS s16x8*)(Qs + (16 * w + lt) * 144 + (32 * ks + 8 * g) * 2);
  float carry = 0.f; f32x4 o[4];
#pragma unroll
  for (int et = 0; et < 4; ++et) o[et] = (f32x4){0.f, 0.f, 0.f, 0.f};
  const int tq = t0 + 16 * w + lt;
  for (int kt = ktmax, it = 0; kt >= 0; --kt, ++it) {
    const int buf = it & 1; LAS unsigned char* Ks = lds + 18432 + buf * 21504; LAS unsigned char* Vs = Ks + 9216;
    if (kt > 0) SB_LOAD(kt - 1);
    const bool wskip = (kt * 64 >= t0 + 16 * w + 16) || __all(carry < -150.1f);
    if (!wskip) {
    f32x4 z[4];
#pragma unroll
    for (int a = 0; a < 4; ++a) { z[a] = (f32x4){0.f, 0.f, 0.f, 0.f};
#pragma unroll
      for (int ks = 0; ks < 2; ++ks) { const s16x8 af = *(const LAS s16x8*)(Ks + (16 * a + lt) * 144 + (32 * ks + 8 * g) * 2); z[a] = MFMA16(af, qf[ks], z[a]); } }
    float ls[4][4], zl[4][4], G[4], T[4], suf[4];
    const bool masked = kt * 64 + 64 > t0 + 16 * w;
#pragma unroll
    for (int a = 0; a < 4; ++a) { G[a] = 0.f;
#pragma unroll
      for (int rr = 0; rr < 4; ++rr) { const float zv = z[a][rr];
        const float sp = fmaxf(zv, 0.f) + __builtin_amdgcn_logf(1.0f + __builtin_amdgcn_exp2f(-fabsf(zv)));
        ls[a][rr] = -sp; zl[a][rr] = zv - sp; } }
    if (masked) {
#pragma unroll
      for (int a = 0; a < 4; ++a)
#pragma unroll
        for (int rr = 0; rr < 4; ++rr) { const bool valid = (kt * 64 + 16 * a + 4 * g + rr) < tq; ls[a][rr] = valid ? ls[a][rr] : 0.f; zl[a][rr] = valid ? zl[a][rr] : -1.0e30f; }
    }
#pragma unroll
    for (int a = 0; a < 4; ++a) G[a] = (ls[a][0] + ls[a][1]) + (ls[a][2] + ls[a][3]);
#pragma unroll
    for (int a = 0; a < 4; ++a) { const float x1 = __shfl_xor(G[a], 16), x2 = __shfl_xor(G[a], 32), x3 = __shfl_xor(G[a], 48);
      T[a] = G[a] + x1 + x2 + x3; suf[a] = g == 0 ? (x1 + x2 + x3) : (g == 1 ? (x2 + x3) : (g == 2 ? x1 : 0.f)); }
    float wv[4][4];
    { float after = 0.f;
#pragma unroll
      for (int a = 3; a >= 0; --a) { float base = carry + after + suf[a];
#pragma unroll
        for (int rr = 3; rr >= 0; --rr) { wv[a][rr] = __builtin_amdgcn_exp2f(zl[a][rr] + base); base += ls[a][rr]; }
        after += T[a]; }
      carry += after; }
#pragma unroll
    for (int ap = 0; ap < 2; ++ap) {
      u32x4 bw; bw.x = pk_bf16(wv[2 * ap][0], wv[2 * ap][1]); bw.y = pk_bf16(wv[2 * ap][2], wv[2 * ap][3]); bw.z = pk_bf16(wv[2 * ap + 1][0], wv[2 * ap + 1][1]); bw.w = pk_bf16(wv[2 * ap + 1][2], wv[2 * ap + 1][3]);
      const s16x8 bf = __builtin_bit_cast(s16x8, bw);
#pragma unroll
      for (int et = 0; et < 4; ++et) { const s16x8 af = cat4(tr16(Vs, 192, 32 * ap + 4 * g, 16 * et, lane), tr16(Vs, 192, 32 * ap + 16 + 4 * g, 16 * et, lane)); o[et] = MFMA16(af, bf, o[et]); }
    }
    }
    const bool done = __all(carry < -150.1f);
    if (lane == 0) flags[buf * 8 + w] = done ? 1u : 0u;
    if (kt > 0) SB_WRITE(buf ^ 1);
    __syncthreads();
    if (kt > 0) { unsigned all = 1u;
#pragma unroll
      for (int i = 0; i < 8; ++i) all &= flags[buf * 8 + i];
      if (all) break; }
  }
  { u16* op = SB + (size_t)tq * 512 + h * 64 + 4 * g;
#pragma unroll
    for (int et = 0; et < 4; ++et) { uint2 ov; ov.x = pk_bf16(o[et][0], o[et][1]); ov.y = pk_bf16(o[et][2], o[et][3]); *(uint2*)(op + 16 * et) = ov; } }
  __syncthreads();
#undef SB_LOAD
#undef SB_WRITE
}
__device__ __forceinline__ void phase_mixA(const Params& p, unsigned char* smem, char* dob) {
  LAS unsigned char* lds = (LAS unsigned char*)smem;
  { const int half = ptid() >> 8; KvRegs2 cur, nxt; int pi = blockIdx.x; if (pi < 512) kv_load2(p, 2 * pi + half, cur);
    for (; pi < 512; pi += gridDim.x) { const int ni = pi + gridDim.x; if (ni < 512) kv_load2(p, 2 * ni + half, nxt); kv_item2(p, lds, 2 * pi + half, (u16*)(dob + DO_KV), cur); cur = nxt; } }
  for (int item = blockIdx.x; item < 1024; item += gridDim.x) sb_item(p, lds, item, (u16*)(dob + DO_SB));
}
template <bool DRY> __device__ __forceinline__ void phase_retout(const Params& p, unsigned char* smem) {
  LAS unsigned char* lds = (LAS unsigned char*)smem;
  RetRegs cur, nxt; int item = blockIdx.x; if (item < 1024) retout_load(p, item, cur);
  for (; item < 1024; item += gridDim.x) { const int ni = item + gridDim.x; if (ni < 1024) retout_load(p, ni, nxt); retout_item<DRY>(p, lds, item, cur); cur = nxt; }
}


#define XB_TMO      128
#define XB_XCNT(j)  (256  + 64 * (j))
#define XB_XSUB(j)  (1280 + 64 * (j))
#define XB_XGEN(j)  (2304 + 64 * (j))
#define XB_TOP      3328
#define XB_TOPGEN   3392
#define XCD_BAR_WORDS 3456
#define XB_SPIN_CAP (1u << 22)
__device__ __forceinline__ unsigned xb_ld(unsigned* p)              { return __hip_atomic_load(p, __ATOMIC_RELAXED, __HIP_MEMORY_SCOPE_AGENT); }
__device__ __forceinline__ unsigned xb_add(unsigned* p, unsigned v) { return __hip_atomic_fetch_add(p, v, __ATOMIC_RELAXED, __HIP_MEMORY_SCOPE_AGENT); }
__device__ __forceinline__ unsigned xb_xcc_id() { return (unsigned)__builtin_amdgcn_s_getreg((3 << 11) | 20) & 0xFu; }
#define XB_SPIN(cond, bar) do { unsigned _sp = 0; while (cond) { __builtin_amdgcn_s_sleep(1); \
    if ((++_sp & 255u) == 0u) { if (xb_ld(&(bar)[XB_TMO])) break; if (_sp > XB_SPIN_CAP) { atomicAdd(&(bar)[XB_TMO], 1u); break; } } } } while (0)
struct XcdBarrier { unsigned* bar; unsigned x; volatile LAS unsigned* st; };
__device__ __forceinline__ XcdBarrier xcd_barrier_post(unsigned* bar, volatile LAS unsigned* st) {
  XcdBarrier b; b.bar = bar; b.x = xb_xcc_id(); b.st = st;
  if (ptid() == 0) (void)xb_add(&bar[XB_XCNT(b.x)], 1u);
  return b;
}
__device__ __forceinline__ void xcd_barrier_complete(unsigned* bar, unsigned x, unsigned& nloc, unsigned& nx) {
  const unsigned G = gridDim.x * gridDim.y * gridDim.z;
  unsigned sum, cnt, mine, sp = 0u;
  for (;;) {
    sum = 0u; cnt = 0u; mine = 0u;
#pragma unroll
    for (unsigned j = 0; j < 16; ++j) { const unsigned c = xb_ld(&bar[XB_XCNT(j)]); sum += c; cnt += (c > 0u) ? 1u : 0u; mine = (j == x) ? c : mine; }
    if (sum == G) break;
    __builtin_amdgcn_s_sleep(1);
    if ((++sp & 255u) == 0u) { if (xb_ld(&bar[XB_TMO])) break; if (sp > XB_SPIN_CAP) { atomicAdd(&bar[XB_TMO], 1u); break; } }
  }
  nloc = mine > 0u ? mine : 1u; nx = cnt > 0u ? cnt : 1u;
}
__device__ __forceinline__ void xcd_barrier(const XcdBarrier& b) {
  asm volatile("s_waitcnt vmcnt(0)" ::: "memory");
  __syncthreads();
  if (ptid() == 0) {
    unsigned* bar = b.bar;
    __builtin_amdgcn_s_waitcnt(0);
    unsigned nloc = b.st[0], nx = b.st[1];
    if (nloc == 0u) { xcd_barrier_complete(bar, b.x, nloc, nx); b.st[0] = nloc; b.st[1] = nx; }
    const unsigned old = xb_add(&bar[XB_XSUB(b.x)], 1u);
    const unsigned gen = old / nloc;
    if (old + 1u == (gen + 1u) * nloc) {
      __builtin_amdgcn_fence(__ATOMIC_RELEASE, "agent");
      asm volatile("s_waitcnt vmcnt(0)" ::: "memory");
      const unsigned og = xb_add(&bar[XB_TOP], 1u);
      const unsigned tg = og / nx;
      if (og + 1u == (tg + 1u) * nx) xb_add(&bar[XB_TOPGEN], 1u);
      else XB_SPIN(xb_ld(&bar[XB_TOPGEN]) == tg, bar);
      __builtin_amdgcn_fence(__ATOMIC_ACQUIRE, "agent");
      xb_add(&bar[XB_XGEN(b.x)], 1u);
      asm volatile("s_waitcnt vmcnt(0)" ::: "memory");
    } else {
      XB_SPIN(xb_ld(&bar[XB_XGEN(b.x)]) == gen, bar);
      __builtin_amdgcn_fence(__ATOMIC_ACQUIRE, "agent");
      asm volatile("s_waitcnt vmcnt(0)" ::: "memory");
    }
  }
  __syncthreads();
}

#define LDS_BYTES 147456
#ifndef PROBE_DUP
#define PROBE_DUP -1
#endif
#define LDS_BAR_OFF 147440
__global__ __launch_bounds__(512, 2) void k_mega(Params p) {
  extern __shared__ __attribute__((aligned(16))) unsigned char smem[];
  cg::grid_group grid = cg::this_grid();
  char* dob = (char*)p.out; char* ws = p.ws;
  PG8_LAS unsigned char* lds = (PG8_LAS unsigned char*)smem;
  u16* XN = (u16*)(dob + DO_XN); u16* WINT = (u16*)(dob + DO_WINT); u16* SB = (u16*)(dob + DO_SB); u16* WBRAT = (u16*)(dob + DO_WBRAT); u16* WBRBT = (u16*)(dob + DO_WBRBT);
  u16* WOUTT = (u16*)(ws + WS_WOUTT); u16* WQT = (u16*)(ws + WS_WQT); float* SSQ = (float*)(ws + WS_SSQ);
  u16* RQ = (u16*)(ws + WS_RQ); u16* RK = (u16*)(ws + WS_RK); u16* RV = (u16*)(ws + WS_RV); u16* SQ = (u16*)(ws + WS_SQ); u16* SK = (u16*)(ws + WS_SK);
  u16* SV = (u16*)(ws + WS_SV); u16* RG = (u16*)(ws + WS_RG); u16* GA = (u16*)(ws + WS_GA); u16* GB = (u16*)(ws + WS_GB);
  u16* MIXED = (u16*)(ws + WS_MIXED); u16* X1H = (u16*)(ws + WS_X1H); u16* Q = (u16*)(ws + WS_Q);
  const int G = (int)gridDim.x, c = (int)blockIdx.x;
  volatile LAS unsigned* xst = (volatile LAS unsigned*)((LAS unsigned char*)smem + LDS_BAR_OFF);
  if (ptid() < 4) xst[ptid()] = 0u;
  __syncthreads();
  const XcdBarrier xb = xcd_barrier_post((unsigned*)ws, xst);
  if (p.use_cg) grid.sync();
#define GRID_SYNC() xcd_barrier(xb)
#if PROBE_DUP == 100
  for (int i = 0; i < 10; ++i) GRID_SYNC();
#endif
#if PROBE_DUP == 0
  phase_prologue(p, smem, dob); __syncthreads();
#endif
  phase_prologue(p, smem, dob);
  GRID_SYNC();
  { FEpiQK e{p.ws}; pg8::StaticOrder S; S.init(S_, 2048, G, c); pg8::gemm_phase<0>(lds, pg8::Gemm{XN, WINT, S_, 2048, 1024, 0}, S, e);
    FEpiMX em{p.ws}; pg8::StaticOrder S2; S2.init(S_, 4608, G, c);
    pg8::gemm_phase<2>(lds, pg8::Gemm{(const u16*)(dob + DO_XN8), (const u16*)(dob + DO_W8T), S_, 4608, 512, 0}, S2, em);
    const int rem = S2.nwg % G;
    if (rem && c >= rem) conv_u4(p, c - rem, G - rem); }
  GRID_SYNC();
#if PROBE_DUP == 2
  phase_mixA(p, smem, dob);
#endif
  phase_mixA(p, smem, dob);
  GRID_SYNC();
#if PROBE_DUP == 3
  phase_scan(p, smem, (const u16*)(dob + DO_KV));
#endif
  phase_scan(p, smem, (const u16*)(dob + DO_KV));
  GRID_SYNC();
#if PROBE_DUP == 4
  phase_retout<true>(p, smem);
#endif
  phase_retout<false>(p, smem);
  GRID_SYNC();
  { const int rem = ((S_ / 256) * 18) % G; if (!rem) conv_u4(p, c, G); }
  __syncthreads();
#if PROBE_DUP == 51
  { FEpiMixB e{MIXED, GB}; pg8::StaticOrder S; S.init(S_, 1024, G, c); pg8::gemm_phase<0>(lds, pg8::Gemm{SB, WBRBT, S_, 1024, 512, 0}, S, e); }
  { FEpiMixA e{MIXED, GA}; pg8::StaticOrder S; S.init(S_, 1024, G, c); pg8::gemm_phase<0>(lds, pg8::Gemm{RG, WBRAT, S_, 1024, 1024, 0}, S, e); }
#endif
  { FEpiMixB e0{RQ, GA}; FEpiMixA e1{MIXED, GB, RQ}; pg8::StaticOrder S; S.init(S_, 1024, G, c);
    pg8::gemm_phase2(lds, pg8::Gemm{RG, WBRAT, S_, 1024, 1024, 0}, pg8::Gemm{SB, WBRBT, S_, 1024, 512, 0}, S, e0, e1); }
  GRID_SYNC();
#if PROBE_DUP == 6
  { FEpiOut e{p.x, p.out, X1H, nullptr}; pg8::StaticOrder S; S.init(S_, 1024, G, c); pg8::gemm_phase<0>(lds, pg8::Gemm{MIXED, WOUTT, S_, 1024, 1024, 0}, S, e); }
#endif
  { FEpiOut e{p.x, p.out, X1H, SSQ}; pg8::StaticOrder S; S.init(S_, 1024, G, c); pg8::gemm_phase<0>(lds, pg8::Gemm{MIXED, WOUTT, S_, 1024, 1024, 0}, S, e); }
  GRID_SYNC();
  { FEpiQ e{SSQ, Q}; pg8::StaticOrder S; S.init(S_, 2048, G, c); pg8::gemm_phase<1>(lds, pg8::Gemm{X1H, WQT, S_, 2048, 1024, 0}, S, e);
    __syncthreads();
#if PROBE_DUP == 8
    phase_select(p, smem, S); __syncthreads();
#endif
    phase_select(p, smem, S); }
  GRID_SYNC();
#if PROBE_DUP == 9
  phase_gather_sliced<0, true>(p, smem);
#endif
  phase_gather_sliced<0, false>(p, smem);
  GRID_SYNC();
#if PROBE_DUP == 10
  phase_areduce(p);
#endif
  phase_areduce(p);
  GRID_SYNC();
#if PROBE_DUP == 11
  phase_gather_sliced<1, true>(p, smem);
#endif
  phase_gather_sliced<1, false>(p, smem);
}

extern "C" void kernel_launch(void* const* d_in, const int* in_sizes, int n_in, void* d_out, int out_size, void* d_ws, size_t ws_size, hipStream_t stream) {
  if (ws_size < WS_NEED || n_in != 17) return;
  static int grid_blocks = 0;
  if (!grid_blocks) {
    int dev = 0, cus = 0, per_cu = 0;
    (void)hipGetDevice(&dev);
    (void)hipDeviceGetAttribute(&cus, hipDeviceAttributeMultiprocessorCount, dev);
    (void)hipFuncSetAttribute((const void*)k_mega, hipFuncAttributeMaxDynamicSharedMemorySize, LDS_BYTES);
    (void)hipOccupancyMaxActiveBlocksPerMultiprocessor(&per_cu, (const void*)k_mega, 512, LDS_BYTES);
    if (per_cu < 1) { fprintf(stderr, "k_mega: occupancy query says %d blocks per CU\n", per_cu); grid_blocks = -1; }
    else grid_blocks = cus * per_cu;
  }
  if (grid_blocks < 0) return;
  Params P{};
  P.x = (const float*)d_in[0]; P.norm_attn = (const float*)d_in[1]; P.w_in = (const float*)d_in[2]; P.ret_q_norm = (const float*)d_in[3]; P.ret_k_norm = (const float*)d_in[4];
  P.ret_gn = (const float*)d_in[5]; P.sb_q_norm = (const float*)d_in[6]; P.sb_k_norm = (const float*)d_in[7]; P.w_bra = (const float*)d_in[8]; P.w_brb = (const float*)d_in[9];
  P.w_out = (const float*)d_in[10]; P.norm_ffn = (const float*)d_in[11]; P.w_q = (const float*)d_in[12]; P.sk1 = (const float*)d_in[13]; P.sk2 = (const float*)d_in[14];
  P.peer_u = (const float*)d_in[15]; P.peer_v = (const float*)d_in[16]; P.out = (float*)d_out; P.ws = (char*)d_ws;
  for (int h = 0; h < 8; ++h) P.l2g[h] = (float)log2(1.0 - exp2(-5.0 - (double)h));
  P.use_cg = 0; P.pad = 0;
  (void)hipMemsetAsync(d_ws, 0, 32768, stream);
  void* args[] = {&P};
  hipError_t e = hipLaunchCooperativeKernel((const void*)k_mega, dim3(grid_blocks), dim3(512), args, LDS_BYTES, stream);
  if (e != hipSuccess) fprintf(stderr, "cooperative launch failed: %s (grid %d)\n", hipGetErrorString(e), grid_blocks);
}
```
